# Optimizing an MI355X kernel written in HIP

```python
import math
import jax, jax.numpy as jnp
from jax import lax
import numpy as np

D_MODEL = 2048
BATCH = 4
SEQ = 4096
DEPTH = 1

D_MIX = D_MODEL
SSM_WIDTH = D_MIX // 2
SSM_GROUP = 16
SSM_GROUPS = SSM_WIDTH // SSM_GROUP
SSM_STATE = 64
NSA_WIDTH = D_MIX - SSM_WIDTH
HEAD_DIM = 64
NSA_HEADS = NSA_WIDTH // HEAD_DIM
KV_HEADS = 4
Q_PER_KV = NSA_HEADS // KV_HEADS
KV_WIDTH = KV_HEADS * HEAD_DIM
CMP_BLOCK = 32
CMP_STRIDE = 16
CMP_HIDDEN = 256
SLC_BLOCK = 64
SLC_TOPK = 16
WINDOW = 512
Q_BLOCK = 128
SLC_Q_BLOCK = 64
REL_BUCKETS = 32
REL_MAX_DIST = 128
D_FF = 4 * D_MODEL
EPS = 1e-6
NEG = -1e30
FORCED_SCORE = 1e4
D_IN = SSM_WIDTH + NSA_WIDTH + 6 * KV_WIDTH + 3 * NSA_HEADS

kernel_name = "hymba_s5_nsa_hybrid_block"


def rmsnorm(x, w):
    xf = x.astype(jnp.float32)
    y = xf * lax.rsqrt(jnp.mean(xf * xf, axis=-1, keepdims=True) + EPS)
    return (y * w.astype(jnp.float32)).astype(x.dtype)


def masked_softmax(logits, mask):
    p = jax.nn.softmax(jnp.where(mask, logits, NEG), axis=-1)
    return p * jnp.any(mask, axis=-1, keepdims=True)


def rel_bucket(dist):
    dist = jnp.maximum(dist, 0)
    max_exact = REL_BUCKETS // 2
    large = max_exact + (jnp.log(jnp.maximum(dist, 1).astype(jnp.float32) / max_exact)
                         / math.log(REL_MAX_DIST / max_exact) * (REL_BUCKETS - max_exact)).astype(jnp.int32)
    large = jnp.minimum(large, REL_BUCKETS - 1)
    return jnp.where(dist < max_exact, dist, large)


def s5_mixer(u, a_re, a_im, log_dt, b_re, b_im, c_re, c_im, d, w_glu, b_glu):
    bsz, L, _ = u.shape
    ug = u.reshape(bsz, L, SSM_GROUPS, SSM_GROUP)
    dt = jnp.exp(log_dt)[:, None]
    mag = jnp.exp(dt * a_re)
    abar_re = mag * jnp.cos(dt * a_im)
    abar_im = mag * jnp.sin(dt * a_im)
    den = a_re * a_re + a_im * a_im
    zr, zi = abar_re - 1.0, abar_im
    coef_re = (zr * a_re + zi * a_im) / den
    coef_im = (zi * a_re - zr * a_im) / den
    bu_re = jnp.einsum('blgh,gph->blgp', ug, b_re)
    bu_im = jnp.einsum('blgh,gph->blgp', ug, b_im)
    xb_re = coef_re * bu_re - coef_im * bu_im
    xb_im = coef_re * bu_im + coef_im * bu_re
    ar = jnp.broadcast_to(abar_re, xb_re.shape)
    ai = jnp.broadcast_to(abar_im, xb_re.shape)

    def combine(e1, e2):
        a1r, a1i, b1r, b1i = e1
        a2r, a2i, b2r, b2i = e2
        return (a1r * a2r - a1i * a2i, a1r * a2i + a1i * a2r,
                a2r * b1r - a2i * b1i + b2r, a2r * b1i + a2i * b1r + b2i)

    _, _, s_re, s_im = lax.associative_scan(combine, (ar, ai, xb_re, xb_im), axis=1)
    y = (jnp.einsum('blgp,ghp->blgh', s_re, c_re) - jnp.einsum('blgp,ghp->blgh', s_im, c_im)
         + d * ug).reshape(bsz, L, SSM_WIDTH)
    z = jax.nn.gelu(y)
    return z * jax.nn.sigmoid(z @ w_glu + b_glu)


def compress(k, idx, pe, w1, w2):
    bsz = k.shape[0]
    n_cmp = idx.shape[0]
    blocks = k[:, idx] + pe[None, None, :, None, :]
    flat = blocks.transpose(0, 1, 3, 2, 4).reshape(bsz, n_cmp, KV_HEADS, CMP_BLOCK * HEAD_DIM)
    return jax.nn.gelu(flat @ w1) @ w2


def nsa_mixer(q, kc, vc, ks, vs, kw, vw, gate_logits, pe_ck, w_ck1, w_ck2, pe_cv, w_cv1, w_cv2, rel_table):
    bsz, L, _ = q.shape
    q = q.reshape(bsz, L, KV_HEADS, Q_PER_KV, HEAD_DIM) * (HEAD_DIM ** -0.5)
    kc, vc, ks, vs, kw, vw = [t.reshape(bsz, L, KV_HEADS, HEAD_DIM) for t in (kc, vc, ks, vs, kw, vw)]
    pos = jnp.arange(L)
    table_g = rel_table.reshape(REL_BUCKETS, KV_HEADS, Q_PER_KV).transpose(1, 0, 2)
    g_ix = jnp.arange(KV_HEADS)[None, :, None, None]
    b_ix = jnp.arange(bsz)[:, None, None, None]

    n_cmp = (L - CMP_BLOCK) // CMP_STRIDE + 1
    cmp_idx = np.arange(n_cmp)[:, None] * CMP_STRIDE + np.arange(CMP_BLOCK)[None, :]
    k_cmp = compress(kc, cmp_idx, pe_ck, w_ck1, w_ck2)
    v_cmp = compress(vc, cmp_idx, pe_cv, w_cv1, w_cv2)
    dist_c = pos[:, None] - jnp.asarray(cmp_idx[:, -1])[None, :]
    bias_c = table_g[:, rel_bucket(dist_c)].transpose(0, 3, 1, 2)
    logits_c = jnp.einsum('blgrd,bngd->bgrln', q, k_cmp).astype(jnp.float32) + bias_c
    p_c = masked_softmax(logits_c, dist_c >= 0)
    o_cmp = jnp.einsum('bgrln,bngd->blgrd', p_c.astype(v_cmp.dtype), v_cmp)

    n_slc = L // SLC_BLOCK
    overlap = ((cmp_idx[:, :, None] // SLC_BLOCK) == np.arange(n_slc)[None, None, :]).sum(1) / CMP_BLOCK
    imp = jnp.einsum('bgrln,ns->bgls', p_c, jnp.asarray(overlap, dtype=jnp.float32))
    cur = pos // SLC_BLOCK
    blk = jnp.arange(n_slc)
    forced = (blk[None, :] == 0) | (blk[None, :] == cur[:, None]) | (blk[None, :] == cur[:, None] - 1)
    valid = blk[None, :] <= cur[:, None]
    score = jnp.where(forced, FORCED_SCORE, jnp.where(valid, imp, -1.0))
    n_top = min(SLC_TOPK, n_slc)
    _, sel = lax.top_k(score, n_top)

    ks_g = ks.reshape(bsz, n_slc, SLC_BLOCK, KV_HEADS, HEAD_DIM).transpose(0, 3, 1, 2, 4)
    vs_g = vs.reshape(bsz, n_slc, SLC_BLOCK, KV_HEADS, HEAD_DIM).transpose(0, 3, 1, 2, 4)
    n_qb = L // SLC_Q_BLOCK
    q_blocks = q.reshape(bsz, n_qb, SLC_Q_BLOCK, KV_HEADS, Q_PER_KV, HEAD_DIM).transpose(1, 0, 2, 3, 4, 5)
    sel_blocks = sel.reshape(bsz, KV_HEADS, n_qb, SLC_Q_BLOCK, n_top).transpose(2, 0, 1, 3, 4)
    pos_blocks = pos.reshape(n_qb, SLC_Q_BLOCK)
    n_tok = n_top * SLC_BLOCK

    def slc_block(args):
        qb_, selb, posb = args
        kg = ks_g[b_ix, g_ix, selb].reshape(bsz, KV_HEADS, SLC_Q_BLOCK, n_tok, HEAD_DIM)
        vg = vs_g[b_ix, g_ix, selb].reshape(bsz, KV_HEADS, SLC_Q_BLOCK, n_tok, HEAD_DIM)
        tok = (selb[..., None] * SLC_BLOCK + jnp.arange(SLC_BLOCK)).reshape(bsz, KV_HEADS, SLC_Q_BLOCK, n_tok)
        dist = posb[None, None, :, None] - tok
        bias = table_g[g_ix, rel_bucket(dist)].transpose(0, 1, 4, 2, 3)
        logits = jnp.einsum('bqgrd,bgqtd->bgrqt', qb_, kg).astype(jnp.float32) + bias
        p = masked_softmax(logits, (dist >= 0)[:, :, None])
        return jnp.einsum('bgrqt,bgqtd->bqgrd', p.astype(vg.dtype), vg)

    o_slc = lax.map(slc_block, (q_blocks, sel_blocks, pos_blocks))
    o_slc = o_slc.transpose(1, 0, 2, 3, 4, 5).reshape(bsz, L, KV_HEADS, Q_PER_KV, HEAD_DIM)

    n_wb = L // Q_BLOCK
    span = WINDOW + Q_BLOCK
    key_idx = np.arange(n_wb)[:, None] * Q_BLOCK + np.arange(span)[None, :]
    kw_pad = jnp.pad(kw, ((0, 0), (WINDOW, 0), (0, 0), (0, 0)))
    vw_pad = jnp.pad(vw, ((0, 0), (WINDOW, 0), (0, 0), (0, 0)))
    kwin = kw_pad[:, key_idx]
    vwin = vw_pad[:, key_idx]
    qw = q.reshape(bsz, n_wb, Q_BLOCK, KV_HEADS, Q_PER_KV, HEAD_DIM)
    kpos = jnp.asarray(key_idx - WINDOW)
    qpos = pos.reshape(n_wb, Q_BLOCK)
    dist_w = qpos[:, :, None] - kpos[:, None, :]
    mask_w = (dist_w >= 0) & (dist_w < WINDOW) & (kpos[:, None, :] >= 0)
    bias_w = table_g[:, rel_bucket(dist_w)].transpose(1, 0, 4, 2, 3)
    logits_w = jnp.einsum('bnqgrd,bnkgd->bngrqk', qw, kwin).astype(jnp.float32) + bias_w
    p_w = masked_softmax(logits_w, mask_w[:, None, None])
    o_win = jnp.einsum('bngrqk,bnkgd->bnqgrd', p_w.astype(vwin.dtype), vwin)
    o_win = o_win.reshape(bsz, L, KV_HEADS, Q_PER_KV, HEAD_DIM)

    g = jax.nn.sigmoid(gate_logits.reshape(bsz, L, KV_HEADS, Q_PER_KV, 3))
    o = g[..., 0:1] * o_cmp + g[..., 1:2] * o_slc + g[..., 2:3] * o_win
    return o.reshape(bsz, L, NSA_WIDTH)


def setup_inputs(seed: int = 0) -> dict:
    key = jax.random.key(seed)
    ks = jax.random.split(key, 26)
    nrm = jax.random.normal
    f32 = jnp.float32
    x = nrm(ks[0], (BATCH, SEQ, D_MODEL), f32)
    norm1_w = 1.0 + 0.01 * nrm(ks[1], (DEPTH, D_MODEL), f32)
    w_in = nrm(ks[2], (DEPTH, D_MODEL, D_IN), f32) * D_MODEL ** -0.5
    ssm_a_re = -0.5 * jnp.exp(0.02 * nrm(ks[3], (DEPTH, SSM_GROUPS, SSM_STATE), f32))
    ssm_a_im = (math.pi * jnp.arange(SSM_STATE, dtype=f32))[None, None, :] + 0.01 * nrm(ks[4], (DEPTH, SSM_GROUPS, SSM_STATE), f32)
    ssm_log_dt = jax.random.uniform(ks[5], (DEPTH, SSM_GROUPS), f32, math.log(1e-3), math.log(1e-1))
    ssm_b_re = nrm(ks[6], (DEPTH, SSM_GROUPS, SSM_STATE, SSM_GROUP), f32) * (2 * SSM_GROUP) ** -0.5
    ssm_b_im = nrm(ks[7], (DEPTH, SSM_GROUPS, SSM_STATE, SSM_GROUP), f32) * (2 * SSM_GROUP) ** -0.5
    ssm_c_re = nrm(ks[8], (DEPTH, SSM_GROUPS, SSM_GROUP, SSM_STATE), f32) * (2 * SSM_STATE) ** -0.5
    ssm_c_im = nrm(ks[9], (DEPTH, SSM_GROUPS, SSM_GROUP, SSM_STATE), f32) * (2 * SSM_STATE) ** -0.5
    ssm_d = nrm(ks[10], (DEPTH, SSM_GROUPS, SSM_GROUP), f32)
    w_glu = nrm(ks[11], (DEPTH, SSM_WIDTH, SSM_WIDTH), f32) * SSM_WIDTH ** -0.5
    b_glu = 0.01 * nrm(ks[12], (DEPTH, SSM_WIDTH), f32)
    pe_ck = 0.1 * nrm(ks[13], (DEPTH, CMP_BLOCK, HEAD_DIM), f32)
    w_ck1 = nrm(ks[14], (DEPTH, CMP_BLOCK * HEAD_DIM, CMP_HIDDEN), f32) * (CMP_BLOCK * HEAD_DIM) ** -0.5
    w_ck2 = nrm(ks[15], (DEPTH, CMP_HIDDEN, HEAD_DIM), f32) * CMP_HIDDEN ** -0.5
    pe_cv = 0.1 * nrm(ks[16], (DEPTH, CMP_BLOCK, HEAD_DIM), f32)
    w_cv1 = nrm(ks[17], (DEPTH, CMP_BLOCK * HEAD_DIM, CMP_HIDDEN), f32) * (CMP_BLOCK * HEAD_DIM) ** -0.5
    w_cv2 = nrm(ks[18], (DEPTH, CMP_HIDDEN, HEAD_DIM), f32) * CMP_HIDDEN ** -0.5
    w_out = nrm(ks[19], (DEPTH, D_MIX, D_MODEL), f32) * D_MIX ** -0.5
    norm2_w = 1.0 + 0.01 * nrm(ks[20], (DEPTH, D_MODEL), f32)
    w_up = nrm(ks[21], (DEPTH, D_MODEL, D_FF), f32) * D_MODEL ** -0.5
    w_down = nrm(ks[22], (DEPTH, D_FF, D_MODEL), f32) * D_FF ** -0.5
    rel_table = 0.5 * nrm(ks[23], (REL_BUCKETS, NSA_HEADS), f32)
    norm_f_w = 1.0 + 0.01 * nrm(ks[24], (D_MODEL,), f32)
    return {"x": x, "norm1_w": norm1_w, "w_in": w_in, "ssm_a_re": ssm_a_re, "ssm_a_im": ssm_a_im,
            "ssm_log_dt": ssm_log_dt, "ssm_b_re": ssm_b_re, "ssm_b_im": ssm_b_im, "ssm_c_re": ssm_c_re,
            "ssm_c_im": ssm_c_im, "ssm_d": ssm_d, "w_glu": w_glu, "b_glu": b_glu, "pe_ck": pe_ck,
            "w_ck1": w_ck1, "w_ck2": w_ck2, "pe_cv": pe_cv, "w_cv1": w_cv1, "w_cv2": w_cv2,
            "w_out": w_out, "norm2_w": norm2_w, "w_up": w_up, "w_down": w_down,
            "rel_table": rel_table, "norm_f_w": norm_f_w}


def reference(x, norm1_w, w_in, ssm_a_re, ssm_a_im, ssm_log_dt, ssm_b_re, ssm_b_im, ssm_c_re, ssm_c_im,
              ssm_d, w_glu, b_glu, pe_ck, w_ck1, w_ck2, pe_cv, w_cv1, w_cv2, w_out, norm2_w, w_up, w_down,
              rel_table, norm_f_w):
    sizes = [SSM_WIDTH, NSA_WIDTH] + [KV_WIDTH] * 6
    offsets = np.cumsum(sizes).tolist()
    for l in range(DEPTH):
        h = rmsnorm(x, norm1_w[l])
        proj = h @ w_in[l]
        u, q, kc, vc, ks_, vs_, kw, vw, gl = jnp.split(proj, offsets, axis=-1)
        y_ssm = s5_mixer(u, ssm_a_re[l], ssm_a_im[l], ssm_log_dt[l], ssm_b_re[l], ssm_b_im[l],
                         ssm_c_re[l], ssm_c_im[l], ssm_d[l], w_glu[l], b_glu[l])
        y_nsa = nsa_mixer(q, kc, vc, ks_, vs_, kw, vw, gl, pe_ck[l], w_ck1[l], w_ck2[l],
                          pe_cv[l], w_cv1[l], w_cv2[l], rel_table)
        x = x + jnp.concatenate([y_ssm, y_nsa], axis=-1) @ w_out[l]
        h = rmsnorm(x, norm2_w[l])
        x = x + jnp.square(jax.nn.relu(h @ w_up[l])) @ w_down[l]
    return rmsnorm(x, norm_f_w)
```

```cpp
#include <hip/hip_runtime.h>
#include <cstdio>
#include <cstdint>

#ifndef MK_N_LAUNCHES
#define MK_N_LAUNCHES 1
#endif

#define LAS __attribute__((address_space(3)))
#define GAS __attribute__((address_space(1)))
typedef unsigned short bf16_t;
typedef short bf16x8 __attribute__((ext_vector_type(8)));
typedef float f32x2 __attribute__((ext_vector_type(2)));
typedef float f32x4 __attribute__((ext_vector_type(4)));
typedef float f32x16 __attribute__((ext_vector_type(16)));
typedef unsigned u32x2 __attribute__((ext_vector_type(2)));
typedef unsigned u32x4 __attribute__((ext_vector_type(4)));
typedef __bf16 bf16x2_t __attribute__((ext_vector_type(2)));

#define LDS_WAIT() asm volatile("s_waitcnt lgkmcnt(0)" ::: "memory")
#define VM_WAIT() asm volatile("s_waitcnt vmcnt(0)" ::: "memory")

constexpr int BATCH = 4, SEQ = 4096, DM = 2048, MTOK = BATCH * SEQ, DFF = 8192;
constexpr int D_IN = 3632, NPROJ = 3840;
constexpr int COL_U = 0, COL_Q = 1024, COL_KC = 2048, COL_VC = 2304, COL_KS = 2560, COL_VS = 2816, COL_KW = 3072, COL_VW = 3328, COL_GL = 3584;
constexpr float EPS = 1e-6f;
constexpr float LOG2E = 1.4426950408889634f;
constexpr float C2 = 0.125f * LOG2E;
constexpr int NWAVES = 8;

constexpr size_t MiB = 1u << 20;
constexpr size_t WS_CTL = 0, CTL_ZERO_BYTES = 1 * MiB;
constexpr int CW_BAR = 4096;
constexpr size_t CTL_SS1 = 256 * 1024, CTL_SS2 = 512 * 1024, CTL_CB = 768 * 1024;
constexpr size_t WS_R1 = 1 * MiB, WS_BTAB = 1 * MiB + 64 * 1024, WS_S5AB = 1 * MiB + 128 * 1024, WS_CBP = 1 * MiB + 256 * 1024  , WS_CBF = 1 * MiB + 384 * 1024  ;
constexpr size_t WS_BRE = 2 * MiB, WS_BIM = 2 * MiB + 128 * 1024, WS_CM = 2 * MiB + 256 * 1024;
constexpr size_t WS_SEG = 3 * MiB;
constexpr size_t WS_WIN = 4 * MiB, WS_WGLU = 19 * MiB, WS_WOUT = 21 * MiB, WS_WUP = 29 * MiB, WS_WDOWN = 61 * MiB, WS_WC1K = 93 * MiB, WS_WC1V = 94 * MiB,
                 WS_WC2K = 95 * MiB, WS_WC2V = 95 * MiB + 64 * 1024;
constexpr size_t WS_X1B = 100 * MiB, WS_MIX = 164 * MiB, WS_HID = 228 * MiB;
constexpr size_t WS_XB = 228 * MiB, WS_PROJ = 292 * MiB, WS_Z = 412 * MiB, WS_HC = 444 * MiB, WS_KCMP = 448 * MiB, WS_VCMP = 448 * MiB + 512 * 1024;
constexpr size_t WS_END = 484 * MiB;

constexpr int LDS_BYTES = 147456;
constexpr int MISC_OFF = 135168 + 4096;

__device__ __forceinline__ unsigned f2bf(float f) { unsigned u = __builtin_bit_cast(unsigned, f); return (u + 0x7fffu + ((u >> 16) & 1u)) >> 16; }
__device__ __forceinline__ unsigned pk2(float lo, float hi) { f32x2 v = {lo, hi}; bf16x2_t b = __builtin_convertvector(v, bf16x2_t); return __builtin_bit_cast(unsigned, b); }
__device__ __forceinline__ float bf2f(unsigned b) { return __builtin_bit_cast(float, b << 16); }
__device__ __forceinline__ float bflo(unsigned w) { return __builtin_bit_cast(float, w << 16); }
__device__ __forceinline__ float bfhi(unsigned w) { return __builtin_bit_cast(float, w & 0xffff0000u); }
__device__ __forceinline__ float fexp2(float x) { return __builtin_amdgcn_exp2f(x); }
__device__ __forceinline__ float frcp(float x) { return __builtin_amdgcn_rcpf(x); }
__device__ __forceinline__ float sigmoidf_(float x) { return frcp(1.f + fexp2(-x * LOG2E)); }
__device__ __forceinline__ float gelu_tanh(float x) {
    const float u = 0.7978845608028654f * (x + 0.044715f * x * x * x);
    return x * frcp(1.f + fexp2(-2.f * LOG2E * u));
}
__device__ __forceinline__ int crow(int r, int hi) { return (r & 3) + 8 * (r >> 2) + 4 * hi; }
__device__ __forceinline__ float wave_sum(float v) {
#pragma unroll
    for (int o = 1; o < 64; o <<= 1) v += __shfl_xor(v, o);
    return v;
}
__device__ __forceinline__ float pair_max(float v) {
    unsigned a = __builtin_bit_cast(unsigned, v), b = a; asm volatile("" : "+v"(b));
    auto rr = __builtin_amdgcn_permlane32_swap(a, b, false, false);
    unsigned r0 = rr[0], r1 = rr[1]; asm volatile("" : "+v"(r0), "+v"(r1));
    return fmaxf(__builtin_bit_cast(float, r0), __builtin_bit_cast(float, r1));
}
__device__ __forceinline__ float pair_sum(float v) {
    unsigned a = __builtin_bit_cast(unsigned, v), b = a; asm volatile("" : "+v"(b));
    auto rr = __builtin_amdgcn_permlane32_swap(a, b, false, false);
    unsigned r0 = rr[0], r1 = rr[1]; asm volatile("" : "+v"(r0), "+v"(r1));
    return __builtin_bit_cast(float, r0) + __builtin_bit_cast(float, r1);
}

__device__ const unsigned char T5B[128] = {0, 1, 2, 3, 4, 5, 6, 7, 8, 9, 10, 11, 12, 13, 14, 15, 16, 16, 16, 17, 17, 18, 18, 18, 19, 19, 19, 20, 20, 20, 20, 21, 21, 21, 21, 22, 22, 22, 22, 22, 23, 23, 23, 23, 23, 23,
    24, 24, 24, 24, 24, 24, 25, 25, 25, 25, 25, 25, 25, 26, 26, 26, 26, 26, 26, 26, 26, 27, 27, 27, 27, 27, 27, 27, 27, 27, 27, 28, 28, 28, 28, 28, 28, 28, 28, 28, 28, 29, 29, 29, 29, 29, 29, 29, 29, 29, 29, 29, 29,
    30, 30, 30, 30, 30, 30, 30, 30, 30, 30, 30, 30, 30, 30, 31, 31, 31, 31, 31, 31, 31, 31, 31, 31, 31, 31, 31, 31, 31};

namespace pg8 {
constexpr int BM = 256, BK = 64, HALF = 128, HTB = HALF * BK * 2, STAGE_BYTES = 8 * HTB, NXCD = 8, WGM = 8;
__host__ __device__ __forceinline__ int lds_byte(int r, int c) { const int st = (r >> 4) * 2 + (c >> 5), rr = r & 15, cc = c & 31, ob = rr * 64 + cc * 2; return st * 1024 + (ob ^ (((ob >> 9) & 1) << 5)); }
__host__ __device__ __forceinline__ void stage_rc(int b, int& R, int& C) { const int st = b / 1024, sb = b % 1024, swz = sb ^ (((sb >> 9) & 1) << 5); R = (st >> 1) * 16 + swz / 64; C = (st & 1) * 32 + (swz % 64) / 2; }
__host__ __device__ __forceinline__ int perm32(int rho) { const int n = rho >> 4, i = rho & 15; return 8 * (i >> 2) + 4 * n + (i & 3); }

struct Unit { int pm, pn; };
struct Gemm { const bf16_t* A; const bf16_t* Bt; int M, N, K; int lda; int a_kstep; int amode; };
__device__ __forceinline__ const char* a_base(const Gemm& g, int pm) {
    if (g.amode == 0) return (const char*)g.A + (size_t)pm * (size_t)BM * (size_t)g.lda * 2;
    return (const char*)g.A + ((size_t)(pm >> 2) * SEQ * NPROJ + (size_t)(pm & 3) * 64) * 2;
}

struct StaticOrder {
    int nM, nN, nwg, G, c;
    __host__ __device__ void init(int M, int N, int G_, int c_) { nM = M / BM; nN = N / BM; nwg = nM * nN; G = G_; c = c_; }
    __host__ __device__ bool next(int i, Unit& u) const {
        const long L = (long)i * G + c; if (L >= nwg) return false;
        int wgid = (int)L; { const int q = nwg / NXCD, r = nwg % NXCD, xcd = wgid % NXCD, off = wgid / NXCD; wgid = (xcd < r ? xcd * (q + 1) : r * (q + 1) + (xcd - r) * q) + off; }
        const int nig = WGM * nN, gid = wgid / nig, fm = gid * WGM, gsz = (nM - fm) < WGM ? (nM - fm) : WGM;
        u.pm = fm + ((wgid % nig) % gsz); u.pn = (wgid % nig) / gsz; return true;
    }
};

typedef f32x4 Acc[2][2][4][2];

template <class Epi, class Sched, bool ALIGN_EPI = true>
__device__ __forceinline__ void gemm_phase(LAS unsigned char* lds, const Gemm g, const Sched& S, const Epi& E) {
    const int tid = threadIdx.x, wid = __builtin_amdgcn_readfirstlane(tid >> 6), lane = tid & 63, wr = wid >> 2, wc = wid & 3, fr = lane & 15, fq = lane >> 4;
    const int K = g.K, nt = K / BK;
    unsigned voffA[2], voffB[2];
#pragma unroll
    for (int i = 0; i < 2; ++i) { int R, C; stage_rc(tid * 16 + i * 8192, R, C); const int Rb = (R & ~31) + perm32(R & 31);
        voffA[i] = (unsigned)(R * g.lda + C) * 2u; voffB[i] = (unsigned)(Rb * K + C) * 2u; }
    const size_t kstepA = (size_t)g.a_kstep, kstepB = (size_t)(BK * 2);
    const size_t hstepA = (size_t)HALF * g.lda * 2, hstepB = (size_t)HALF * K * 2;
    const size_t tstepB = 2 * hstepB;
    const unsigned ldsw = (unsigned)wid * 1024u;
    const int aoff = lds_byte(wr * 64 + fr, fq * 8), boff = lds_byte(wc * 32 + fr, fq * 8);
#define PG8_SA(b, h) (((b) * 2 + (h)) * HTB)
#define PG8_SB(b, h) ((4 + (b) * 2 + (h)) * HTB)
#define PG8_STAGE(bufoff, gbase, voff) do { _Pragma("unroll") for (int _i = 0; _i < 2; ++_i) \
        __builtin_amdgcn_global_load_lds((const unsigned*)((const char*)(gbase) + (voff)[_i]), (LAS unsigned*)(lds + (bufoff) + ldsw + _i * 8192), 16, 0, 0); } while (0)
#define PG8_LDA(dst, b, h) do { _Pragma("unroll") for (int m = 0; m < 4; ++m) _Pragma("unroll") for (int k = 0; k < 2; ++k) dst[m][k] = *(const LAS bf16x8*)(lds + PG8_SA(b, h) + aoff + m * 2048 + k * 1024); } while (0)
#define PG8_LDB(dst, b, h) do { _Pragma("unroll") for (int n = 0; n < 2; ++n) _Pragma("unroll") for (int k = 0; k < 2; ++k) dst[n][k] = *(const LAS bf16x8*)(lds + PG8_SB(b, h) + boff + n * 2048 + k * 1024); } while (0)
#define PG8_MMA(ai, bj, At, Bt) do { __builtin_amdgcn_s_setprio(1); _Pragma("unroll") for (int m = 0; m < 4; ++m) _Pragma("unroll") for (int n = 0; n < 2; ++n) _Pragma("unroll") for (int k = 0; k < 2; ++k) \
        acc[ai][bj][m][n] = __builtin_amdgcn_mfma_f32_16x16x32_bf16(Bt[n][k], At[m][k], acc[ai][bj][m][n], 0, 0, 0); __builtin_amdgcn_s_setprio(0); } while (0)
#define PG8_WAIT_V(n) asm volatile("s_waitcnt vmcnt(" #n ")" ::: "memory")
#define PG8_WAIT_L(n) asm volatile("s_waitcnt lgkmcnt(" #n ")" ::: "memory")
#define PG8_BAR __builtin_amdgcn_s_barrier()
#define PG8_SCHED __builtin_amdgcn_sched_barrier(0)
    Unit cur, nxt; int ui = 0;
    if (!S.next(0, cur)) return;
    f32x4 acc[2][2][4][2];
#pragma unroll
    for (int a = 0; a < 2; ++a)
#pragma unroll
        for (int b = 0; b < 2; ++b)
#pragma unroll
            for (int m = 0; m < 4; ++m)
#pragma unroll
                for (int n = 0; n < 2; ++n) acc[a][b][m][n] = (f32x4){0.f, 0.f, 0.f, 0.f};
    bf16x8 At[4][2], B0[2][2], B1[2][2];
    const char* cA = a_base(g, cur.pm); const char* cB = (const char*)g.Bt + (size_t)cur.pn * tstepB;
    PG8_STAGE(PG8_SB(0, 0), cB, voffB); PG8_STAGE(PG8_SB(0, 1), cB + hstepB, voffB); PG8_STAGE(PG8_SA(0, 0), cA, voffA); PG8_STAGE(PG8_SA(0, 1), cA + hstepA, voffA);
    if (wr == 1) PG8_BAR;
    PG8_WAIT_V(2); PG8_BAR;
    PG8_STAGE(PG8_SB(1, 0), cB + kstepB, voffB); PG8_STAGE(PG8_SA(1, 0), cA + kstepA, voffA); PG8_STAGE(PG8_SB(1, 1), cB + hstepB + kstepB, voffB);
    PG8_WAIT_V(6); PG8_BAR;
    for (;;) {
        const bool has_next = S.next(ui + 1, nxt);
        const char* nA = has_next ? a_base(g, nxt.pm) : cA; const char* nB = has_next ? (const char*)g.Bt + (size_t)nxt.pn * tstepB : cB;
        for (int t = 0; t < nt; t += 2) {
            const bool last = (t == nt - 2);
            const char* a1 = cA + (size_t)(t + 1) * kstepA;
            const char* a2 = last ? nA : cA + (size_t)(t + 2) * kstepA; const char* b2 = last ? nB : cB + (size_t)(t + 2) * kstepB;
            const char* a3 = a2 + kstepA; const char* b3 = b2 + kstepB;
            PG8_LDB(B0, 0, 0); PG8_LDB(B1, 0, 1); PG8_SCHED; PG8_LDA(At, 0, 0); PG8_STAGE(PG8_SA(1, 1), a1 + hstepA, voffA);
            PG8_WAIT_V(8); PG8_WAIT_L(0); PG8_BAR; PG8_MMA(0, 0, At, B0); PG8_MMA(0, 1, At, B1); PG8_BAR; PG8_SCHED;
            PG8_LDA(At, 0, 1); PG8_STAGE(PG8_SB(0, 0), b2, voffB); PG8_STAGE(PG8_SB(0, 1), b2 + hstepB, voffB); PG8_STAGE(PG8_SA(0, 0), a2, voffA);
            PG8_WAIT_V(8); PG8_WAIT_L(0); PG8_BAR; PG8_MMA(1, 0, At, B0); PG8_MMA(1, 1, At, B1); PG8_BAR; PG8_SCHED;
            PG8_LDB(B0, 1, 0); PG8_LDB(B1, 1, 1); PG8_SCHED; PG8_LDA(At, 1, 0); PG8_STAGE(PG8_SA(0, 1), a2 + hstepA, voffA);
            PG8_WAIT_V(8); PG8_WAIT_L(0); PG8_BAR; PG8_MMA(0, 0, At, B0); PG8_MMA(0, 1, At, B1); PG8_BAR; PG8_SCHED;
            PG8_LDA(At, 1, 1); PG8_STAGE(PG8_SB(1, 0), b3, voffB); PG8_STAGE(PG8_SB(1, 1), b3 + hstepB, voffB); PG8_STAGE(PG8_SA(1, 0), a3, voffA);
            PG8_WAIT_V(8); PG8_WAIT_L(0); PG8_BAR; PG8_MMA(1, 0, At, B0); PG8_MMA(1, 1, At, B1); PG8_BAR; PG8_SCHED;
        }
        if constexpr (ALIGN_EPI) { if (wr == 0) PG8_BAR; }
        E(acc, cur, wr, wc, fr, fq);
        if (!has_next) break;
#pragma unroll
        for (int a = 0; a < 2; ++a)
#pragma unroll
            for (int b = 0; b < 2; ++b)
#pragma unroll
                for (int m = 0; m < 4; ++m)
#pragma unroll
                    for (int n = 0; n < 2; ++n) acc[a][b][m][n] = (f32x4){0.f, 0.f, 0.f, 0.f};
        cur = nxt; cA = nA; cB = nB; ++ui;
        if constexpr (ALIGN_EPI) { if (wr == 1) PG8_BAR; }
    }
    PG8_WAIT_V(0);
    if constexpr (!ALIGN_EPI) { if (wr == 0) PG8_BAR; }
    PG8_BAR;
#undef PG8_SA
#undef PG8_SB
#undef PG8_STAGE
#undef PG8_LDA
#undef PG8_LDB
#undef PG8_MMA
#undef PG8_WAIT_V
#undef PG8_WAIT_L
#undef PG8_BAR
#undef PG8_SCHED
}

#define EPI_ROWS_BEGIN const int row0 = u.pm * BM + wr * 64 + fr; const int col0 = u.pn * BM + wc * 32 + 8 * fq; \
    _Pragma("unroll") for (int ai = 0; ai < 2; ++ai) _Pragma("unroll") for (int m = 0; m < 4; ++m) { const int row = row0 + ai * HALF + m * 16;
#define EPI_ROWS_END }

struct EpiProj {
    bf16_t* O; const float* r1;
    __device__ __forceinline__ void operator()(const Acc& acc, const Unit& u, int wr, int wc, int fr, int fq) const {
        const float sc = (u.pn >= 4 && u.pn < 8) ? C2 : 1.f;
        EPI_ROWS_BEGIN
            const float rs = r1[row] * sc; bf16_t* rowp = O + (size_t)row * NPROJ + col0;
#pragma unroll
            for (int bj = 0; bj < 2; ++bj) { const f32x4 v0 = acc[ai][bj][m][0] * rs, v1 = acc[ai][bj][m][1] * rs;
                u32x4 w; w.x = pk2(v0[0], v0[1]); w.y = pk2(v0[2], v0[3]); w.z = pk2(v1[0], v1[1]); w.w = pk2(v1[2], v1[3]);
                *(u32x4*)(rowp + bj * HALF) = w; }
        EPI_ROWS_END
    }
};
struct EpiCmp {
    bf16_t* O; const float* bias;
    __device__ __forceinline__ void operator()(const Acc& acc, const Unit& u, int wr, int wc, int fr, int fq) const {
        const int bc = wc * 32 + 8 * fq;
        f32x4 bv[2][2];
#pragma unroll
        for (int bj = 0; bj < 2; ++bj)
#pragma unroll
            for (int n = 0; n < 2; ++n) bv[bj][n] = *(const f32x4*)(bias + bc + bj * HALF + 4 * n);
        EPI_ROWS_BEGIN
            bf16_t* rowp = O + (size_t)row * 256 + col0;
#pragma unroll
            for (int bj = 0; bj < 2; ++bj) { const f32x4 v0 = acc[ai][bj][m][0] + bv[bj][0], v1 = acc[ai][bj][m][1] + bv[bj][1];
                u32x4 w; w.x = pk2(gelu_tanh(v0[0]), gelu_tanh(v0[1])); w.y = pk2(gelu_tanh(v0[2]), gelu_tanh(v0[3])); w.z = pk2(gelu_tanh(v1[0]), gelu_tanh(v1[1])); w.w = pk2(gelu_tanh(v1[2]), gelu_tanh(v1[3]));
                *(u32x4*)(rowp + bj * HALF) = w; }
        EPI_ROWS_END
    }
};
struct EpiGlu {
    bf16_t* O; const bf16_t* Z; const float* bias;
    __device__ __forceinline__ void operator()(const Acc& acc, const Unit& u, int wr, int wc, int fr, int fq) const {
        f32x4 bv[2][2];
#pragma unroll
        for (int bj = 0; bj < 2; ++bj)
#pragma unroll
            for (int n = 0; n < 2; ++n) bv[bj][n] = *(const f32x4*)(bias + u.pn * BM + wc * 32 + 8 * fq + bj * HALF + 4 * n);
        EPI_ROWS_BEGIN
            bf16_t* rowp = O + (size_t)row * DM + col0; const bf16_t* zp = Z + (size_t)row * 1024 + col0;
#pragma unroll
            for (int bj = 0; bj < 2; ++bj) { const f32x4 v0 = acc[ai][bj][m][0] + bv[bj][0], v1 = acc[ai][bj][m][1] + bv[bj][1];
                const u32x4 zz = *(const u32x4*)(zp + bj * HALF);
                u32x4 w; w.x = pk2(bflo(zz.x) * sigmoidf_(v0[0]), bfhi(zz.x) * sigmoidf_(v0[1])); w.y = pk2(bflo(zz.y) * sigmoidf_(v0[2]), bfhi(zz.y) * sigmoidf_(v0[3]));
                w.z = pk2(bflo(zz.z) * sigmoidf_(v1[0]), bfhi(zz.z) * sigmoidf_(v1[1])); w.w = pk2(bflo(zz.w) * sigmoidf_(v1[2]), bfhi(zz.w) * sigmoidf_(v1[3]));
                *(u32x4*)(rowp + bj * HALF) = w; }
        EPI_ROWS_END
    }
};
struct EpiRes {
    const float* base; float* out; bf16_t* ob; float* ss;
    __device__ __forceinline__ void operator()(const Acc& acc, const Unit& u, int wr, int wc, int fr, int fq) const {
        EPI_ROWS_BEGIN
            const size_t off = (size_t)row * DM + col0; float q = 0.f;
#pragma unroll
            for (int bj = 0; bj < 2; ++bj) { const f32x4 b0 = *(const f32x4*)(base + off + bj * HALF), b1 = *(const f32x4*)(base + off + bj * HALF + 4);
                const f32x4 v0 = acc[ai][bj][m][0] + b0, v1 = acc[ai][bj][m][1] + b1;
                *(f32x4*)(out + off + bj * HALF) = v0; *(f32x4*)(out + off + bj * HALF + 4) = v1;
                q += (v0[0] * v0[0] + v0[1] * v0[1]) + (v0[2] * v0[2] + v0[3] * v0[3]) + (v1[0] * v1[0] + v1[1] * v1[1]) + (v1[2] * v1[2] + v1[3] * v1[3]);
                if (ob) { u32x4 w; w.x = pk2(v0[0], v0[1]); w.y = pk2(v0[2], v0[3]); w.z = pk2(v1[0], v1[1]); w.w = pk2(v1[2], v1[3]); *(u32x4*)(ob + off + bj * HALF) = w; } }
            q += __shfl_xor(q, 16); q += __shfl_xor(q, 32);
            if (fq == 0) atomicAdd(ss + row, q);
        EPI_ROWS_END
    }
};
struct EpiUp {
    bf16_t* O; const float* ss;
    __device__ __forceinline__ void operator()(const Acc& acc, const Unit& u, int wr, int wc, int fr, int fq) const {
        EPI_ROWS_BEGIN
            const float rs = __builtin_amdgcn_rsqf(ss[row] * (1.f / DM) + EPS); bf16_t* rowp = O + (size_t)row * DFF + col0;
#pragma unroll
            for (int bj = 0; bj < 2; ++bj) { f32x4 v0 = acc[ai][bj][m][0] * rs, v1 = acc[ai][bj][m][1] * rs;
#pragma unroll
                for (int e = 0; e < 4; ++e) { const float a = fmaxf(v0[e], 0.f), b = fmaxf(v1[e], 0.f); v0[e] = a * a; v1[e] = b * b; }
                u32x4 w; w.x = pk2(v0[0], v0[1]); w.y = pk2(v0[2], v0[3]); w.z = pk2(v1[0], v1[1]); w.w = pk2(v1[2], v1[3]);
                *(u32x4*)(rowp + bj * HALF) = w; }
        EPI_ROWS_END
    }
};
}

typedef GAS unsigned gu32;
#define RLX_AGENT __ATOMIC_RELAXED, __HIP_MEMORY_SCOPE_AGENT
#define XB_TMO      128
#define XB_XCNT(j)  (256  + 64 * (j))
#define XB_XSUB(j)  (1280 + 64 * (j))
#define XB_XGEN(j)  (2304 + 64 * (j))
#define XB_TOP      3328
#define XB_TOPGEN   3392
#define XCD_BAR_WORDS 3456
#define XB_SPIN_CAP (1u << 22)
__device__ __forceinline__ unsigned xb_ld(unsigned* p)              { return __hip_atomic_load(p, __ATOMIC_RELAXED, __HIP_MEMORY_SCOPE_AGENT); }
__device__ __forceinline__ unsigned xb_add(unsigned* p, unsigned v) { return __hip_atomic_fetch_add(p, v, __ATOMIC_RELAXED, __HIP_MEMORY_SCOPE_AGENT); }
__device__ __forceinline__ unsigned xb_xcc_id() { return (unsigned)__builtin_amdgcn_s_getreg((3 << 11) | 20) & 0xFu; }
#define XB_SPIN(cond, bar) do { unsigned _sp = 0; while (cond) { __builtin_amdgcn_s_sleep(1); \
    if ((++_sp & 255u) == 0u) { if (xb_ld(&(bar)[XB_TMO])) break; if (_sp > XB_SPIN_CAP) { atomicAdd(&(bar)[XB_TMO], 1u); break; } } } } while (0)
struct XcdBarrier { unsigned* bar; unsigned x; volatile LAS unsigned* st; };
__device__ __forceinline__ XcdBarrier xcd_barrier_post(unsigned* bar, volatile LAS unsigned* st) {
    XcdBarrier b; b.bar = bar; b.x = xb_xcc_id(); b.st = st;
    if (threadIdx.x == 0) (void)xb_add(&bar[XB_XCNT(b.x)], 1u);
    return b;
}
__device__ __forceinline__ void xcd_barrier_complete(unsigned* bar, unsigned x, unsigned& nloc, unsigned& nx) {
    const unsigned G = gridDim.x * gridDim.y * gridDim.z;
    unsigned sum, cnt, mine, sp = 0u;
    for (;;) {
        sum = 0u; cnt = 0u; mine = 0u;
#pragma unroll
        for (unsigned j = 0; j < 16; ++j) { const unsigned c = xb_ld(&bar[XB_XCNT(j)]); sum += c; cnt += (c > 0u) ? 1u : 0u; mine = (j == x) ? c : mine; }
        if (sum == G) break;
        __builtin_amdgcn_s_sleep(1);
        if ((++sp & 255u) == 0u) { if (xb_ld(&bar[XB_TMO])) break; if (sp > XB_SPIN_CAP) { atomicAdd(&bar[XB_TMO], 1u); break; } }
    }
    nloc = mine > 0u ? mine : 1u; nx = cnt > 0u ? cnt : 1u;
}
__device__ __forceinline__ void xcd_barrier(const XcdBarrier& b) {
    asm volatile("s_waitcnt vmcnt(0)" ::: "memory");
    __syncthreads();
    if (threadIdx.x == 0) {
        unsigned* bar = b.bar;
        __builtin_amdgcn_s_waitcnt(0);
        unsigned nloc = b.st[0], nx = b.st[1];
        if (nloc == 0u) { xcd_barrier_complete(bar, b.x, nloc, nx); b.st[0] = nloc; b.st[1] = nx; }
        const unsigned old = xb_add(&bar[XB_XSUB(b.x)], 1u);
        const unsigned gen = old / nloc;
        if (old + 1u == (gen + 1u) * nloc) {
            __builtin_amdgcn_fence(__ATOMIC_RELEASE, "agent");
            asm volatile("s_waitcnt vmcnt(0)" ::: "memory");
            const unsigned og = xb_add(&bar[XB_TOP], 1u);
            const unsigned tg = og / nx;
            if (og + 1u == (tg + 1u) * nx) xb_add(&bar[XB_TOPGEN], 1u);
            else XB_SPIN(xb_ld(&bar[XB_TOPGEN]) == tg, bar);
            __builtin_amdgcn_fence(__ATOMIC_ACQUIRE, "agent");
            xb_add(&bar[XB_XGEN(b.x)], 1u);
            asm volatile("s_waitcnt vmcnt(0)" ::: "memory");
        } else {
            XB_SPIN(xb_ld(&bar[XB_XGEN(b.x)]) == gen, bar);
            __builtin_amdgcn_fence(__ATOMIC_ACQUIRE, "agent");
            asm volatile("s_waitcnt vmcnt(0)" ::: "memory");
        }
    }
    __syncthreads();
}

struct Args { const float* in[25]; float* out; unsigned char* ws; int ph_lo, ph_hi; };
struct Frame {
    LAS unsigned char* lds;
    int tid, lane, wave, vcu, G;
    const Args* a; float* out; unsigned char* ws;
};
enum { I_X = 0, I_N1W, I_WIN, I_ARE, I_AIM, I_LOGDT, I_BRE, I_BIM, I_CRE, I_CIM, I_D, I_WGLU, I_BGLU, I_PECK, I_WCK1, I_WCK2, I_PECV, I_WCV1, I_WCV2, I_WOUT, I_N2W, I_WUP, I_WDOWN, I_REL, I_NFW };

__device__ __forceinline__ void p0_transpose_item(const float* W, int K, int N, int Npad, bf16_t* WT, const float* scale, LAS float* scr, int item, int lane) {
    const int nblk = Npad / 32, kb = item / nblk, nb = item % nblk, k0 = 64 * kb, n0 = 32 * nb;
    const int n = n0 + (lane & 31);
#pragma unroll 8
    for (int i = 0; i < 32; ++i) { const int kk = 2 * i + (lane >> 5); float v = 0.f; if (n < N) { v = W[(size_t)(k0 + kk) * N + n]; if (scale) v *= scale[k0 + kk]; } scr[kk * 33 + (lane & 31)] = v; }
    LDS_WAIT();
    const int c = lane & 7;
#pragma unroll
    for (int j = 0; j < 4; ++j) { const int nn = (lane >> 3) + 8 * j; const LAS float* s = scr + (8 * c) * 33 + nn;
        u32x4 o; o.x = pk2(s[0 * 33], s[1 * 33]); o.y = pk2(s[2 * 33], s[3 * 33]); o.z = pk2(s[4 * 33], s[5 * 33]); o.w = pk2(s[6 * 33], s[7 * 33]);
        *(u32x4*)(WT + (size_t)(n0 + nn) * K + k0 + 8 * c) = o; }
    LDS_WAIT();
}
__device__ __forceinline__ void p0_prologue(Frame& F) {
    LAS float* scr = (LAS float*)(F.lds + F.wave * 16384);
    const int gw = F.vcu * NWAVES + F.wave, NGW = F.G * NWAVES, lane = F.lane;
    unsigned char* ws = F.ws;
    constexpr int T_IN = (DM / 64) * (NPROJ / 32), T_GLU = (1024 / 64) * (1024 / 32), T_OUT = (DM / 64) * (DM / 32), T_UP = (DM / 64) * (DFF / 32), T_DOWN = (DFF / 64) * (DM / 32),
                  T_C1 = (2048 / 64) * (256 / 32), T_C2 = (256 / 64) * (64 / 32);
    constexpr int NITEMS = T_IN + T_GLU + T_OUT + T_UP + T_DOWN + 2 * T_C1 + 2 * T_C2;
    for (int it = gw; it < NITEMS; it += NGW) {
        int r = it;
        if (r < T_UP) { p0_transpose_item(F.a->in[I_WUP], DM, DFF, DFF, (bf16_t*)(ws + WS_WUP), F.a->in[I_N2W], scr, r, lane); continue; } r -= T_UP;
        if (r < T_DOWN) { p0_transpose_item(F.a->in[I_WDOWN], DFF, DM, DM, (bf16_t*)(ws + WS_WDOWN), nullptr, scr, r, lane); continue; } r -= T_DOWN;
        if (r < T_IN) { p0_transpose_item(F.a->in[I_WIN], DM, D_IN, NPROJ, (bf16_t*)(ws + WS_WIN), F.a->in[I_N1W], scr, r, lane); continue; } r -= T_IN;
        if (r < T_OUT) { p0_transpose_item(F.a->in[I_WOUT], DM, DM, DM, (bf16_t*)(ws + WS_WOUT), nullptr, scr, r, lane); continue; } r -= T_OUT;
        if (r < T_GLU) { p0_transpose_item(F.a->in[I_WGLU], 1024, 1024, 1024, (bf16_t*)(ws + WS_WGLU), nullptr, scr, r, lane); continue; } r -= T_GLU;
        if (r < T_C1) { p0_transpose_item(F.a->in[I_WCK1], 2048, 256, 256, (bf16_t*)(ws + WS_WC1K), nullptr, scr, r, lane); continue; } r -= T_C1;
        if (r < T_C1) { p0_transpose_item(F.a->in[I_WCV1], 2048, 256, 256, (bf16_t*)(ws + WS_WC1V), nullptr, scr, r, lane); continue; } r -= T_C1;
        if (r < T_C2) { p0_transpose_item(F.a->in[I_WCK2], 256, 64, 64, (bf16_t*)(ws + WS_WC2K), nullptr, scr, r, lane); continue; } r -= T_C2;
        p0_transpose_item(F.a->in[I_WCV2], 256, 64, 64, (bf16_t*)(ws + WS_WC2V), nullptr, scr, r, lane);
    }
    {
        const float* x = F.a->in[I_X]; bf16_t* xb = (bf16_t*)(ws + WS_XB); float* r1 = (float*)(ws + WS_R1);
        for (int mrow = gw; mrow < MTOK; mrow += NGW) {
            const f32x4* xr = (const f32x4*)(x + (size_t)mrow * DM) + lane; u32x2* o8 = (u32x2*)(xb + (size_t)mrow * DM) + lane;
            f32x4 v[8]; float s = 0.f;
#pragma unroll
            for (int j = 0; j < 8; ++j) { v[j] = xr[64 * j]; s += (v[j].x * v[j].x + v[j].y * v[j].y) + (v[j].z * v[j].z + v[j].w * v[j].w); }
            s = wave_sum(s);
#pragma unroll
            for (int j = 0; j < 8; ++j) { u32x2 w; w.x = pk2(v[j].x, v[j].y); w.y = pk2(v[j].z, v[j].w); o8[64 * j] = w; }
            if (lane == 0) r1[mrow] = __builtin_amdgcn_rsqf(s * (1.f / DM) + EPS);
        }
    }
    {
        const int idx = gw * 64 + lane;
        if (idx < 4096) {
            const int g = idx >> 6;
            const float dt = expf(F.a->in[I_LOGDT][g]); const float ar = F.a->in[I_ARE][idx], ai = F.a->in[I_AIM][idx];
            const float em1 = expm1f(dt * ar), th = dt * ai, c = cosf(th), s = sinf(th), sh = sinf(0.5f * th);
            const float mag = em1 + 1.f, abr = mag * c, abi = mag * s;
            const float zr = em1 * c - 2.f * sh * sh, zi = abi;
            const float den = ar * ar + ai * ai;
            const float cr = (zr * ar + zi * ai) / den, ci = (zi * ar - zr * ai) / den;
            const float magS = expf(512.f * dt * ar), thS = 512.f * th;
            f32x4 ab; ab.x = abr; ab.y = abi; ab.z = magS * cosf(thS); ab.w = magS * sinf(thS);
            ((f32x4*)(ws + WS_S5AB))[idx] = ab;
            bf16_t* bre = (bf16_t*)(ws + WS_BRE) + (size_t)idx * 16; bf16_t* bim = (bf16_t*)(ws + WS_BIM) + (size_t)idx * 16;
            const float* sbr = F.a->in[I_BRE] + (size_t)idx * 16; const float* sbi = F.a->in[I_BIM] + (size_t)idx * 16;
#pragma unroll
            for (int h = 0; h < 16; ++h) { const float br = sbr[h], bi = sbi[h]; bre[h] = (bf16_t)f2bf(cr * br - ci * bi); bim[h] = (bf16_t)f2bf(cr * bi + ci * br); }
        }
        const int i2 = gw * 64 + lane;
        if (i2 < 64 * 16 * 64) { bf16_t* cm = (bf16_t*)(ws + WS_CM); ((unsigned*)cm)[i2] = pk2(F.a->in[I_CRE][i2], -F.a->in[I_CIM][i2]); }
        if (i2 < 2048) { const int h = i2 >> 7, d = i2 & 127; ((float*)(ws + WS_BTAB))[i2] = F.a->in[I_REL][(int)T5B[d] * 16 + h] * LOG2E; }
    }
    for (int it = gw; it < 2 * 32 * 4; it += NGW) {
        const int which = it >> 7, ks = (it >> 2) & 31, jg = it & 3;
        const float* pe = F.a->in[which ? I_PECV : I_PECK] + ks * 64; const float* w1 = F.a->in[which ? I_WCV1 : I_WCK1] + (size_t)(ks * 64) * 256 + jg * 64 + lane;
        float a = 0.f;
#pragma unroll 16
        for (int k = 0; k < 64; ++k) a += pe[k] * w1[(size_t)k * 256];
        ((float*)(ws + WS_CBP))[(which * 32 + ks) * 256 + jg * 64 + lane] = a;
    }
    for (int idx = gw * 64 + lane; idx < MTOK; idx += NGW * 64) { ((float*)(ws + CTL_SS1))[idx] = 0.f; ((float*)(ws + CTL_SS2))[idx] = 0.f; }
}
__device__ __forceinline__ void cmp_bias_reduce(Frame& F) {
    if (blockIdx.x != 0) return;
    const float* p = (const float*)(F.ws + WS_CBP); float* o = (float*)(F.ws + WS_CBF);
    const int which = F.tid >> 8, col = F.tid & 255; float a = 0.f;
    for (int ks = 0; ks < 32; ++ks) a += p[(which * 32 + ks) * 256 + col];
    o[which * 256 + col] = a;
}

template <bool FINAL>
__device__ __forceinline__ void s5_item(Frame& F, int b, int g, int seg) {
    const int lane = F.lane, pp = lane & 31, hi = lane >> 5;
    unsigned char* ws = F.ws;
    LAS unsigned char* L = F.lds + F.wave * 16896;
    const bf16_t* proj = (const bf16_t*)(ws + WS_PROJ);
    const f32x4 ab = ((const f32x4*)(ws + WS_S5AB))[g * 64 + lane];
    const float ar = ab.x, ai = ab.y;
    const bf16_t* bre = (const bf16_t*)(ws + WS_BRE) + (size_t)g * 64 * 16; const bf16_t* bim = (const bf16_t*)(ws + WS_BIM) + (size_t)g * 64 * 16;
    const bf16x8 bre0 = *(const bf16x8*)(bre + pp * 16 + 8 * hi), bre1 = *(const bf16x8*)(bre + (32 + pp) * 16 + 8 * hi);
    const bf16x8 bim0 = *(const bf16x8*)(bim + pp * 16 + 8 * hi), bim1 = *(const bf16x8*)(bim + (32 + pp) * 16 + 8 * hi);
    f32x2* segend = (f32x2*)(ws + WS_SEG) + (size_t)((b * 64 + g) * 8) * 64;
    float sr = 0.f, si = 0.f;
    bf16x8 cf[4]; f32x4 dv = {0.f, 0.f, 0.f, 0.f};
    if (FINAL) {
        for (int s2 = 0; s2 < seg; ++s2) { const f32x2 e = segend[s2 * 64 + lane]; const float nr = ab.z * sr - ab.w * si + e.x, ni = ab.z * si + ab.w * sr + e.y; sr = nr; si = ni; }
        const bf16_t* cm = (const bf16_t*)(ws + WS_CM) + (size_t)(g * 16 + (lane & 15)) * 128 + 8 * (lane >> 4);
#pragma unroll
        for (int ks = 0; ks < 4; ++ks) cf[ks] = *(const bf16x8*)(cm + 32 * ks);
        dv = *(const f32x4*)(F.a->in[I_D] + g * 16 + 4 * (lane >> 4));
    }
    bf16_t* zb = (bf16_t*)(ws + WS_Z);
    for (int ch = 0; ch < 16; ++ch) {
        const size_t row0 = (size_t)b * SEQ + seg * 512 + ch * 32;
        const bf16x8 ua = *(const bf16x8*)(proj + (row0 + pp) * NPROJ + COL_U + g * 16 + 8 * hi);
        const f32x16 z16 = {};
        const f32x16 re0 = __builtin_amdgcn_mfma_f32_32x32x16_bf16(ua, bre0, z16, 0, 0, 0), im0 = __builtin_amdgcn_mfma_f32_32x32x16_bf16(ua, bim0, z16, 0, 0, 0);
        const f32x16 re1 = __builtin_amdgcn_mfma_f32_32x32x16_bf16(ua, bre1, z16, 0, 0, 0), im1 = __builtin_amdgcn_mfma_f32_32x32x16_bf16(ua, bim1, z16, 0, 0, 0);
#pragma unroll
        for (int r = 0; r < 16; ++r) { const int t = crow(r, hi);
            *(LAS f32x2*)(L + t * 528 + 8 * pp) = (f32x2){re0[r], im0[r]};
            *(LAS f32x2*)(L + t * 528 + 8 * (32 + pp)) = (f32x2){re1[r], im1[r]}; }
        LDS_WAIT();
#pragma unroll 8
        for (int t = 0; t < 32; ++t) {
            const f32x2 xv = *(const LAS f32x2*)(L + t * 528 + 8 * lane);
            const float nr = ar * sr - ai * si + xv.x, ni = ar * si + ai * sr + xv.y; sr = nr; si = ni;
            if (FINAL) *(LAS unsigned*)(L + t * 528 + 4 * lane) = pk2(sr, si);
        }
        if (FINAL) {
            LDS_WAIT();
#pragma unroll
            for (int tt = 0; tt < 2; ++tt) {
                f32x4 acc = {0.f, 0.f, 0.f, 0.f};
#pragma unroll
                for (int ks = 0; ks < 4; ++ks) { const bf16x8 sb = *(const LAS bf16x8*)(L + (16 * tt + (lane & 15)) * 528 + (32 * ks + 8 * (lane >> 4)) * 2);
                    acc = __builtin_amdgcn_mfma_f32_16x16x32_bf16(cf[ks], sb, acc, 0, 0, 0); }
                const size_t row = row0 + 16 * tt + (lane & 15);
                const u32x2 uu = *(const u32x2*)(proj + row * NPROJ + COL_U + g * 16 + 4 * (lane >> 4));
                const float y0 = acc[0] + dv[0] * bflo(uu.x), y1 = acc[1] + dv[1] * bfhi(uu.x), y2 = acc[2] + dv[2] * bflo(uu.y), y3 = acc[3] + dv[3] * bfhi(uu.y);
                u32x2 w; w.x = pk2(gelu_tanh(y0), gelu_tanh(y1)); w.y = pk2(gelu_tanh(y2), gelu_tanh(y3));
                *(u32x2*)(zb + row * 1024 + g * 16 + 4 * (lane >> 4)) = w;
            }
        }
        LDS_WAIT();
    }
    if (!FINAL) segend[seg * 64 + lane] = (f32x2){sr, si};
}
template <bool FINAL> __device__ __forceinline__ void s5_phase(Frame& F) {
    const int gw = F.vcu * NWAVES + F.wave, NGW = F.G * NWAVES;
    for (int it = gw; it < BATCH * 64 * 8; it += NGW) { const int g = it & 63, bs = it >> 6; s5_item<FINAL>(F, bs >> 3, g, bs & 7); }
}

__device__ __forceinline__ void cmp2_phase(Frame& F) {
    const int gw = F.vcu * NWAVES + F.wave, NGW = F.G * NWAVES, lane = F.lane, pp = lane & 31, hi = lane >> 5;
    unsigned char* ws = F.ws;
    for (int it = gw; it < 256; it += NGW) {
        const int which = it >> 7, rt = it & 127;
        const bf16_t* Hc = (const bf16_t*)(ws + WS_HC) + (size_t)which * 4096 * 256 + (size_t)(32 * rt + pp) * 256 + 8 * hi;
        const bf16_t* W2 = (const bf16_t*)(ws + (which ? WS_WC2V : WS_WC2K)) + (size_t)pp * 256 + 8 * hi;
        bf16_t* O = (bf16_t*)(ws + (which ? WS_VCMP : WS_KCMP));
        f32x16 a0 = {}, a1 = {};
#pragma unroll 4
        for (int ks = 0; ks < 16; ++ks) { const bf16x8 a = *(const bf16x8*)(Hc + 16 * ks), b0 = *(const bf16x8*)(W2 + 16 * ks), b1 = *(const bf16x8*)(W2 + 32 * 256 + 16 * ks);
            a0 = __builtin_amdgcn_mfma_f32_32x32x16_bf16(a, b0, a0, 0, 0, 0); a1 = __builtin_amdgcn_mfma_f32_32x32x16_bf16(a, b1, a1, 0, 0, 0); }
#pragma unroll
        for (int r = 0; r < 16; ++r) { const int row = 32 * rt + crow(r, hi); const bool zero = (row & 255) == 255;
            O[(size_t)row * 64 + pp] = zero ? (bf16_t)0 : (bf16_t)f2bf(a0[r]); O[(size_t)row * 64 + 32 + pp] = zero ? (bf16_t)0 : (bf16_t)f2bf(a1[r]); }
    }
}

namespace att {
constexpr int KSTR = 144, VSTR = 136;
constexpr int K_OFF = 0, V_OFF = 64 * KSTR, BIAS_OFF = V_OFF + 64 * VSTR, WSCR_OFF = BIAS_OFF + 2048, IMP_OFF = WSCR_OFF + 8 * 256, SEL_OFF = IMP_OFF + 64 * 65 * 4, OT_OFF = SEL_OFF + 512, END_OFF = OT_OFF + 8 * 8192;
constexpr float NEG = -1e30f, MFLOOR = -1e20f;
enum { CMP_A = 0, CMP_B = 1, SLC = 2, WIN = 3 };
struct TileRegs { u32x4 k, v; };
struct Ctx {
    LAS unsigned char* lds; int tid, lane, wave, q, hi, tl, head, t, i;
    bf16x8 qr[4];
};
__device__ __forceinline__ void load_tile(TileRegs& R, const bf16_t* kb, const bf16_t* vb, size_t stride, int row0, int tid) {
    const int r = tid >> 3, c = tid & 7;
    R.k = *(const u32x4*)(kb + (size_t)(row0 + r) * stride + c * 8);
    R.v = *(const u32x4*)(vb + (size_t)(row0 + r) * stride + c * 8);
}
__device__ __forceinline__ void store_tile(const TileRegs& R, LAS unsigned char* lds, int tid) {
    const int r = tid >> 3, c = tid & 7;
    *(LAS u32x4*)(lds + K_OFF + r * KSTR + c * 16) = R.k;
    LAS bf16_t* vt = (LAS bf16_t*)(lds + V_OFF) + r;
    const unsigned w[4] = {R.v.x, R.v.y, R.v.z, R.v.w};
#pragma unroll
    for (int e = 0; e < 4; ++e) { vt[(c * 8 + 2 * e) * (VSTR / 2)] = (bf16_t)(w[e] & 0xffffu); vt[(c * 8 + 2 * e + 1) * (VSTR / 2)] = (bf16_t)(w[e] >> 16); }
}
__device__ __forceinline__ void qk_tile(f32x16& p0, f32x16& p1, const Ctx& C) {
    const LAS unsigned char* kl = C.lds + K_OFF + C.q * KSTR + 16 * C.hi;
    p0 = f32x16{}; p1 = f32x16{};
#pragma unroll
    for (int d0 = 0; d0 < 4; ++d0) { const bf16x8 a0 = *(const LAS bf16x8*)(kl + 32 * d0), a1 = *(const LAS bf16x8*)(kl + 32 * KSTR + 32 * d0);
        p0 = __builtin_amdgcn_mfma_f32_32x32x16_bf16(a0, C.qr[d0], p0, 0, 0, 0); p1 = __builtin_amdgcn_mfma_f32_32x32x16_bf16(a1, C.qr[d0], p1, 0, 0, 0); }
}
template <int MODE> __device__ __forceinline__ void mask_bias(f32x16& p0, f32x16& p1, const Ctx& C, int kbase, bool sel) {
    const LAS float* bt = (const LAS float*)(C.lds + BIAS_OFF) + C.head * 128;
#pragma unroll
    for (int T = 0; T < 2; ++T)
#pragma unroll
        for (int r = 0; r < 16; ++r) {
            const int kidx = kbase + 32 * T + crow(r, C.hi);
            const int dist = (MODE == CMP_A || MODE == CMP_B) ? (C.t - 31 - 16 * kidx) : (C.t - kidx);
            bool valid = dist >= 0; if (MODE == WIN) valid = valid && dist < 512; if (MODE == SLC) valid = valid && sel;
            const int di = dist < 0 ? 0 : (dist > 127 ? 127 : dist);
            const float bv = bt[di];
            if (T == 0) p0[r] = valid ? p0[r] + bv : NEG; else p1[r] = valid ? p1[r] + bv : NEG;
        }
}
__device__ __forceinline__ float tile_max(const f32x16& p0, const f32x16& p1) {
    float a = fmaxf(p0[0], p1[0]);
#pragma unroll
    for (int r = 1; r < 16; ++r) a = fmaxf(a, fmaxf(p0[r], p1[r]));
    return pair_max(a);
}
__device__ __forceinline__ void pv_tile(f32x16 (&o)[2], const f32x16& p0, const f32x16& p1, const Ctx& C) {
    bf16x8 pa[2][2];
#pragma unroll
    for (int s = 0; s < 2; ++s) {
        u32x4 w0, w1;
        w0.x = pk2(p0[8 * s + 0], p0[8 * s + 1]); w0.y = pk2(p0[8 * s + 2], p0[8 * s + 3]); w0.z = pk2(p0[8 * s + 4], p0[8 * s + 5]); w0.w = pk2(p0[8 * s + 6], p0[8 * s + 7]);
        w1.x = pk2(p1[8 * s + 0], p1[8 * s + 1]); w1.y = pk2(p1[8 * s + 2], p1[8 * s + 3]); w1.z = pk2(p1[8 * s + 4], p1[8 * s + 5]); w1.w = pk2(p1[8 * s + 6], p1[8 * s + 7]);
        pa[0][s] = __builtin_bit_cast(bf16x8, w0); pa[1][s] = __builtin_bit_cast(bf16x8, w1);
    }
    const LAS unsigned char* vl = C.lds + V_OFF + C.q * VSTR + 8 * C.hi;
#pragma unroll
    for (int db = 0; db < 2; ++db)
#pragma unroll
        for (int T = 0; T < 2; ++T)
#pragma unroll
            for (int s = 0; s < 2; ++s) {
                const LAS unsigned char* a = vl + db * 32 * VSTR + (32 * T + 16 * s) * 2;
                const u32x2 lo = *(const LAS u32x2*)a, hi2 = *(const LAS u32x2*)(a + 16);
                const u32x4 vv = {lo.x, lo.y, hi2.x, hi2.y};
                o[db] = __builtin_amdgcn_mfma_f32_32x32x16_bf16(pa[T][s], __builtin_bit_cast(bf16x8, vv), o[db], 0, 0, 0);
            }
}
__device__ __forceinline__ void row_scale(f32x16 (&o)[2], float fq_, const Ctx& C) {
    LAS float* wsc = (LAS float*)(C.lds + WSCR_OFF + C.wave * 256);
    wsc[C.q] = fq_; LDS_WAIT();
#pragma unroll
    for (int r = 0; r < 16; ++r) { const float f = wsc[crow(r, C.hi)]; o[0][r] *= f; o[1][r] *= f; }
    LDS_WAIT();
}
template <bool FIRST> __device__ __forceinline__ void row_fma(const f32x16 (&o)[2], float fq_, const Ctx& C) {
    LAS float* wsc = (LAS float*)(C.lds + WSCR_OFF + C.wave * 256);
    LAS float* otl = (LAS float*)(C.lds + OT_OFF + C.wave * 8192) + C.lane;
    wsc[C.q] = fq_; LDS_WAIT();
#pragma unroll
    for (int r = 0; r < 16; ++r) { const float f = wsc[crow(r, C.hi)];
        if (FIRST) { otl[(2 * r) * 64] = o[0][r] * f; otl[(2 * r + 1) * 64] = o[1][r] * f; }
        else { otl[(2 * r) * 64] += o[0][r] * f; otl[(2 * r + 1) * 64] += o[1][r] * f; } }
    LDS_WAIT();
}

template <int MODE>
__device__ __forceinline__ void branch(const Ctx& C, const bf16_t* kb, const bf16_t* vb, size_t stride, int jlo, int jhi, float& m, float& l, f32x16 (&o)[2], float inv_l, unsigned sel_lo, unsigned sel_hi) {
    TileRegs R; load_tile(R, kb, vb, stride, 64 * jlo, C.tid);
    const float far_bias = ((const LAS float*)(C.lds + BIAS_OFF))[C.head * 128 + 127];
    for (int j = jlo; j <= jhi; ++j) {
        __syncthreads();
        store_tile(R, C.lds, C.tid);
        __syncthreads();
        if (j < jhi) load_tile(R, kb, vb, stride, 64 * (j + 1), C.tid);
        f32x16 p0, p1;
        qk_tile(p0, p1, C);
        if (MODE == CMP_A || MODE == CMP_B) mask_bias<MODE>(p0, p1, C, 64 * j, true);
        else {
            const int delta = C.i - j;
            const bool sel = (MODE == SLC) ? (((j < 32 ? (sel_lo >> j) : (sel_hi >> (j - 32))) & 1u) != 0u) : true;
            if (delta <= 2 || (MODE == WIN && delta >= 8)) mask_bias<MODE>(p0, p1, C, 64 * j, sel);
            else {
#pragma unroll
                for (int r = 0; r < 16; ++r) { p0[r] = sel ? p0[r] + far_bias : NEG; p1[r] = sel ? p1[r] + far_bias : NEG; }
            }
        }
        if (MODE == CMP_A) {
            const float mt = tile_max(p0, p1), mn = fmaxf(m, mt), alpha = fexp2(m - mn);
            float s = 0.f;
#pragma unroll
            for (int r = 0; r < 16; ++r) s += fexp2(p0[r] - mn) + fexp2(p1[r] - mn);
            l = l * alpha + s; m = mn;
        } else if (MODE == CMP_B) {
#pragma unroll
            for (int r = 0; r < 16; ++r) { p0[r] = fexp2(p0[r] - m) * inv_l; p1[r] = fexp2(p1[r] - m) * inv_l; }
            LAS float* imp = (LAS float*)(C.lds + IMP_OFF) + C.tl * 65;
#pragma unroll
            for (int T = 0; T < 2; ++T)
#pragma unroll
                for (int c = 0; c < 4; ++c) {
                    const float e0 = T ? p1[4 * c] : p0[4 * c], e1 = T ? p1[4 * c + 1] : p0[4 * c + 1], e2 = T ? p1[4 * c + 2] : p0[4 * c + 2], e3 = T ? p1[4 * c + 3] : p0[4 * c + 3];
                    float mainv = (e0 + e1) + (e2 + 0.5f * e3), carry = 0.5f * e3;
                    mainv += __shfl_xor(mainv, 1); mainv += __shfl_xor(mainv, 2); carry += __shfl_xor(carry, 1); carry += __shfl_xor(carry, 2);
                    const int sb = 16 * j + 8 * T + 2 * c + C.hi;
                    if (C.head == 0) { (void)__hip_atomic_fetch_add(imp + sb, mainv, __ATOMIC_RELAXED, __HIP_MEMORY_SCOPE_WORKGROUP); if (sb + 1 < 64) (void)__hip_atomic_fetch_add(imp + sb + 1, carry, __ATOMIC_RELAXED, __HIP_MEMORY_SCOPE_WORKGROUP); }
                }
            pv_tile(o, p0, p1, C);
        } else {
            const float mt = tile_max(p0, p1), mn = fmaxf(m, mt), alpha = fexp2(m - mn);
            float s = 0.f;
#pragma unroll
            for (int r = 0; r < 16; ++r) { p0[r] = fexp2(p0[r] - mn); p1[r] = fexp2(p1[r] - mn); s += p0[r] + p1[r]; }
            l = l * alpha + s; m = mn;
            if (__any(alpha != 1.f)) row_scale(o, alpha, C);
            pv_tile(o, p0, p1, C);
        }
    }
}

__device__ __forceinline__ void attn_unit(Frame& F, int b, int g, int i) {
    unsigned char* ws = F.ws;
    const bf16_t* proj = (const bf16_t*)(ws + WS_PROJ);
    int tid_ = threadIdx.x; asm volatile("" : "+v"(tid_));
    Ctx C; C.lds = F.lds; C.tid = tid_; C.lane = tid_ & 63; C.wave = F.wave; C.q = C.lane & 31; C.hi = C.lane >> 5; C.tl = 8 * F.wave + (C.q >> 2); C.head = C.q & 3; C.i = i; C.t = 64 * i + C.tl;
    const size_t row = (size_t)b * SEQ + C.t;
    const int hq = g * 4 + C.head;
#pragma unroll
    for (int d0 = 0; d0 < 4; ++d0) C.qr[d0] = *(const bf16x8*)(proj + row * NPROJ + COL_Q + hq * 64 + 16 * d0 + 8 * C.hi);
    float gate[3];
#pragma unroll
    for (int j = 0; j < 3; ++j) gate[j] = sigmoidf_(bf2f(proj[row * NPROJ + COL_GL + hq * 3 + j]));
    __syncthreads();
    ((LAS float*)(C.lds + BIAS_OFF))[C.tid] = ((const float*)(ws + WS_BTAB))[(g * 4 + (C.tid >> 7)) * 128 + (C.tid & 127)];
    for (int idx = C.tid; idx < 64 * 65; idx += 512) ((LAS float*)(C.lds + IMP_OFF))[idx] = 0.f;
    __syncthreads();
    f32x16 o[2];
    float m, l;
    {
        const bf16_t* kc = (const bf16_t*)(ws + WS_KCMP) + (size_t)((b * 4 + g) * 256) * 64; const bf16_t* vc = (const bf16_t*)(ws + WS_VCMP) + (size_t)((b * 4 + g) * 256) * 64;
        const int nkt = (4 * i + 2) / 64 + 1;
        m = MFLOOR; l = 0.f; o[0] = f32x16{}; o[1] = f32x16{};
        branch<CMP_A>(C, kc, vc, 64, 0, nkt - 1, m, l, o, 0.f, 0u, 0u);
        const float lt = pair_sum(l), inv = lt > 0.f ? 1.f / lt : 0.f;
        branch<CMP_B>(C, kc, vc, 64, 0, nkt - 1, m, l, o, inv, 0u, 0u);
        row_fma<true>(o, gate[0], C);
    }
    {
        LDS_WAIT();
        LAS unsigned char* selb = C.lds + SEL_OFF;
        if (i >= 16) {
            const int tk = C.lane >> 3, cg = C.lane & 7;
            const LAS float* rowp = (const LAS float*)(C.lds + IMP_OFF) + (8 * C.wave + tk) * 65;
            float v[8]; int cnt[8];
#pragma unroll
            for (int c = 0; c < 8; ++c) { const int s = cg * 8 + c; const float x = rowp[s]; v[c] = (s == 0 || s == i || s == i - 1) ? 1e4f : (s <= i ? x : -1.f); cnt[c] = 0; }
            for (int s2 = 0; s2 < 64; ++s2) {
                const float x0 = rowp[s2]; const float x = (s2 == 0 || s2 == i || s2 == i - 1) ? 1e4f : (s2 <= i ? x0 : -1.f);
#pragma unroll
                for (int c = 0; c < 8; ++c) { const int s = cg * 8 + c; cnt[c] += ((x > v[c]) || (x == v[c] && s2 < s)) ? 1 : 0; }
            }
            unsigned bits = 0;
#pragma unroll
            for (int c = 0; c < 8; ++c) { const int s = cg * 8 + c; if (cnt[c] < 16 && s <= i) bits |= 1u << c; }
            selb[(8 * C.wave + tk) * 8 + cg] = (unsigned char)bits;
        } else {
            if (C.lane < 8) { const unsigned long long mk = (2ull << i) - 1ull; *(LAS unsigned long long*)(selb + (8 * C.wave + C.lane) * 8) = mk; }
        }
        LDS_WAIT();
    }
    const u32x2 selw = *(const LAS u32x2*)(C.lds + SEL_OFF + C.tl * 8);
    {
        const bf16_t* kb = proj + (size_t)b * SEQ * NPROJ + COL_KS + g * 64; const bf16_t* vb = proj + (size_t)b * SEQ * NPROJ + COL_VS + g * 64;
        m = MFLOOR; l = 0.f; o[0] = f32x16{}; o[1] = f32x16{};
        branch<SLC>(C, kb, vb, NPROJ, 0, i, m, l, o, 0.f, selw.x, selw.y);
        const float lt = pair_sum(l);
        row_fma<false>(o, gate[1] / lt, C);
    }
    {
        const bf16_t* kb = proj + (size_t)b * SEQ * NPROJ + COL_KW + g * 64; const bf16_t* vb = proj + (size_t)b * SEQ * NPROJ + COL_VW + g * 64;
        m = MFLOOR; l = 0.f; o[0] = f32x16{}; o[1] = f32x16{};
        branch<WIN>(C, kb, vb, NPROJ, i >= 8 ? i - 8 : 0, i, m, l, o, 0.f, 0u, 0u);
        const float lt = pair_sum(l);
        row_fma<false>(o, gate[2] / lt, C);
    }
    bf16_t* mix = (bf16_t*)(ws + WS_MIX);
    const LAS float* otl = (const LAS float*)(C.lds + OT_OFF + C.wave * 8192) + C.lane;
#pragma unroll
    for (int r = 0; r < 16; ++r) { const int qq = crow(r, C.hi); const size_t orow = (size_t)b * SEQ + 64 * i + 8 * C.wave + (qq >> 2);
        bf16_t* op = mix + orow * DM + 1024 + (g * 4 + (qq & 3)) * 64 + C.q;
        op[0] = (bf16_t)f2bf(otl[(2 * r) * 64]); op[32] = (bf16_t)f2bf(otl[(2 * r + 1) * 64]); }
}
__device__ __forceinline__ void attn_phase(Frame& F) {
    for (int v = F.vcu; v < 256; v += F.G) {
        const int bg = v >> 4, s = v & 15;
#pragma unroll 1
        for (int k = 0; k < 4; ++k) { const int i = (k == 0) ? 63 - s : (k == 1) ? 32 + s : (k == 2) ? 31 - s : s; attn_unit(F, bg >> 2, bg & 3, i); }
    }
}
}

__device__ __forceinline__ void final_norm_phase(Frame& F) {
    const int gw = F.vcu * NWAVES + F.wave, NGW = F.G * NWAVES, lane = F.lane;
    const float* ss = (const float*)(F.ws + CTL_SS2); const f32x4* nw = (const f32x4*)F.a->in[I_NFW] + lane;
    for (int mrow = gw; mrow < MTOK; mrow += NGW) {
        const float rs = __builtin_amdgcn_rsqf(ss[mrow] * (1.f / DM) + EPS);
        f32x4* xr = (f32x4*)(F.out + (size_t)mrow * DM) + lane;
#pragma unroll
        for (int j = 0; j < 8; ++j) { f32x4 v = xr[64 * j]; const f32x4 w = nw[64 * j]; v = v * rs * w; xr[64 * j] = v; }
    }
}


#ifndef DBG_STOP
#define DBG_STOP -1
#endif
__device__ __forceinline__ void dbg_dump(Frame& F) {
    const size_t n = (size_t)MTOK * DM; unsigned char* ws = F.ws;
    for (size_t idx = (size_t)blockIdx.x * 512 + F.tid; idx < n; idx += (size_t)F.G * 512) {
        const size_t row = idx / DM, c = idx % DM; float v = 0.f;
        if (DBG_STOP == 0) { v = bf2f(((const bf16_t*)(ws + WS_XB))[idx]) + bf2f(((const bf16_t*)(ws + WS_WUP))[idx % ((size_t)DFF * DM)]) + bf2f(((const bf16_t*)(ws + WS_WDOWN))[idx % ((size_t)DFF * DM)])
                                 + bf2f(((const bf16_t*)(ws + WS_WIN))[idx % ((size_t)NPROJ * DM)]) + bf2f(((const bf16_t*)(ws + WS_WOUT))[idx % ((size_t)DM * DM)]) + bf2f(((const bf16_t*)(ws + WS_WGLU))[idx % ((size_t)1024 * 1024)])
                                 + bf2f(((const bf16_t*)(ws + WS_WC1K))[idx % ((size_t)1024 * 1024)]) + ((const float*)(ws + WS_R1))[row] + ((const float*)(ws + WS_S5AB))[idx % 16384] + bf2f(((const bf16_t*)(ws + WS_BRE))[idx % (2 * 65536 + 131072)]) + ((const float*)(ws + WS_BTAB))[idx % 2048]; }
        if (DBG_STOP == 1) { if (c < 1920) v = bf2f(((const bf16_t*)(ws + WS_PROJ))[row * NPROJ + c]) + 3.f * bf2f(((const bf16_t*)(ws + WS_PROJ))[row * NPROJ + c + 1920]); }
        if (DBG_STOP == 2) { if (idx < 2097152) v = bf2f(((const bf16_t*)(ws + WS_HC))[idx]); else if (idx < 2097152 + 262144) v = ((const float*)(ws + WS_SEG))[idx - 2097152]; }
        if (DBG_STOP == 3) { if (c < 1024) v = bf2f(((const bf16_t*)(ws + WS_Z))[row * 1024 + c]); else { const size_t k = row * 1024 + (c - 1024); if (k < 524288) v = bf2f(((const bf16_t*)(ws + WS_KCMP))[k]); } }
        if (DBG_STOP == 4) { v = bf2f(((const bf16_t*)(ws + WS_MIX))[idx]); }
        if (DBG_STOP == 6) { const bf16_t* h = (const bf16_t*)(ws + WS_HID) + row * DFF + c; v = bf2f(h[0]) + bf2f(h[2048]) + bf2f(h[4096]) + bf2f(h[6144]); }
        if (DBG_STOP != 5 && DBG_STOP != 7) F.out[idx] = v;
    }
}

constexpr int N_PHASES = 9;
__global__ void __launch_bounds__(NWAVES * 64, 2) hymba_fwd(Args args) {
    extern __shared__ __attribute__((aligned(16))) unsigned char lds_raw[];
    Frame F;
    F.lds = (LAS unsigned char*)lds_raw;
    F.tid = threadIdx.x; F.lane = F.tid & 63; F.wave = __builtin_amdgcn_readfirstlane(F.tid >> 6);
    F.G = gridDim.x; { const int bx = blockIdx.x; F.vcu = (F.G % 8 == 0) ? (bx % 8) * (F.G / 8) + bx / 8 : bx; }
    F.a = &args; F.out = args.out; F.ws = args.ws;
    unsigned char* ws = args.ws;
    volatile LAS unsigned* MISC = (volatile LAS unsigned*)(F.lds + MISC_OFF);
    if (F.tid < 32) MISC[F.tid] = 0u;
    __syncthreads();
    XcdBarrier bar; bar.bar = (unsigned*)(ws + WS_CTL) + CW_BAR; bar.x = 0; bar.st = nullptr;
    const int lo = args.ph_lo, hi = args.ph_hi;
    const bool multi = (hi - lo) > 1;
    if (multi) bar = xcd_barrier_post((unsigned*)(ws + WS_CTL) + CW_BAR, MISC + 8);
#ifndef ONLY_PHASE
#define ONLY_PHASE -1
#endif
#define IN(k) ((ONLY_PHASE < 0 || ONLY_PHASE == (k)) && (DBG_STOP < 0 || (k) <= DBG_STOP) && lo <= (k) && (k) < hi)
#define SEAM(k) do { if (IN(k) && IN((k) + 1)) xcd_barrier(bar); } while (0)
    const int cblk = (int)blockIdx.x;

    if (IN(0)) { p0_prologue(F); SEAM(0); }
    if (IN(1)) {
        pg8::Gemm g{(const bf16_t*)(ws + WS_XB), (const bf16_t*)(ws + WS_WIN), MTOK, NPROJ, DM, DM, 128, 0};
        pg8::StaticOrder S; S.init(MTOK, NPROJ, F.G, cblk);
        pg8::EpiProj E{(bf16_t*)(ws + WS_PROJ), (const float*)(ws + WS_R1)};
        pg8::gemm_phase<pg8::EpiProj, pg8::StaticOrder, true>(F.lds, g, S, E);
        cmp_bias_reduce(F);
        SEAM(1);
    }
    if (IN(2)) {
        {
            pg8::Gemm g{(const bf16_t*)(ws + WS_PROJ) + COL_KC, (const bf16_t*)(ws + WS_WC1K), 4096, 256, 2048, 16 * NPROJ, NPROJ * 2, 1};
            pg8::StaticOrder S; S.init(4096, 256, F.G, cblk);
            pg8::EpiCmp E{(bf16_t*)(ws + WS_HC), (const float*)(ws + WS_CBF)};
            pg8::gemm_phase<pg8::EpiCmp, pg8::StaticOrder, true>(F.lds, g, S, E);
        }
        {
            pg8::Gemm g{(const bf16_t*)(ws + WS_PROJ) + COL_VC, (const bf16_t*)(ws + WS_WC1V), 4096, 256, 2048, 16 * NPROJ, NPROJ * 2, 1};
            pg8::StaticOrder S; S.init(4096, 256, F.G, (cblk + F.G - 16) % F.G);
            pg8::EpiCmp E{(bf16_t*)(ws + WS_HC) + (size_t)4096 * 256, (const float*)(ws + WS_CBF) + 256};
            pg8::gemm_phase<pg8::EpiCmp, pg8::StaticOrder, true>(F.lds, g, S, E);
        }
        __syncthreads();
        s5_phase<false>(F);
        SEAM(2);
    }
    if (IN(3)) { s5_phase<true>(F); cmp2_phase(F); SEAM(3); }
    if (IN(4)) {
        __syncthreads();
        pg8::Gemm g{(const bf16_t*)(ws + WS_Z), (const bf16_t*)(ws + WS_WGLU), MTOK, 1024, 1024, 1024, 128, 0};
        pg8::StaticOrder S; S.init(MTOK, 1024, F.G, cblk);
        pg8::EpiGlu E{(bf16_t*)(ws + WS_MIX), (const bf16_t*)(ws + WS_Z), F.a->in[I_BGLU]};
        pg8::gemm_phase<pg8::EpiGlu, pg8::StaticOrder, true>(F.lds, g, S, E);
        __syncthreads();
        att::attn_phase(F);
        SEAM(4);
    }
    if (IN(5)) {
        __syncthreads();
        pg8::Gemm g{(const bf16_t*)(ws + WS_MIX), (const bf16_t*)(ws + WS_WOUT), MTOK, DM, DM, DM, 128, 0};
        pg8::StaticOrder S; S.init(MTOK, DM, F.G, cblk);
        pg8::EpiRes E{F.a->in[I_X], F.out, (bf16_t*)(ws + WS_X1B), (float*)(ws + CTL_SS1)};
        pg8::gemm_phase<pg8::EpiRes, pg8::StaticOrder, true>(F.lds, g, S, E);
        SEAM(5);
    }
    if (IN(6)) {
        pg8::Gemm g{(const bf16_t*)(ws + WS_X1B), (const bf16_t*)(ws + WS_WUP), MTOK, DFF, DM, DM, 128, 0};
        pg8::StaticOrder S; S.init(MTOK, DFF, F.G, cblk);
        pg8::EpiUp E{(bf16_t*)(ws + WS_HID), (const float*)(ws + CTL_SS1)};
        pg8::gemm_phase<pg8::EpiUp, pg8::StaticOrder, true>(F.lds, g, S, E);
        SEAM(6);
    }
    if (IN(7)) {
        pg8::Gemm g{(const bf16_t*)(ws + WS_HID), (const bf16_t*)(ws + WS_WDOWN), MTOK, DM, DFF, DFF, 128, 0};
        pg8::StaticOrder S; S.init(MTOK, DM, F.G, cblk);
        pg8::EpiRes E{F.out, F.out, nullptr, (float*)(ws + CTL_SS2)};
        pg8::gemm_phase<pg8::EpiRes, pg8::StaticOrder, true>(F.lds, g, S, E);
        SEAM(7);
    }
    if (IN(8)) final_norm_phase(F);
    if (DBG_STOP >= 0 && lo == 8) dbg_dump(F);
#undef IN
#undef SEAM
}

extern "C" void kernel_launch(void* const* d_in, const int* in_sizes, int n_in, void* d_out, int out_size, void* d_ws, size_t ws_size, hipStream_t stream) {
    static int grid = 0;
    if (grid == 0) {
        if (n_in != 25 || in_sizes[0] != MTOK * DM || out_size != MTOK * DM || ws_size < WS_END) {
            fprintf(stderr, "kernel_launch: unexpected shapes (n_in %d, in0 %d, out %d, ws %zu < %zu); nothing launched\n", n_in, n_in > 0 ? in_sizes[0] : -1, out_size, ws_size, (size_t)WS_END); grid = -1; return; }
        int dev = 0, cus = 0, per_cu = 0;
        if (hipGetDevice(&dev) != hipSuccess || hipDeviceGetAttribute(&cus, hipDeviceAttributeMultiprocessorCount, dev) != hipSuccess) { grid = -1; return; }
        if (hipFuncSetAttribute((const void*)hymba_fwd, hipFuncAttributeMaxDynamicSharedMemorySize, LDS_BYTES) != hipSuccess) { fprintf(stderr, "kernel_launch: hipFuncSetAttribute failed\n"); grid = -1; return; }
        if (hipOccupancyMaxActiveBlocksPerMultiprocessor(&per_cu, (const void*)hymba_fwd, NWAVES * 64, LDS_BYTES) != hipSuccess || per_cu < 1) { fprintf(stderr, "kernel_launch: occupancy query says %d blocks per CU\n", per_cu); per_cu = 1; }
        (void)hipGetLastError();
        grid = cus;
    }
    if (grid < 0) return;
    if (MK_N_LAUNCHES == 1) { if (hipMemsetAsync((char*)d_ws + WS_CTL, 0, CTL_ZERO_BYTES, stream) != hipSuccess) return; }
    Args a{};
    for (int i = 0; i < 25; ++i) a.in[i] = (const float*)d_in[i];
    a.out = (float*)d_out; a.ws = (unsigned char*)d_ws;
    if (MK_N_LAUNCHES == 1) {
        a.ph_lo = 0; a.ph_hi = N_PHASES;
        void* kargs[] = {&a};
        hipError_t e = hipLaunchCooperativeKernel((const void*)hymba_fwd, dim3(grid), dim3(NWAVES * 64), kargs, LDS_BYTES, stream);
        if (e != hipSuccess) fprintf(stderr, "kernel_launch: cooperative launch failed: %s (grid %d)\n", hipGetErrorString(e), grid);
    } else {
        for (int p = 0; p < N_PHASES; ++p) { a.ph_lo = p; a.ph_hi = p + 1; hipLaunchKernelGGL(hymba_fwd, dim3(grid), dim3(NWAVES * 64), LDS_BYTES, stream, a); }
    }
}
```

```cpp
#include <hip/hip_runtime.h>
#include <cstdio>
#include <cstdint>

#ifndef MK_N_LAUNCHES
#define MK_N_LAUNCHES 1
#endif

#define LAS __attribute__((address_space(3)))
#define GAS __attribute__((address_space(1)))
typedef unsigned short bf16_t;
typedef short bf16x8 __attribute__((ext_vector_type(8)));
typedef float f32x2 __attribute__((ext_vector_type(2)));
typedef float f32x4 __attribute__((ext_vector_type(4)));
typedef float f32x16 __attribute__((ext_vector_type(16)));
typedef unsigned u32x2 __attribute__((ext_vector_type(2)));
typedef unsigned u32x4 __attribute__((ext_vector_type(4)));
typedef __bf16 bf16x2_t __attribute__((ext_vector_type(2)));

#define LDS_WAIT() asm volatile("s_waitcnt lgkmcnt(0)" ::: "memory")
#define VM_WAIT() asm volatile("s_waitcnt vmcnt(0)" ::: "memory")

constexpr int BATCH = 4, SEQ = 4096, DM = 2048, MTOK = BATCH * SEQ, DFF = 8192;
constexpr int D_IN = 3632, NPROJ = 3840;
constexpr int COL_U = 0, COL_Q = 1024, COL_KC = 2048, COL_VC = 2304, COL_KS = 2560, COL_VS = 2816, COL_KW = 3072, COL_VW = 3328, COL_GL = 3584;
constexpr float EPS = 1e-6f;
constexpr float LOG2E = 1.4426950408889634f;
constexpr float C2 = 0.125f * LOG2E;
constexpr int NWAVES = 8;

constexpr size_t MiB = 1u << 20;
constexpr size_t WS_CTL = 0, CTL_ZERO_BYTES = 1 * MiB;
constexpr int CW_BAR = 4096;
constexpr size_t CTL_SS1 = 256 * 1024, CTL_SS2 = 512 * 1024, CTL_CB = 768 * 1024;
constexpr size_t WS_R1 = 1 * MiB, WS_BTAB = 1 * MiB + 64 * 1024, WS_S5AB = 1 * MiB + 128 * 1024, WS_CBP = 1 * MiB + 256 * 1024  , WS_CBF = 1 * MiB + 384 * 1024  ;
constexpr size_t WS_BRE = 2 * MiB, WS_BIM = 2 * MiB + 128 * 1024, WS_CM = 2 * MiB + 256 * 1024;
constexpr size_t WS_SEG = 3 * MiB;
constexpr size_t WS_WIN = 4 * MiB, WS_WGLU = 19 * MiB, WS_WOUT = 21 * MiB, WS_WUP = 29 * MiB, WS_WDOWN = 61 * MiB, WS_WC1K = 93 * MiB, WS_WC1V = 94 * MiB,
                 WS_WC2K = 95 * MiB, WS_WC2V = 95 * MiB + 64 * 1024;
constexpr size_t WS_X1B = 100 * MiB, WS_MIX = 164 * MiB, WS_HID = 228 * MiB;
constexpr size_t WS_XB = 228 * MiB, WS_PROJ = 292 * MiB, WS_Z = 412 * MiB, WS_HC = 444 * MiB, WS_KCMP = 448 * MiB, WS_VCMP = 448 * MiB + 512 * 1024;
constexpr size_t WS_VST = 450 * MiB, WS_VWT = 458 * MiB, WS_VCT = 466 * MiB;
constexpr size_t WS_END = 484 * MiB;

constexpr int LDS_BYTES = 147456;
constexpr int MISC_OFF = 135168 + 4096;

__device__ __forceinline__ unsigned f2bf(float f) { unsigned u = __builtin_bit_cast(unsigned, f); return (u + 0x7fffu + ((u >> 16) & 1u)) >> 16; }
__device__ __forceinline__ unsigned pk2(float lo, float hi) { f32x2 v = {lo, hi}; bf16x2_t b = __builtin_convertvector(v, bf16x2_t); return __builtin_bit_cast(unsigned, b); }
__device__ __forceinline__ float bf2f(unsigned b) { return __builtin_bit_cast(float, b << 16); }
__device__ __forceinline__ float bflo(unsigned w) { return __builtin_bit_cast(float, w << 16); }
__device__ __forceinline__ float bfhi(unsigned w) { return __builtin_bit_cast(float, w & 0xffff0000u); }
__device__ __forceinline__ float fexp2(float x) { return __builtin_amdgcn_exp2f(x); }
__device__ __forceinline__ float frcp(float x) { return __builtin_amdgcn_rcpf(x); }
__device__ __forceinline__ float sigmoidf_(float x) { return frcp(1.f + fexp2(-x * LOG2E)); }
__device__ __forceinline__ float gelu_tanh(float x) {
    const float u = 0.7978845608028654f * (x + 0.044715f * x * x * x);
    return x * frcp(1.f + fexp2(-2.f * LOG2E * u));
}
__device__ __forceinline__ int crow(int r, int hi) { return (r & 3) + 8 * (r >> 2) + 4 * hi; }
__device__ __forceinline__ float wave_sum(float v) {
#pragma unroll
    for (int o = 1; o < 64; o <<= 1) v += __shfl_xor(v, o);
    return v;
}
__device__ __forceinline__ float pair_max(float v) {
    unsigned a = __builtin_bit_cast(unsigned, v), b = a; asm volatile("" : "+v"(b));
    auto rr = __builtin_amdgcn_permlane32_swap(a, b, false, false);
    unsigned r0 = rr[0], r1 = rr[1]; asm volatile("" : "+v"(r0), "+v"(r1));
    return fmaxf(__builtin_bit_cast(float, r0), __builtin_bit_cast(float, r1));
}
__device__ __forceinline__ float pair_sum(float v) {
    unsigned a = __builtin_bit_cast(unsigned, v), b = a; asm volatile("" : "+v"(b));
    auto rr = __builtin_amdgcn_permlane32_swap(a, b, false, false);
    unsigned r0 = rr[0], r1 = rr[1]; asm volatile("" : "+v"(r0), "+v"(r1));
    return __builtin_bit_cast(float, r0) + __builtin_bit_cast(float, r1);
}

__device__ const unsigned char T5B[128] = {0, 1, 2, 3, 4, 5, 6, 7, 8, 9, 10, 11, 12, 13, 14, 15, 16, 16, 16, 17, 17, 18, 18, 18, 19, 19, 19, 20, 20, 20, 20, 21, 21, 21, 21, 22, 22, 22, 22, 22, 23, 23, 23, 23, 23, 23,
    24, 24, 24, 24, 24, 24, 25, 25, 25, 25, 25, 25, 25, 26, 26, 26, 26, 26, 26, 26, 26, 27, 27, 27, 27, 27, 27, 27, 27, 27, 27, 28, 28, 28, 28, 28, 28, 28, 28, 28, 28, 29, 29, 29, 29, 29, 29, 29, 29, 29, 29, 29, 29,
    30, 30, 30, 30, 30, 30, 30, 30, 30, 30, 30, 30, 30, 30, 31, 31, 31, 31, 31, 31, 31, 31, 31, 31, 31, 31, 31, 31, 31};

namespace pg8 {
constexpr int BM = 256, BK = 64, HALF = 128, HTB = HALF * BK * 2, STAGE_BYTES = 8 * HTB, NXCD = 8, WGM = 8;
__host__ __device__ __forceinline__ int lds_byte(int r, int c) { const int st = (r >> 4) * 2 + (c >> 5), rr = r & 15, cc = c & 31, ob = rr * 64 + cc * 2; return st * 1024 + (ob ^ (((ob >> 9) & 1) << 5)); }
__host__ __device__ __forceinline__ void stage_rc(int b, int& R, int& C) { const int st = b / 1024, sb = b % 1024, swz = sb ^ (((sb >> 9) & 1) << 5); R = (st >> 1) * 16 + swz / 64; C = (st & 1) * 32 + (swz % 64) / 2; }
__host__ __device__ __forceinline__ int perm32(int rho) { const int n = rho >> 4, i = rho & 15; return 8 * (i >> 2) + 4 * n + (i & 3); }

struct Unit { int pm, pn; };
struct Gemm { const bf16_t* A; const bf16_t* Bt; int M, N, K; int lda; int a_kstep; int amode; };
__device__ __forceinline__ const char* a_base(const Gemm& g, int pm) {
    if (g.amode == 0) return (const char*)g.A + (size_t)pm * (size_t)BM * (size_t)g.lda * 2;
    return (const char*)g.A + ((size_t)(pm >> 2) * SEQ * NPROJ + (size_t)(pm & 3) * 64) * 2;
}

struct StaticOrder {
    int nM, nN, nwg, G, c;
    __host__ __device__ void init(int M, int N, int G_, int c_) { nM = M / BM; nN = N / BM; nwg = nM * nN; G = G_; c = c_; }
    __host__ __device__ bool next(int i, Unit& u) const {
        const long L = (long)i * G + c; if (L >= nwg) return false;
        int wgid = (int)L; { const int q = nwg / NXCD, r = nwg % NXCD, xcd = wgid % NXCD, off = wgid / NXCD; wgid = (xcd < r ? xcd * (q + 1) : r * (q + 1) + (xcd - r) * q) + off; }
        const int nig = WGM * nN, gid = wgid / nig, fm = gid * WGM, gsz = (nM - fm) < WGM ? (nM - fm) : WGM;
        u.pm = fm + ((wgid % nig) % gsz); u.pn = (wgid % nig) / gsz; return true;
    }
};

typedef f32x4 Acc[2][2][4][2];

template <class Epi, class Sched, bool ALIGN_EPI = true>
__device__ __forceinline__ void gemm_phase(LAS unsigned char* lds, const Gemm g, const Sched& S, const Epi& E) {
    const int tid = threadIdx.x, wid = __builtin_amdgcn_readfirstlane(tid >> 6), lane = tid & 63, wr = wid >> 2, wc = wid & 3, fr = lane & 15, fq = lane >> 4;
    const int K = g.K, nt = K / BK;
    unsigned voffA[2], voffB[2];
#pragma unroll
    for (int i = 0; i < 2; ++i) { int R, C; stage_rc(tid * 16 + i * 8192, R, C); const int Rb = (R & ~31) + perm32(R & 31);
        voffA[i] = (unsigned)(R * g.lda + C) * 2u; voffB[i] = (unsigned)(Rb * K + C) * 2u; }
    const size_t kstepA = (size_t)g.a_kstep, kstepB = (size_t)(BK * 2);
    const size_t hstepA = (size_t)HALF * g.lda * 2, hstepB = (size_t)HALF * K * 2;
    const size_t tstepB = 2 * hstepB;
    const unsigned ldsw = (unsigned)wid * 1024u;
    const int aoff = lds_byte(wr * 64 + fr, fq * 8), boff = lds_byte(wc * 32 + fr, fq * 8);
#define PG8_SA(b, h) (((b) * 2 + (h)) * HTB)
#define PG8_SB(b, h) ((4 + (b) * 2 + (h)) * HTB)
#define PG8_STAGE(bufoff, gbase, voff) do { _Pragma("unroll") for (int _i = 0; _i < 2; ++_i) \
        __builtin_amdgcn_global_load_lds((const unsigned*)((const char*)(gbase) + (voff)[_i]), (LAS unsigned*)(lds + (bufoff) + ldsw + _i * 8192), 16, 0, 0); } while (0)
#define PG8_LDA(dst, b, h) do { _Pragma("unroll") for (int m = 0; m < 4; ++m) _Pragma("unroll") for (int k = 0; k < 2; ++k) dst[m][k] = *(const LAS bf16x8*)(lds + PG8_SA(b, h) + aoff + m * 2048 + k * 1024); } while (0)
#define PG8_LDB(dst, b, h) do { _Pragma("unroll") for (int n = 0; n < 2; ++n) _Pragma("unroll") for (int k = 0; k < 2; ++k) dst[n][k] = *(const LAS bf16x8*)(lds + PG8_SB(b, h) + boff + n * 2048 + k * 1024); } while (0)
#define PG8_MMA(ai, bj, At, Bt) do { __builtin_amdgcn_s_setprio(1); _Pragma("unroll") for (int m = 0; m < 4; ++m) _Pragma("unroll") for (int n = 0; n < 2; ++n) _Pragma("unroll") for (int k = 0; k < 2; ++k) \
        acc[ai][bj][m][n] = __builtin_amdgcn_mfma_f32_16x16x32_bf16(Bt[n][k], At[m][k], acc[ai][bj][m][n], 0, 0, 0); __builtin_amdgcn_s_setprio(0); } while (0)
#define PG8_WAIT_V(n) asm volatile("s_waitcnt vmcnt(" #n ")" ::: "memory")
#define PG8_WAIT_L(n) asm volatile("s_waitcnt lgkmcnt(" #n ")" ::: "memory")
#define PG8_BAR __builtin_amdgcn_s_barrier()
#define PG8_SCHED __builtin_amdgcn_sched_barrier(0)
    Unit cur, nxt; int ui = 0;
    if (!S.next(0, cur)) return;
    f32x4 acc[2][2][4][2];
#pragma unroll
    for (int a = 0; a < 2; ++a)
#pragma unroll
        for (int b = 0; b < 2; ++b)
#pragma unroll
            for (int m = 0; m < 4; ++m)
#pragma unroll
                for (int n = 0; n < 2; ++n) acc[a][b][m][n] = (f32x4){0.f, 0.f, 0.f, 0.f};
    bf16x8 At[4][2], B0[2][2], B1[2][2];
    const char* cA = a_base(g, cur.pm); const char* cB = (const char*)g.Bt + (size_t)cur.pn * tstepB;
    PG8_STAGE(PG8_SB(0, 0), cB, voffB); PG8_STAGE(PG8_SB(0, 1), cB + hstepB, voffB); PG8_STAGE(PG8_SA(0, 0), cA, voffA); PG8_STAGE(PG8_SA(0, 1), cA + hstepA, voffA);
    if (wr == 1) PG8_BAR;
    PG8_WAIT_V(2); PG8_BAR;
    PG8_STAGE(PG8_SB(1, 0), cB + kstepB, voffB); PG8_STAGE(PG8_SA(1, 0), cA + kstepA, voffA); PG8_STAGE(PG8_SB(1, 1), cB + hstepB + kstepB, voffB);
    PG8_WAIT_V(6); PG8_BAR;
    for (;;) {
        const bool has_next = S.next(ui + 1, nxt);
        const char* nA = has_next ? a_base(g, nxt.pm) : cA; const char* nB = has_next ? (const char*)g.Bt + (size_t)nxt.pn * tstepB : cB;
        for (int t = 0; t < nt; t += 2) {
            const bool last = (t == nt - 2);
            const char* a1 = cA + (size_t)(t + 1) * kstepA;
            const char* a2 = last ? nA : cA + (size_t)(t + 2) * kstepA; const char* b2 = last ? nB : cB + (size_t)(t + 2) * kstepB;
            const char* a3 = a2 + kstepA; const char* b3 = b2 + kstepB;
            PG8_LDB(B0, 0, 0); PG8_LDB(B1, 0, 1); PG8_SCHED; PG8_LDA(At, 0, 0); PG8_STAGE(PG8_SA(1, 1), a1 + hstepA, voffA);
            PG8_WAIT_V(8); PG8_WAIT_L(0); PG8_BAR; PG8_MMA(0, 0, At, B0); PG8_MMA(0, 1, At, B1); PG8_BAR; PG8_SCHED;
            PG8_LDA(At, 0, 1); PG8_STAGE(PG8_SB(0, 0), b2, voffB); PG8_STAGE(PG8_SB(0, 1), b2 + hstepB, voffB); PG8_STAGE(PG8_SA(0, 0), a2, voffA);
            PG8_WAIT_V(8); PG8_WAIT_L(0); PG8_BAR; PG8_MMA(1, 0, At, B0); PG8_MMA(1, 1, At, B1); PG8_BAR; PG8_SCHED;
            PG8_LDB(B0, 1, 0); PG8_LDB(B1, 1, 1); PG8_SCHED; PG8_LDA(At, 1, 0); PG8_STAGE(PG8_SA(0, 1), a2 + hstepA, voffA);
            PG8_WAIT_V(8); PG8_WAIT_L(0); PG8_BAR; PG8_MMA(0, 0, At, B0); PG8_MMA(0, 1, At, B1); PG8_BAR; PG8_SCHED;
            PG8_LDA(At, 1, 1); PG8_STAGE(PG8_SB(1, 0), b3, voffB); PG8_STAGE(PG8_SB(1, 1), b3 + hstepB, voffB); PG8_STAGE(PG8_SA(1, 0), a3, voffA);
            PG8_WAIT_V(8); PG8_WAIT_L(0); PG8_BAR; PG8_MMA(1, 0, At, B0); PG8_MMA(1, 1, At, B1); PG8_BAR; PG8_SCHED;
        }
        if constexpr (ALIGN_EPI) { if (wr == 0) PG8_BAR; }
        E(acc, cur, wr, wc, fr, fq);
        if (!has_next) break;
#pragma unroll
        for (int a = 0; a < 2; ++a)
#pragma unroll
            for (int b = 0; b < 2; ++b)
#pragma unroll
                for (int m = 0; m < 4; ++m)
#pragma unroll
                    for (int n = 0; n < 2; ++n) acc[a][b][m][n] = (f32x4){0.f, 0.f, 0.f, 0.f};
        cur = nxt; cA = nA; cB = nB; ++ui;
        if constexpr (ALIGN_EPI) { if (wr == 1) PG8_BAR; }
    }
    PG8_WAIT_V(0);
    if constexpr (!ALIGN_EPI) { if (wr == 0) PG8_BAR; }
    PG8_BAR;
#undef PG8_SA
#undef PG8_SB
#undef PG8_STAGE
#undef PG8_LDA
#undef PG8_LDB
#undef PG8_MMA
#undef PG8_WAIT_V
#undef PG8_WAIT_L
#undef PG8_BAR
#undef PG8_SCHED
}

#define EPI_ROWS_BEGIN const int row0 = u.pm * BM + wr * 64 + fr; const int col0 = u.pn * BM + wc * 32 + 8 * fq; \
    _Pragma("unroll") for (int ai = 0; ai < 2; ++ai) _Pragma("unroll") for (int m = 0; m < 4; ++m) { const int row = row0 + ai * HALF + m * 16;
#define EPI_ROWS_END }

struct EpiProj {
    bf16_t* O; const float* r1; bf16_t* vst; bf16_t* vwt;
    __device__ __forceinline__ void operator()(const Acc& acc, const Unit& u, int wr, int wc, int fr, int fq) const {
        const float sc = (u.pn >= 4 && u.pn < 8) ? C2 : 1.f;
        if (u.pn == 11 || u.pn == 13) {
            bf16_t* vt = (u.pn == 11) ? vst : vwt;
            const int cl = wc * 32 + 8 * fq;
            EPI_ROWS_BEGIN
                const float rs = r1[row]; const int bb = row >> 12, tok = row & (SEQ - 1);
#pragma unroll
                for (int bj = 0; bj < 2; ++bj) { const int c0 = cl + bj * HALF; bf16_t* bp = vt + ((size_t)(bb * 4 + (c0 >> 6)) * 64 + (c0 & 63)) * SEQ + tok;
#pragma unroll
                    for (int e = 0; e < 4; ++e) { bp[(size_t)e * SEQ] = (bf16_t)f2bf(acc[ai][bj][m][0][e] * rs); bp[(size_t)(4 + e) * SEQ] = (bf16_t)f2bf(acc[ai][bj][m][1][e] * rs); } }
            EPI_ROWS_END
            (void)col0;
            return;
        }
        EPI_ROWS_BEGIN
            const float rs = r1[row] * sc; bf16_t* rowp = O + (size_t)row * NPROJ + col0;
#pragma unroll
            for (int bj = 0; bj < 2; ++bj) { const f32x4 v0 = acc[ai][bj][m][0] * rs, v1 = acc[ai][bj][m][1] * rs;
                u32x4 w; w.x = pk2(v0[0], v0[1]); w.y = pk2(v0[2], v0[3]); w.z = pk2(v1[0], v1[1]); w.w = pk2(v1[2], v1[3]);
                *(u32x4*)(rowp + bj * HALF) = w; }
        EPI_ROWS_END
    }
};
struct EpiCmp {
    bf16_t* O; const float* bias;
    __device__ __forceinline__ void operator()(const Acc& acc, const Unit& u, int wr, int wc, int fr, int fq) const {
        const int bc = wc * 32 + 8 * fq;
        f32x4 bv[2][2];
#pragma unroll
        for (int bj = 0; bj < 2; ++bj)
#pragma unroll
            for (int n = 0; n < 2; ++n) bv[bj][n] = *(const f32x4*)(bias + bc + bj * HALF + 4 * n);
        EPI_ROWS_BEGIN
            bf16_t* rowp = O + (size_t)row * 256 + col0;
#pragma unroll
            for (int bj = 0; bj < 2; ++bj) { const f32x4 v0 = acc[ai][bj][m][0] + bv[bj][0], v1 = acc[ai][bj][m][1] + bv[bj][1];
                u32x4 w; w.x = pk2(gelu_tanh(v0[0]), gelu_tanh(v0[1])); w.y = pk2(gelu_tanh(v0[2]), gelu_tanh(v0[3])); w.z = pk2(gelu_tanh(v1[0]), gelu_tanh(v1[1])); w.w = pk2(gelu_tanh(v1[2]), gelu_tanh(v1[3]));
                *(u32x4*)(rowp + bj * HALF) = w; }
        EPI_ROWS_END
    }
};
struct EpiGlu {
    bf16_t* O; const bf16_t* Z; const float* bias;
    __device__ __forceinline__ void operator()(const Acc& acc, const Unit& u, int wr, int wc, int fr, int fq) const {
        f32x4 bv[2][2];
#pragma unroll
        for (int bj = 0; bj < 2; ++bj)
#pragma unroll
            for (int n = 0; n < 2; ++n) bv[bj][n] = *(const f32x4*)(bias + u.pn * BM + wc * 32 + 8 * fq + bj * HALF + 4 * n);
        EPI_ROWS_BEGIN
            bf16_t* rowp = O + (size_t)row * DM + col0; const bf16_t* zp = Z + (size_t)row * 1024 + col0;
#pragma unroll
            for (int bj = 0; bj < 2; ++bj) { const f32x4 v0 = acc[ai][bj][m][0] + bv[bj][0], v1 = acc[ai][bj][m][1] + bv[bj][1];
                const u32x4 zz = *(const u32x4*)(zp + bj * HALF);
                u32x4 w; w.x = pk2(bflo(zz.x) * sigmoidf_(v0[0]), bfhi(zz.x) * sigmoidf_(v0[1])); w.y = pk2(bflo(zz.y) * sigmoidf_(v0[2]), bfhi(zz.y) * sigmoidf_(v0[3]));
                w.z = pk2(bflo(zz.z) * sigmoidf_(v1[0]), bfhi(zz.z) * sigmoidf_(v1[1])); w.w = pk2(bflo(zz.w) * sigmoidf_(v1[2]), bfhi(zz.w) * sigmoidf_(v1[3]));
                *(u32x4*)(rowp + bj * HALF) = w; }
        EPI_ROWS_END
    }
};
template <bool BF> struct EpiRes {
    const void* base; bf16_t* ob; float* ss;
    __device__ __forceinline__ void operator()(const Acc& acc, const Unit& u, int wr, int wc, int fr, int fq) const {
        EPI_ROWS_BEGIN
            const size_t off = (size_t)row * DM + col0; float q = 0.f;
#pragma unroll
            for (int bj = 0; bj < 2; ++bj) { f32x4 b0, b1;
                if (BF) { const u32x4 bb = *(const u32x4*)((const bf16_t*)base + off + bj * HALF); b0 = (f32x4){bflo(bb.x), bfhi(bb.x), bflo(bb.y), bfhi(bb.y)}; b1 = (f32x4){bflo(bb.z), bfhi(bb.z), bflo(bb.w), bfhi(bb.w)}; }
                else { b0 = *(const f32x4*)((const float*)base + off + bj * HALF); b1 = *(const f32x4*)((const float*)base + off + bj * HALF + 4); }
                const f32x4 v0 = acc[ai][bj][m][0] + b0, v1 = acc[ai][bj][m][1] + b1;
                q += (v0[0] * v0[0] + v0[1] * v0[1]) + (v0[2] * v0[2] + v0[3] * v0[3]) + (v1[0] * v1[0] + v1[1] * v1[1]) + (v1[2] * v1[2] + v1[3] * v1[3]);
                u32x4 w; w.x = pk2(v0[0], v0[1]); w.y = pk2(v0[2], v0[3]); w.z = pk2(v1[0], v1[1]); w.w = pk2(v1[2], v1[3]); *(u32x4*)(ob + off + bj * HALF) = w; }
            q += __shfl_xor(q, 16); q += __shfl_xor(q, 32);
            if (fq == 0) atomicAdd(ss + row, q);
        EPI_ROWS_END
    }
};
struct EpiUp {
    bf16_t* O; const float* ss;
    __device__ __forceinline__ void operator()(const Acc& acc, const Unit& u, int wr, int wc, int fr, int fq) const {
        EPI_ROWS_BEGIN
            const float rs = __builtin_amdgcn_rsqf(ss[row] * (1.f / DM) + EPS); bf16_t* rowp = O + (size_t)row * DFF + col0;
#pragma unroll
            for (int bj = 0; bj < 2; ++bj) { f32x4 v0 = acc[ai][bj][m][0] * rs, v1 = acc[ai][bj][m][1] * rs;
#pragma unroll
                for (int e = 0; e < 4; ++e) { const float a = fmaxf(v0[e], 0.f), b = fmaxf(v1[e], 0.f); v0[e] = a * a; v1[e] = b * b; }
                u32x4 w; w.x = pk2(v0[0], v0[1]); w.y = pk2(v0[2], v0[3]); w.z = pk2(v1[0], v1[1]); w.w = pk2(v1[2], v1[3]);
                *(u32x4*)(rowp + bj * HALF) = w; }
        EPI_ROWS_END
    }
};
}

typedef GAS unsigned gu32;
#define RLX_AGENT __ATOMIC_RELAXED, __HIP_MEMORY_SCOPE_AGENT
#define XB_TMO      128
#define XB_XCNT(j)  (256  + 64 * (j))
#define XB_XSUB(j)  (1280 + 64 * (j))
#define XB_XGEN(j)  (2304 + 64 * (j))
#define XB_TOP      3328
#define XB_TOPGEN   3392
#define XCD_BAR_WORDS 3456
#define XB_SPIN_CAP (1u << 22)
__device__ __forceinline__ unsigned xb_ld(unsigned* p)              { return __hip_atomic_load(p, __ATOMIC_RELAXED, __HIP_MEMORY_SCOPE_AGENT); }
__device__ __forceinline__ unsigned xb_add(unsigned* p, unsigned v) { return __hip_atomic_fetch_add(p, v, __ATOMIC_RELAXED, __HIP_MEMORY_SCOPE_AGENT); }
__device__ __forceinline__ unsigned xb_xcc_id() { return (unsigned)__builtin_amdgcn_s_getreg((3 << 11) | 20) & 0xFu; }
#define XB_SPIN(cond, bar) do { unsigned _sp = 0; while (cond) { __builtin_amdgcn_s_sleep(1); \
    if ((++_sp & 255u) == 0u) { if (xb_ld(&(bar)[XB_TMO])) break; if (_sp > XB_SPIN_CAP) { atomicAdd(&(bar)[XB_TMO], 1u); break; } } } } while (0)
struct XcdBarrier { unsigned* bar; unsigned x; volatile LAS unsigned* st; };
__device__ __forceinline__ XcdBarrier xcd_barrier_post(unsigned* bar, volatile LAS unsigned* st) {
    XcdBarrier b; b.bar = bar; b.x = xb_xcc_id(); b.st = st;
    if (threadIdx.x == 0) (void)xb_add(&bar[XB_XCNT(b.x)], 1u);
    return b;
}
__device__ __forceinline__ void xcd_barrier_complete(unsigned* bar, unsigned x, unsigned& nloc, unsigned& nx) {
    const unsigned G = gridDim.x * gridDim.y * gridDim.z;
    unsigned sum, cnt, mine, sp = 0u;
    for (;;) {
        sum = 0u; cnt = 0u; mine = 0u;
#pragma unroll
        for (unsigned j = 0; j < 16; ++j) { const unsigned c = xb_ld(&bar[XB_XCNT(j)]); sum += c; cnt += (c > 0u) ? 1u : 0u; mine = (j == x) ? c : mine; }
        if (sum == G) break;
        __builtin_amdgcn_s_sleep(1);
        if ((++sp & 255u) == 0u) { if (xb_ld(&bar[XB_TMO])) break; if (sp > XB_SPIN_CAP) { atomicAdd(&bar[XB_TMO], 1u); break; } }
    }
    nloc = mine > 0u ? mine : 1u; nx = cnt > 0u ? cnt : 1u;
}
__device__ __forceinline__ void xcd_barrier(const XcdBarrier& b) {
    asm volatile("s_waitcnt vmcnt(0)" ::: "memory");
    __syncthreads();
    if (threadIdx.x == 0) {
        unsigned* bar = b.bar;
        __builtin_amdgcn_s_waitcnt(0);
        unsigned nloc = b.st[0], nx = b.st[1];
        if (nloc == 0u) { xcd_barrier_complete(bar, b.x, nloc, nx); b.st[0] = nloc; b.st[1] = nx; }
        const unsigned old = xb_add(&bar[XB_XSUB(b.x)], 1u);
        const unsigned gen = old / nloc;
        if (old + 1u == (gen + 1u) * nloc) {
            __builtin_amdgcn_fence(__ATOMIC_RELEASE, "agent");
            asm volatile("s_waitcnt vmcnt(0)" ::: "memory");
            const unsigned og = xb_add(&bar[XB_TOP], 1u);
            const unsigned tg = og / nx;
            if (og + 1u == (tg + 1u) * nx) xb_add(&bar[XB_TOPGEN], 1u);
            else XB_SPIN(xb_ld(&bar[XB_TOPGEN]) == tg, bar);
            __builtin_amdgcn_fence(__ATOMIC_ACQUIRE, "agent");
            xb_add(&bar[XB_XGEN(b.x)], 1u);
            asm volatile("s_waitcnt vmcnt(0)" ::: "memory");
        } else {
            XB_SPIN(xb_ld(&bar[XB_XGEN(b.x)]) == gen, bar);
            __builtin_amdgcn_fence(__ATOMIC_ACQUIRE, "agent");
            asm volatile("s_waitcnt vmcnt(0)" ::: "memory");
        }
    }
    __syncthreads();
}

struct Args { const float* in[25]; float* out; unsigned char* ws; int ph_lo, ph_hi; };
struct Frame {
    LAS unsigned char* lds;
    int tid, lane, wave, vcu, G;
    const Args* a; float* out; unsigned char* ws;
};
enum { I_X = 0, I_N1W, I_WIN, I_ARE, I_AIM, I_LOGDT, I_BRE, I_BIM, I_CRE, I_CIM, I_D, I_WGLU, I_BGLU, I_PECK, I_WCK1, I_WCK2, I_PECV, I_WCV1, I_WCV2, I_WOUT, I_N2W, I_WUP, I_WDOWN, I_REL, I_NFW };

__device__ __forceinline__ void p0_transpose_item(const float* W, int K, int N, int Npad, bf16_t* WT, const float* scale, LAS float* scr, int item, int lane) {
    const int nblk = Npad / 64, kb = item / nblk, nb = item % nblk, k0 = 64 * kb, n0 = 64 * nb;
    const int rr = lane >> 4, cc = lane & 15, n = n0 + 4 * cc;
    f32x4 v[16];
#pragma unroll
    for (int i = 0; i < 16; ++i) { v[i] = (f32x4){0.f, 0.f, 0.f, 0.f}; if (n < N) v[i] = *(const f32x4*)(W + (size_t)(k0 + 4 * i + rr) * N + n); }
#pragma unroll
    for (int i = 0; i < 16; ++i) { const int kk = 4 * i + rr; f32x4 x = v[i]; if (scale) x = x * scale[k0 + kk];
        LAS float* d = scr + kk * 65 + 4 * cc; d[0] = x[0]; d[1] = x[1]; d[2] = x[2]; d[3] = x[3]; }
    LDS_WAIT();
    const int c = lane & 7;
#pragma unroll
    for (int j = 0; j < 8; ++j) { const int nn = (lane >> 3) + 8 * j; const LAS float* s = scr + (8 * c) * 65 + nn;
        u32x4 o; o.x = pk2(s[0 * 65], s[1 * 65]); o.y = pk2(s[2 * 65], s[3 * 65]); o.z = pk2(s[4 * 65], s[5 * 65]); o.w = pk2(s[6 * 65], s[7 * 65]);
        *(u32x4*)(WT + (size_t)(n0 + nn) * K + k0 + 8 * c) = o; }
    LDS_WAIT();
}
__device__ __forceinline__ void late_transposes(Frame& F, int part) {
    LAS float* scr = (LAS float*)(F.lds + F.wave * 16896);
    const int gw = F.vcu * NWAVES + F.wave, NGW = F.G * NWAVES, lane = F.lane;
    unsigned char* ws = F.ws;
    constexpr int T_GLU = (1024 / 64) * (1024 / 64), T_OUT = (DM / 64) * (DM / 64), T_UP = (DM / 64) * (DFF / 64), T_DOWN = (DFF / 64) * (DM / 64);
    if (part == 0) {
        int g2 = gw, n2 = NGW;
        if (F.G > 64) { if (blockIdx.x < 32) return; g2 = ((int)blockIdx.x - 32) * NWAVES + F.wave; n2 = (F.G - 32) * NWAVES; }
        for (int it = g2; it < T_GLU + T_OUT + T_UP; it += n2) {
            if (it < T_UP) p0_transpose_item(F.a->in[I_WUP], DM, DFF, DFF, (bf16_t*)(ws + WS_WUP), F.a->in[I_N2W], scr, it, lane);
            else if (it < T_UP + T_OUT) p0_transpose_item(F.a->in[I_WOUT], DM, DM, DM, (bf16_t*)(ws + WS_WOUT), nullptr, scr, it - T_UP, lane);
            else p0_transpose_item(F.a->in[I_WGLU], 1024, 1024, 1024, (bf16_t*)(ws + WS_WGLU), nullptr, scr, it - T_UP - T_OUT, lane);
        }
    } else {
        for (int it = gw; it < T_DOWN; it += NGW) p0_transpose_item(F.a->in[I_WDOWN], DFF, DM, DM, (bf16_t*)(ws + WS_WDOWN), nullptr, scr, it, lane);
    }
}
__device__ __forceinline__ void p0_prologue(Frame& F) {
    LAS float* scr = (LAS float*)(F.lds + F.wave * 16896);
    const int gw = F.vcu * NWAVES + F.wave, NGW = F.G * NWAVES, lane = F.lane;
    unsigned char* ws = F.ws;
    constexpr int T_IN = (DM / 64) * (NPROJ / 64), T_C1 = (2048 / 64) * (256 / 64), T_C2 = (256 / 64) * (64 / 64);
    constexpr int NITEMS = T_IN + 2 * T_C1 + 2 * T_C2;
    for (int it = gw; it < NITEMS; it += NGW) {
        int r = it;
        if (r < T_IN) { p0_transpose_item(F.a->in[I_WIN], DM, D_IN, NPROJ, (bf16_t*)(ws + WS_WIN), F.a->in[I_N1W], scr, r, lane); continue; } r -= T_IN;
        if (r < T_C1) { p0_transpose_item(F.a->in[I_WCK1], 2048, 256, 256, (bf16_t*)(ws + WS_WC1K), nullptr, scr, r, lane); continue; } r -= T_C1;
        if (r < T_C1) { p0_transpose_item(F.a->in[I_WCV1], 2048, 256, 256, (bf16_t*)(ws + WS_WC1V), nullptr, scr, r, lane); continue; } r -= T_C1;
        if (r < T_C2) { p0_transpose_item(F.a->in[I_WCK2], 256, 64, 64, (bf16_t*)(ws + WS_WC2K), nullptr, scr, r, lane); continue; } r -= T_C2;
        p0_transpose_item(F.a->in[I_WCV2], 256, 64, 64, (bf16_t*)(ws + WS_WC2V), nullptr, scr, r, lane);
    }
    {
        const float* x = F.a->in[I_X]; bf16_t* xb = (bf16_t*)(ws + WS_XB); float* r1 = (float*)(ws + WS_R1);
        for (int mrow = gw; mrow < MTOK; mrow += NGW) {
            const f32x4* xr = (const f32x4*)(x + (size_t)mrow * DM) + lane; u32x2* o8 = (u32x2*)(xb + (size_t)mrow * DM) + lane;
            f32x4 v[8]; float s = 0.f;
#pragma unroll
            for (int j = 0; j < 8; ++j) { v[j] = xr[64 * j]; s += (v[j].x * v[j].x + v[j].y * v[j].y) + (v[j].z * v[j].z + v[j].w * v[j].w); }
            s = wave_sum(s);
#pragma unroll
            for (int j = 0; j < 8; ++j) { u32x2 w; w.x = pk2(v[j].x, v[j].y); w.y = pk2(v[j].z, v[j].w); o8[64 * j] = w; }
            if (lane == 0) r1[mrow] = __builtin_amdgcn_rsqf(s * (1.f / DM) + EPS);
        }
    }
    {
        const int idx = gw * 64 + lane;
        if (idx < 4096) {
            const int g = idx >> 6;
            const float dt = expf(F.a->in[I_LOGDT][g]); const float ar = F.a->in[I_ARE][idx], ai = F.a->in[I_AIM][idx];
            const float em1 = expm1f(dt * ar), th = dt * ai, c = cosf(th), s = sinf(th), sh = sinf(0.5f * th);
            const float mag = em1 + 1.f, abr = mag * c, abi = mag * s;
            const float zr = em1 * c - 2.f * sh * sh, zi = abi;
            const float den = ar * ar + ai * ai;
            const float cr = (zr * ar + zi * ai) / den, ci = (zi * ar - zr * ai) / den;
            const float magS = expf(512.f * dt * ar), thS = 512.f * th;
            f32x4 ab; ab.x = abr; ab.y = abi; ab.z = magS * cosf(thS); ab.w = magS * sinf(thS);
            ((f32x4*)(ws + WS_S5AB))[idx] = ab;
            bf16_t* bre = (bf16_t*)(ws + WS_BRE) + (size_t)idx * 16; bf16_t* bim = (bf16_t*)(ws + WS_BIM) + (size_t)idx * 16;
            const float* sbr = F.a->in[I_BRE] + (size_t)idx * 16; const float* sbi = F.a->in[I_BIM] + (size_t)idx * 16;
#pragma unroll
            for (int h = 0; h < 16; ++h) { const float br = sbr[h], bi = sbi[h]; bre[h] = (bf16_t)f2bf(cr * br - ci * bi); bim[h] = (bf16_t)f2bf(cr * bi + ci * br); }
        }
        const int i2 = gw * 64 + lane;
        if (i2 < 64 * 16 * 64) { bf16_t* cm = (bf16_t*)(ws + WS_CM); ((unsigned*)cm)[i2] = pk2(F.a->in[I_CRE][i2], -F.a->in[I_CIM][i2]); }
        if (i2 < 2048) { const int h = i2 >> 7, d = i2 & 127; ((float*)(ws + WS_BTAB))[i2] = F.a->in[I_REL][(int)T5B[d] * 16 + h] * LOG2E; }
    }
    for (int it = gw; it < 2 * 32 * 4; it += NGW) {
        const int which = it >> 7, ks = (it >> 2) & 31, jg = it & 3;
        const float* pe = F.a->in[which ? I_PECV : I_PECK] + ks * 64; const float* w1 = F.a->in[which ? I_WCV1 : I_WCK1] + (size_t)(ks * 64) * 256 + jg * 64 + lane;
        float a = 0.f;
#pragma unroll 16
        for (int k = 0; k < 64; ++k) a += pe[k] * w1[(size_t)k * 256];
        ((float*)(ws + WS_CBP))[(which * 32 + ks) * 256 + jg * 64 + lane] = a;
    }
    for (int idx = gw * 64 + lane; idx < MTOK; idx += NGW * 64) { ((float*)(ws + CTL_SS1))[idx] = 0.f; ((float*)(ws + CTL_SS2))[idx] = 0.f; }
}
__device__ __forceinline__ void cmp_bias_reduce(Frame& F) {
    if (blockIdx.x != 0) return;
    const float* p = (const float*)(F.ws + WS_CBP); float* o = (float*)(F.ws + WS_CBF);
    const int which = F.tid >> 8, col = F.tid & 255; float a = 0.f;
    for (int ks = 0; ks < 32; ++ks) a += p[(which * 32 + ks) * 256 + col];
    o[which * 256 + col] = a;
}

template <bool FINAL>
__device__ __forceinline__ void s5_item(Frame& F, int b, int g, int seg) {
    const int lane = F.lane, pp = lane & 31, hi = lane >> 5;
    unsigned char* ws = F.ws;
    LAS unsigned char* L = F.lds + F.wave * 16896;
    const bf16_t* proj = (const bf16_t*)(ws + WS_PROJ);
    const f32x4 ab = ((const f32x4*)(ws + WS_S5AB))[g * 64 + lane];
    const float ar = ab.x, ai = ab.y;
    const bf16_t* bre = (const bf16_t*)(ws + WS_BRE) + (size_t)g * 64 * 16; const bf16_t* bim = (const bf16_t*)(ws + WS_BIM) + (size_t)g * 64 * 16;
    const bf16x8 bre0 = *(const bf16x8*)(bre + pp * 16 + 8 * hi), bre1 = *(const bf16x8*)(bre + (32 + pp) * 16 + 8 * hi);
    const bf16x8 bim0 = *(const bf16x8*)(bim + pp * 16 + 8 * hi), bim1 = *(const bf16x8*)(bim + (32 + pp) * 16 + 8 * hi);
    f32x2* segend = (f32x2*)(ws + WS_SEG) + (size_t)((b * 64 + g) * 8) * 64;
    float sr = 0.f, si = 0.f;
    bf16x8 cf[4]; f32x4 dv = {0.f, 0.f, 0.f, 0.f};
    if (FINAL) {
        for (int s2 = 0; s2 < seg; ++s2) { const f32x2 e = segend[s2 * 64 + lane]; const float nr = ab.z * sr - ab.w * si + e.x, ni = ab.z * si + ab.w * sr + e.y; sr = nr; si = ni; }
        const bf16_t* cm = (const bf16_t*)(ws + WS_CM) + (size_t)(g * 16 + (lane & 15)) * 128 + 8 * (lane >> 4);
#pragma unroll
        for (int ks = 0; ks < 4; ++ks) cf[ks] = *(const bf16x8*)(cm + 32 * ks);
        dv = *(const f32x4*)(F.a->in[I_D] + g * 16 + 4 * (lane >> 4));
    }
    bf16_t* zb = (bf16_t*)(ws + WS_Z);
    const bf16_t* up = proj + ((size_t)b * SEQ + seg * 512 + pp) * NPROJ + COL_U + g * 16 + 8 * hi;
    asm volatile("" :: "v"(bre0), "v"(bre1), "v"(bim0), "v"(bim1), "v"(ab));
    if (FINAL) asm volatile("" :: "v"(cf[0]), "v"(cf[1]), "v"(cf[2]), "v"(cf[3]), "v"(dv));
    const bf16_t* up2 = proj + ((size_t)b * SEQ + seg * 512 + (lane & 15)) * NPROJ + COL_U + g * 16 + 4 * (lane >> 4);
    u32x2 uu_next0 = {0u, 0u}, uu_next1 = {0u, 0u};
    if (FINAL) { uu_next0 = *(const u32x2*)up2; uu_next1 = *(const u32x2*)(up2 + (size_t)16 * NPROJ); }
    bf16x8 ua_next = *(const bf16x8*)up;
    for (int ch = 0; ch < 16; ++ch) {
        const size_t row0 = (size_t)b * SEQ + seg * 512 + ch * 32;
        const bf16x8 ua = ua_next;
        ua_next = *(const bf16x8*)(up + (size_t)(ch < 15 ? ch + 1 : 15) * 32 * NPROJ);
        const u32x2 uu_cur[2] = {uu_next0, uu_next1};
        if (FINAL) { const bf16_t* q2 = up2 + (size_t)(ch < 15 ? ch + 1 : 15) * 32 * NPROJ; uu_next0 = *(const u32x2*)q2; uu_next1 = *(const u32x2*)(q2 + (size_t)16 * NPROJ); }
        const f32x16 z16 = {};
        const f32x16 re0 = __builtin_amdgcn_mfma_f32_32x32x16_bf16(ua, bre0, z16, 0, 0, 0), im0 = __builtin_amdgcn_mfma_f32_32x32x16_bf16(ua, bim0, z16, 0, 0, 0);
        const f32x16 re1 = __builtin_amdgcn_mfma_f32_32x32x16_bf16(ua, bre1, z16, 0, 0, 0), im1 = __builtin_amdgcn_mfma_f32_32x32x16_bf16(ua, bim1, z16, 0, 0, 0);
#pragma unroll
        for (int r = 0; r < 16; ++r) { const int t = crow(r, hi);
            *(LAS f32x2*)(L + t * 528 + 8 * pp) = (f32x2){re0[r], im0[r]};
            *(LAS f32x2*)(L + t * 528 + 8 * (32 + pp)) = (f32x2){re1[r], im1[r]}; }
        LDS_WAIT();
#pragma unroll 8
        for (int t = 0; t < 32; ++t) {
            const f32x2 xv = *(const LAS f32x2*)(L + t * 528 + 8 * lane);
            const float nr = ar * sr - ai * si + xv.x, ni = ar * si + ai * sr + xv.y; sr = nr; si = ni;
            if (FINAL) *(LAS unsigned*)(L + t * 528 + 4 * lane) = pk2(sr, si);
        }
        if (FINAL) {
            LDS_WAIT();
#pragma unroll
            for (int tt = 0; tt < 2; ++tt) {
                f32x4 acc = {0.f, 0.f, 0.f, 0.f};
#pragma unroll
                for (int ks = 0; ks < 4; ++ks) { const bf16x8 sb = *(const LAS bf16x8*)(L + (16 * tt + (lane & 15)) * 528 + (32 * ks + 8 * (lane >> 4)) * 2);
                    acc = __builtin_amdgcn_mfma_f32_16x16x32_bf16(cf[ks], sb, acc, 0, 0, 0); }
                const size_t row = row0 + 16 * tt + (lane & 15);
                const u32x2 uu = uu_cur[tt];
                const float y0 = acc[0] + dv[0] * bflo(uu.x), y1 = acc[1] + dv[1] * bfhi(uu.x), y2 = acc[2] + dv[2] * bflo(uu.y), y3 = acc[3] + dv[3] * bfhi(uu.y);
                u32x2 w; w.x = pk2(gelu_tanh(y0), gelu_tanh(y1)); w.y = pk2(gelu_tanh(y2), gelu_tanh(y3));
                *(u32x2*)(zb + row * 1024 + g * 16 + 4 * (lane >> 4)) = w;
            }
        }
        LDS_WAIT();
    }
    if (!FINAL) segend[seg * 64 + lane] = (f32x2){sr, si};
}
__device__ __forceinline__ void cmul(float& cr, float& ci, float ar, float ai, float br, float bi) { cr = ar * br - ai * bi; ci = ar * bi + ai * br; }
__device__ __forceinline__ void s5_pass1_item(Frame& F, int b, int g, int seg) {
    const int lane = F.lane, pp = lane & 31, hi = lane >> 5;
    unsigned char* ws = F.ws;
    const bf16_t* proj = (const bf16_t*)(ws + WS_PROJ);
    const bf16_t* bre = (const bf16_t*)(ws + WS_BRE) + (size_t)g * 64 * 16; const bf16_t* bim = (const bf16_t*)(ws + WS_BIM) + (size_t)g * 64 * 16;
    const bf16x8 bre0 = *(const bf16x8*)(bre + pp * 16 + 8 * hi), bre1 = *(const bf16x8*)(bre + (32 + pp) * 16 + 8 * hi);
    const bf16x8 bim0 = *(const bf16x8*)(bim + pp * 16 + 8 * hi), bim1 = *(const bf16x8*)(bim + (32 + pp) * 16 + 8 * hi);
    float wr[2][16], wi[2][16], a32r[2], a32i[2];
#pragma unroll
    for (int T = 0; T < 2; ++T) {
        const f32x4 ab = ((const f32x4*)(ws + WS_S5AB))[g * 64 + 32 * T + pp];
        float pr[4], pi[4];
        pr[0] = 1.f; pi[0] = 0.f; pr[1] = ab.x; pi[1] = ab.y; cmul(pr[2], pi[2], ab.x, ab.y, ab.x, ab.y); cmul(pr[3], pi[3], pr[2], pi[2], ab.x, ab.y);
        float q4r, q4i, q8r, q8i, q16r, q16i, q24r, q24i;
        cmul(q4r, q4i, pr[2], pi[2], pr[2], pi[2]); cmul(q8r, q8i, q4r, q4i, q4r, q4i); cmul(q16r, q16i, q8r, q8i, q8r, q8i); cmul(q24r, q24i, q16r, q16i, q8r, q8i);
        const float fr = hi ? 1.f : q4r, fi = hi ? 0.f : q4i;
        const float br_[4] = {1.f, q8r, q16r, q24r}, bi_[4] = {0.f, q8i, q16i, q24i};
#pragma unroll
        for (int r = 0; r < 16; ++r) {
            float tr, ti; cmul(tr, ti, br_[3 - (r >> 2)], bi_[3 - (r >> 2)], pr[3 - (r & 3)], pi[3 - (r & 3)]);
            cmul(wr[T][r], wi[T][r], tr, ti, fr, fi);
        }
        float t28r, t28i; cmul(t28r, t28i, q24r, q24i, q4r, q4i); cmul(a32r[T], a32i[T], t28r, t28i, q4r, q4i);
    }
    float sr[2] = {0.f, 0.f}, si[2] = {0.f, 0.f};
    const bf16_t* up = proj + ((size_t)b * SEQ + seg * 512 + pp) * NPROJ + COL_U + g * 16 + 8 * hi;
    asm volatile("" :: "v"(bre0), "v"(bre1), "v"(bim0), "v"(bim1));
    bf16x8 ua_next = *(const bf16x8*)up;
    for (int ch = 0; ch < 16; ++ch) {
        const bf16x8 ua = ua_next;
        ua_next = *(const bf16x8*)(up + (size_t)(ch < 15 ? ch + 1 : 15) * 32 * NPROJ);
        const f32x16 z16 = {};
        const f32x16 re0 = __builtin_amdgcn_mfma_f32_32x32x16_bf16(ua, bre0, z16, 0, 0, 0), im0 = __builtin_amdgcn_mfma_f32_32x32x16_bf16(ua, bim0, z16, 0, 0, 0);
        const f32x16 re1 = __builtin_amdgcn_mfma_f32_32x32x16_bf16(ua, bre1, z16, 0, 0, 0), im1 = __builtin_amdgcn_mfma_f32_32x32x16_bf16(ua, bim1, z16, 0, 0, 0);
        float e0r = 0.f, e0i = 0.f, e1r = 0.f, e1i = 0.f;
#pragma unroll
        for (int r = 0; r < 16; ++r) {
            e0r += wr[0][r] * re0[r] - wi[0][r] * im0[r]; e0i += wr[0][r] * im0[r] + wi[0][r] * re0[r];
            e1r += wr[1][r] * re1[r] - wi[1][r] * im1[r]; e1i += wr[1][r] * im1[r] + wi[1][r] * re1[r];
        }
        e0r = pair_sum(e0r); e0i = pair_sum(e0i); e1r = pair_sum(e1r); e1i = pair_sum(e1i);
        float nr, ni;
        cmul(nr, ni, a32r[0], a32i[0], sr[0], si[0]); sr[0] = nr + e0r; si[0] = ni + e0i;
        cmul(nr, ni, a32r[1], a32i[1], sr[1], si[1]); sr[1] = nr + e1r; si[1] = ni + e1i;
    }
    f32x2* segend = (f32x2*)(ws + WS_SEG) + (size_t)((b * 64 + g) * 8) * 64;
    segend[seg * 64 + 32 * hi + pp] = hi ? (f32x2){sr[1], si[1]} : (f32x2){sr[0], si[0]};
}
template <bool FINAL> __device__ __forceinline__ void s5_phase(Frame& F) {
    int gw = F.vcu * NWAVES + F.wave, NGW = F.G * NWAVES;
    if (!FINAL && F.G > 64) { if (blockIdx.x < 32) return; gw = ((int)blockIdx.x - 32) * NWAVES + F.wave; NGW = (F.G - 32) * NWAVES; }
    for (int it = gw; it < BATCH * 64 * 8; it += NGW) { const int g = it & 63, bs = it >> 6; if (FINAL) s5_item<true>(F, bs >> 3, g, bs & 7); else s5_pass1_item(F, bs >> 3, g, bs & 7); }
}

__device__ __forceinline__ void cmp2_phase(Frame& F) {
    const int gw = F.vcu * NWAVES + F.wave, NGW = F.G * NWAVES, lane = F.lane, pp = lane & 31, hi = lane >> 5;
    unsigned char* ws = F.ws;
    for (int it = gw; it < 256; it += NGW) {
        const int which = it >> 7, rt = it & 127;
        const bf16_t* Hc = (const bf16_t*)(ws + WS_HC) + (size_t)which * 4096 * 256 + (size_t)(32 * rt + pp) * 256 + 8 * hi;
        const bf16_t* W2 = (const bf16_t*)(ws + (which ? WS_WC2V : WS_WC2K)) + (size_t)pp * 256 + 8 * hi;
        bf16_t* O = (bf16_t*)(ws + (which ? WS_VCMP : WS_KCMP));
        f32x16 a0 = {}, a1 = {};
#pragma unroll 4
        for (int ks = 0; ks < 16; ++ks) { const bf16x8 a = *(const bf16x8*)(Hc + 16 * ks), b0 = *(const bf16x8*)(W2 + 16 * ks), b1 = *(const bf16x8*)(W2 + 32 * 256 + 16 * ks);
            a0 = __builtin_amdgcn_mfma_f32_32x32x16_bf16(a, b0, a0, 0, 0, 0); a1 = __builtin_amdgcn_mfma_f32_32x32x16_bf16(a, b1, a1, 0, 0, 0); }
        if (which == 0) {
#pragma unroll
            for (int r = 0; r < 16; ++r) { const int row = 32 * rt + crow(r, hi); const bool zero = (row & 255) == 255;
                O[(size_t)row * 64 + pp] = zero ? (bf16_t)0 : (bf16_t)f2bf(a0[r]); O[(size_t)row * 64 + 32 + pp] = zero ? (bf16_t)0 : (bf16_t)f2bf(a1[r]); }
        } else {
            bf16_t* OT = (bf16_t*)(ws + WS_VCT);
#pragma unroll
            for (int c = 0; c < 4; ++c) { const int row = 32 * rt + 8 * c + 4 * hi; const int bgx = row >> 8, n = row & 255;
                float x0[4], x1[4];
#pragma unroll
                for (int e = 0; e < 4; ++e) { const bool zero = (n + e) == 255; x0[e] = zero ? 0.f : a0[4 * c + e]; x1[e] = zero ? 0.f : a1[4 * c + e]; }
                *(u32x2*)(OT + ((size_t)bgx * 64 + pp) * 256 + n) = (u32x2){pk2(x0[0], x0[1]), pk2(x0[2], x0[3])};
                *(u32x2*)(OT + ((size_t)bgx * 64 + 32 + pp) * 256 + n) = (u32x2){pk2(x1[0], x1[1]), pk2(x1[2], x1[3])}; }
        }
    }
}

namespace att {
constexpr int KSTR = 144, VSTR = 136, KVB = 64 * KSTR + 64 * VSTR;
constexpr int BIAS_OFF = 2 * KVB, WSCR_OFF = BIAS_OFF + 2048, IMP_OFF = WSCR_OFF + 8 * 256, SEL_OFF = IMP_OFF + 64 * 65 * 4, OT_OFF = SEL_OFF + 512, OT_STR = 68, OT_WAVE = 32 * OT_STR * 4, TAB2_OFF = OT_OFF + 8 * OT_WAVE, TAB2_N = 640, END_OFF = TAB2_OFF + 4 * TAB2_N * 4;
static_assert(END_OFF <= MISC_OFF, "attention LDS map");
constexpr float NEG = -1e30f, MFLOOR = -1e20f, THR = 6.f;
enum { CMP_A = 0, CMP_B = 1, SLC = 2, WIN = 3 };
struct TileRegs { u32x4 k, v; };
struct Src { const bf16_t* k; size_t kstride; const bf16_t* vt; size_t vstride; };
struct Ctx {
    LAS unsigned char* lds; int tid, lane, wave, q, hi, tl, head, t, i;
    bf16x8 qr[4];
};
__device__ __forceinline__ void load_tile(TileRegs& R, const Src& S, int key0, int tid) {
    const int r = tid >> 3, c = tid & 7;
    R.k = *(const u32x4*)(S.k + (size_t)(key0 + r) * S.kstride + c * 8);
    R.v = *(const u32x4*)(S.vt + (size_t)r * S.vstride + key0 + c * 8);
}
__device__ __forceinline__ void store_tile(const TileRegs& R, LAS unsigned char* lds, int buf, int tid) {
    const int r = tid >> 3, c = tid & 7;
    LAS unsigned char* b = lds + buf * KVB;
    *(LAS u32x4*)(b + r * KSTR + c * 16) = R.k;
    *(LAS u32x2*)(b + 64 * KSTR + r * VSTR + c * 16) = (u32x2){R.v.x, R.v.y};
    *(LAS u32x2*)(b + 64 * KSTR + r * VSTR + c * 16 + 8) = (u32x2){R.v.z, R.v.w};
}
__device__ __forceinline__ void qk_tile(f32x16& p0, f32x16& p1, const f32x16& cin, const Ctx& C, int buf) {
    const LAS unsigned char* kl = C.lds + buf * KVB + C.q * KSTR + 16 * C.hi;
    bf16x8 kf[8];
#pragma unroll
    for (int d0 = 0; d0 < 4; ++d0) { kf[2 * d0] = *(const LAS bf16x8*)(kl + 32 * d0); kf[2 * d0 + 1] = *(const LAS bf16x8*)(kl + 32 * KSTR + 32 * d0); }
    __builtin_amdgcn_sched_barrier(0);
    p0 = __builtin_amdgcn_mfma_f32_32x32x16_bf16(kf[0], C.qr[0], cin, 0, 0, 0); p1 = __builtin_amdgcn_mfma_f32_32x32x16_bf16(kf[1], C.qr[0], cin, 0, 0, 0);
#pragma unroll
    for (int d0 = 1; d0 < 4; ++d0) { p0 = __builtin_amdgcn_mfma_f32_32x32x16_bf16(kf[2 * d0], C.qr[d0], p0, 0, 0, 0); p1 = __builtin_amdgcn_mfma_f32_32x32x16_bf16(kf[2 * d0 + 1], C.qr[d0], p1, 0, 0, 0); }
}
template <int MODE> __device__ __forceinline__ void mask_bias(f32x16& p0, f32x16& p1, const Ctx& C, int kbase, bool sel) {
    const LAS float* bt = (const LAS float*)(C.lds + BIAS_OFF) + C.head * 128;
    const int d00 = (MODE == CMP_A || MODE == CMP_B) ? (C.t - 31 - 16 * (kbase + 4 * C.hi)) : (C.t - kbase - 4 * C.hi);
    float bv[2][16];
#pragma unroll
    for (int T = 0; T < 2; ++T)
#pragma unroll
        for (int r = 0; r < 16; ++r) {
            const int ko = 32 * T + (r & 3) + 8 * (r >> 2);
            const int dist = (MODE == CMP_A || MODE == CMP_B) ? (d00 - 16 * ko) : (d00 - ko);
            const int di = dist < 0 ? 0 : (dist > 127 ? 127 : dist);
            bv[T][r] = bt[di];
        }
    __builtin_amdgcn_sched_barrier(0);
#pragma unroll
    for (int T = 0; T < 2; ++T)
#pragma unroll
        for (int r = 0; r < 16; ++r) {
            const int ko = 32 * T + (r & 3) + 8 * (r >> 2);
            const int dist = (MODE == CMP_A || MODE == CMP_B) ? (d00 - 16 * ko) : (d00 - ko);
            bool valid = dist >= 0; if (MODE == WIN) valid = valid && dist < 512; if (MODE == SLC) valid = valid && sel;
            if (T == 0) p0[r] = valid ? p0[r] + bv[T][r] : NEG; else p1[r] = valid ? p1[r] + bv[T][r] : NEG;
        }
}
__device__ __forceinline__ void mask_bias2(f32x16& p0, f32x16& p1, const Ctx& C, int kbase) {
    const int d00 = C.t - kbase - 4 * C.hi;
    const LAS float* bp = (const LAS float*)(C.lds + TAB2_OFF) + C.head * TAB2_N + (d00 + 4);
#pragma unroll
    for (int T = 0; T < 2; ++T) {
        float bv[16];
#pragma unroll
        for (int r = 0; r < 16; ++r) bv[r] = bp[59 - (32 * T + (r & 3) + 8 * (r >> 2))];
        __builtin_amdgcn_sched_barrier(0);
#pragma unroll
        for (int r = 0; r < 16; ++r) { if (T == 0) p0[r] += bv[r]; else p1[r] += bv[r]; }
        __builtin_amdgcn_sched_barrier(0);
    }
}
__device__ __forceinline__ float tile_max(const f32x16& p0, const f32x16& p1) {
    float a = fmaxf(fmaxf(p0[0], p1[0]), p0[1]), b = fmaxf(fmaxf(p1[1], p0[2]), p1[2]);
#pragma unroll
    for (int r = 3; r < 15; r += 2) { a = fmaxf(fmaxf(a, p0[r]), p1[r]); b = fmaxf(fmaxf(b, p0[r + 1]), p1[r + 1]); }
    a = fmaxf(fmaxf(a, p0[15]), p1[15]);
    return pair_max(fmaxf(a, b));
}
__device__ __forceinline__ void v_load(bf16x8 (&vf)[8], const Ctx& C, int buf) {
    const LAS unsigned char* vl = C.lds + buf * KVB + 64 * KSTR + C.q * VSTR + 8 * C.hi;
#pragma unroll
    for (int db = 0; db < 2; ++db)
#pragma unroll
        for (int T = 0; T < 2; ++T)
#pragma unroll
            for (int s = 0; s < 2; ++s) {
                const LAS unsigned char* a = vl + db * 32 * VSTR + (32 * T + 16 * s) * 2;
                const u32x2 lo = *(const LAS u32x2*)a, hi2 = *(const LAS u32x2*)(a + 16);
                const u32x4 vv = {lo.x, lo.y, hi2.x, hi2.y};
                vf[db * 4 + T * 2 + s] = __builtin_bit_cast(bf16x8, vv);
            }
}
__device__ __forceinline__ void pv_mma(f32x16 (&o)[2], const f32x16& p0, const f32x16& p1, const bf16x8 (&vf)[8]) {
    bf16x8 pa[2][2];
#pragma unroll
    for (int s = 0; s < 2; ++s) {
        u32x4 w0, w1;
        w0.x = pk2(p0[8 * s + 0], p0[8 * s + 1]); w0.y = pk2(p0[8 * s + 2], p0[8 * s + 3]); w0.z = pk2(p0[8 * s + 4], p0[8 * s + 5]); w0.w = pk2(p0[8 * s + 6], p0[8 * s + 7]);
        w1.x = pk2(p1[8 * s + 0], p1[8 * s + 1]); w1.y = pk2(p1[8 * s + 2], p1[8 * s + 3]); w1.z = pk2(p1[8 * s + 4], p1[8 * s + 5]); w1.w = pk2(p1[8 * s + 6], p1[8 * s + 7]);
        pa[0][s] = __builtin_bit_cast(bf16x8, w0); pa[1][s] = __builtin_bit_cast(bf16x8, w1);
    }
#pragma unroll
    for (int T = 0; T < 2; ++T)
#pragma unroll
        for (int s = 0; s < 2; ++s)
#pragma unroll
            for (int db = 0; db < 2; ++db) o[db] = __builtin_amdgcn_mfma_f32_32x32x16_bf16(pa[T][s], vf[db * 4 + T * 2 + s], o[db], 0, 0, 0);
}
__device__ __forceinline__ void row_scale(f32x16 (&o)[2], float fq_, const Ctx& C) {
    LAS float* wsc = (LAS float*)(C.lds + WSCR_OFF + C.wave * 256);
    wsc[C.q] = fq_; LDS_WAIT();
#pragma unroll
    for (int r = 0; r < 16; ++r) { const float f = wsc[crow(r, C.hi)]; o[0][r] *= f; o[1][r] *= f; }
    LDS_WAIT();
}
template <bool FIRST> __device__ __forceinline__ void row_fma(const f32x16 (&o)[2], float fq_, const Ctx& C) {
    LAS float* wsc = (LAS float*)(C.lds + WSCR_OFF + C.wave * 256);
    LAS float* otl = (LAS float*)(C.lds + OT_OFF + C.wave * OT_WAVE) + C.q;
    wsc[C.q] = fq_; LDS_WAIT();
#pragma unroll
    for (int r = 0; r < 16; ++r) { const int row = crow(r, C.hi); const float f = wsc[row];
        if (FIRST) { otl[row * OT_STR] = o[0][r] * f; otl[row * OT_STR + 32] = o[1][r] * f; }
        else { otl[row * OT_STR] += o[0][r] * f; otl[row * OT_STR + 32] += o[1][r] * f; } }
    LDS_WAIT();
}
struct Soft { float mref, l; bool set; f32x16 negm; };

template <int MODE>
__device__ __forceinline__ void branch(const Ctx& C, const Src& S, int jlo, int jhi, Soft& st, float& m, float& l, f32x16 (&o)[2], float inv_l, unsigned sel_lo, unsigned sel_hi) {
    TileRegs R; load_tile(R, S, 64 * jlo, C.tid);
    const float far_bias = ((const LAS float*)(C.lds + BIAS_OFF))[C.head * 128 + 127];
    store_tile(R, C.lds, 0, C.tid);
    __syncthreads();
    if (jlo + 1 <= jhi) load_tile(R, S, 64 * (jlo + 1), C.tid);
#pragma unroll 1
    for (int j = jlo; j <= jhi; ++j) {
        const int buf = (j - jlo) & 1;
        f32x16 p0, p1;
        const bool cfar = (MODE == CMP_A || MODE == CMP_B) && (1024 * j + 1167 <= 64 * C.i);
        if (MODE == CMP_A) {
            if (cfar) { f32x16 cin;
#pragma unroll
                for (int r = 0; r < 16; ++r) cin[r] = far_bias;
                qk_tile(p0, p1, cin, C, buf); }
            else { const f32x16 z = {}; qk_tile(p0, p1, z, C, buf); mask_bias<MODE>(p0, p1, C, 64 * j, true); }
            const float mt = tile_max(p0, p1), mn = fmaxf(m, mt), alpha = fexp2(m - mn);
            float s = 0.f;
#pragma unroll
            for (int r = 0; r < 16; ++r) s += fexp2(p0[r] - mn) + fexp2(p1[r] - mn);
            l = l * alpha + s; m = mn;
        } else if (MODE == CMP_B) {
            f32x16 cin;
#pragma unroll
            for (int r = 0; r < 16; ++r) cin[r] = cfar ? far_bias - m : -m;
            qk_tile(p0, p1, cin, C, buf);
            bf16x8 vf[8]; v_load(vf, C, buf);
            if (!cfar) mask_bias<MODE>(p0, p1, C, 64 * j, true);
#pragma unroll
            for (int r = 0; r < 16; ++r) { p0[r] = fexp2(p0[r]) * inv_l; p1[r] = fexp2(p1[r]) * inv_l; }
            LAS float* imp = (LAS float*)(C.lds + IMP_OFF) + C.tl * 65;
#pragma unroll
            for (int T = 0; T < 2; ++T)
#pragma unroll
                for (int c = 0; c < 4; ++c) {
                    const float e0 = T ? p1[4 * c] : p0[4 * c], e1 = T ? p1[4 * c + 1] : p0[4 * c + 1], e2 = T ? p1[4 * c + 2] : p0[4 * c + 2], e3 = T ? p1[4 * c + 3] : p0[4 * c + 3];
                    float mainv = (e0 + e1) + (e2 + 0.5f * e3), carry = 0.5f * e3;
                    mainv += __shfl_xor(mainv, 1); mainv += __shfl_xor(mainv, 2); carry += __shfl_xor(carry, 1); carry += __shfl_xor(carry, 2);
                    const int sb = 16 * j + 8 * T + 2 * c + C.hi;
                    if (C.head == 0) { (void)__hip_atomic_fetch_add(imp + sb, mainv, __ATOMIC_RELAXED, __HIP_MEMORY_SCOPE_WORKGROUP); if (sb + 1 < 64) (void)__hip_atomic_fetch_add(imp + sb + 1, carry, __ATOMIC_RELAXED, __HIP_MEMORY_SCOPE_WORKGROUP); }
                }
            pv_mma(o, p0, p1, vf);
        } else {
            const int delta = C.i - j;
            const bool sel = (MODE == SLC) ? (((j < 32 ? (sel_lo >> j) : (sel_hi >> (j - 32))) & 1u) != 0u) : true;
            if (MODE != SLC || __any(sel)) {
                const bool near = delta <= 2 || (MODE == WIN && delta >= 8);
                if (near) {
                    const float c = sel ? -st.mref : NEG;
                    f32x16 cin;
#pragma unroll
                    for (int r = 0; r < 16; ++r) cin[r] = c;
                    qk_tile(p0, p1, cin, C, buf);
                    mask_bias2(p0, p1, C, 64 * j);
                } else if (MODE == SLC && !__all(sel)) {
                    f32x16 cin;
#pragma unroll
                    for (int r = 0; r < 16; ++r) cin[r] = sel ? st.negm[r] : NEG;
                    qk_tile(p0, p1, cin, C, buf);
                } else qk_tile(p0, p1, st.negm, C, buf);
                bf16x8 vf[8]; v_load(vf, C, buf);
                __builtin_amdgcn_sched_barrier(0);
                const float mx = tile_max(p0, p1);
                const bool need = st.set ? (mx > THR) : (mx > 0.5f * NEG);
                if (__any(need)) {
                    const float dl = need ? mx : 0.f;
                    const float f = (need && st.set) ? fexp2(-dl) : 1.f;
                    st.mref += dl; st.l *= f; st.set = st.set || need;
#pragma unroll
                    for (int r = 0; r < 16; ++r) { p0[r] -= dl; p1[r] -= dl; st.negm[r] = far_bias - st.mref; }
                    row_scale(o, f, C);
                }
                float s = 0.f;
#pragma unroll
                for (int r = 0; r < 16; ++r) { p0[r] = fexp2(p0[r]); p1[r] = fexp2(p1[r]); s += p0[r] + p1[r]; }
                st.l += s;
                pv_mma(o, p0, p1, vf);
            }
        }
        if (j < jhi) store_tile(R, C.lds, buf ^ 1, C.tid);
        __syncthreads();
        if (j + 2 <= jhi) load_tile(R, S, 64 * (j + 2), C.tid);
    }
}

__device__ __forceinline__ void attn_unit(Frame& F, int b, int g, int i, bool tables) {
    unsigned char* ws = F.ws;
    const bf16_t* proj = (const bf16_t*)(ws + WS_PROJ);
    int tid_ = threadIdx.x; asm volatile("" : "+v"(tid_));
    Ctx C; C.lds = F.lds; C.tid = tid_; C.lane = tid_ & 63; C.wave = F.wave; C.q = C.lane & 31; C.hi = C.lane >> 5; C.tl = 8 * F.wave + (C.q >> 2); C.head = C.q & 3; C.i = i; C.t = 64 * i + C.tl;
    const size_t row = (size_t)b * SEQ + C.t;
    const int hq = g * 4 + C.head;
#pragma unroll
    for (int d0 = 0; d0 < 4; ++d0) C.qr[d0] = *(const bf16x8*)(proj + row * NPROJ + COL_Q + hq * 64 + 16 * d0 + 8 * C.hi);
    float gate[3];
#pragma unroll
    for (int j = 0; j < 3; ++j) gate[j] = sigmoidf_(bf2f(proj[row * NPROJ + COL_GL + hq * 3 + j]));
    for (int idx = C.tid; idx < 64 * 65; idx += 512) ((LAS float*)(C.lds + IMP_OFF))[idx] = 0.f;
    if (tables) {
        ((LAS float*)(C.lds + BIAS_OFF))[C.tid] = ((const float*)(ws + WS_BTAB))[(g * 4 + (C.tid >> 7)) * 128 + (C.tid & 127)];
        for (int idx = C.tid; idx < 4 * TAB2_N; idx += 512) { const int h = idx / TAB2_N, d = idx % TAB2_N - 63;
            ((LAS float*)(C.lds + TAB2_OFF))[idx] = (d < 0 || d >= 512) ? NEG : ((const float*)(ws + WS_BTAB))[(g * 4 + h) * 128 + (d > 127 ? 127 : d)]; }
    }
    __syncthreads();
    const float far_bias = ((const LAS float*)(C.lds + BIAS_OFF))[C.head * 128 + 127];
    f32x16 o[2];
    float m, l;
    Soft st;
    const int bg = b * 4 + g;
    {
        const Src S{(const bf16_t*)(ws + WS_KCMP) + (size_t)(bg * 256) * 64, 64, (const bf16_t*)(ws + WS_VCT) + (size_t)(bg * 64) * 256, 256};
        const int nkt = (4 * i + 2) / 64 + 1;
        m = MFLOOR; l = 0.f; o[0] = f32x16{}; o[1] = f32x16{};
        branch<CMP_A>(C, S, 0, nkt - 1, st, m, l, o, 0.f, 0u, 0u);
        const float lt = pair_sum(l), inv = lt > 0.f ? 1.f / lt : 0.f;
        branch<CMP_B>(C, S, 0, nkt - 1, st, m, l, o, inv, 0u, 0u);
        row_fma<true>(o, gate[0], C);
    }
    {
        LDS_WAIT();
        LAS unsigned char* selb = C.lds + SEL_OFF;
        if (i >= 16) {
            const int tk = C.lane >> 3, cg = C.lane & 7;
            LAS unsigned* rowb = (LAS unsigned*)(C.lds + IMP_OFF) + (8 * C.wave + tk) * 65;
            unsigned long long kc[8]; unsigned cnt[8];
#pragma unroll
            for (int c = 0; c < 8; ++c) { const int s = cg * 8 + c; unsigned xb = rowb[s];
                xb = (s == 0 || s == i || s == i - 1) ? 0x461c4000u   : xb;
                rowb[s] = xb; kc[c] = ((unsigned long long)xb << 6) | (unsigned)(63 - s); cnt[c] = 0u; }
            LDS_WAIT();
            for (int s2 = 0; s2 <= i; ++s2) {
                const unsigned long long k2 = ((unsigned long long)rowb[s2] << 6) | (unsigned)(63 - s2);
#pragma unroll
                for (int c = 0; c < 8; ++c) cnt[c] += (k2 > kc[c]) ? 1u : 0u;
            }
            unsigned bits = 0;
#pragma unroll
            for (int c = 0; c < 8; ++c) { const int s = cg * 8 + c; if (cnt[c] < 16u && s <= i) bits |= 1u << c; }
            selb[(8 * C.wave + tk) * 8 + cg] = (unsigned char)bits;
        } else {
            if (C.lane < 8) { const unsigned long long mk = (2ull << i) - 1ull; *(LAS unsigned long long*)(selb + (8 * C.wave + C.lane) * 8) = mk; }
        }
        LDS_WAIT();
    }
    const u32x2 selw = *(const LAS u32x2*)(C.lds + SEL_OFF + C.tl * 8);
    {
        const Src S{proj + (size_t)b * SEQ * NPROJ + COL_KS + g * 64, NPROJ, (const bf16_t*)(ws + WS_VST) + (size_t)(bg * 64) * SEQ, SEQ};
        st.mref = 0.f; st.l = 0.f; st.set = false; o[0] = f32x16{}; o[1] = f32x16{};
#pragma unroll
        for (int r = 0; r < 16; ++r) st.negm[r] = far_bias;
        branch<SLC>(C, S, 0, i, st, m, l, o, 0.f, selw.x, selw.y);
        const float lt = pair_sum(st.l);
        row_fma<false>(o, gate[1] / lt, C);
    }
    {
        const Src S{proj + (size_t)b * SEQ * NPROJ + COL_KW + g * 64, NPROJ, (const bf16_t*)(ws + WS_VWT) + (size_t)(bg * 64) * SEQ, SEQ};
        st.mref = 0.f; st.l = 0.f; st.set = false; o[0] = f32x16{}; o[1] = f32x16{};
#pragma unroll
        for (int r = 0; r < 16; ++r) st.negm[r] = far_bias;
        branch<WIN>(C, S, i >= 8 ? i - 8 : 0, i, st, m, l, o, 0.f, 0u, 0u);
        const float lt = pair_sum(st.l);
        row_fma<false>(o, gate[2] / lt, C);
    }
    {
        bf16_t* mix = (bf16_t*)(ws + WS_MIX);
        const LAS float* otw = (const LAS float*)(C.lds + OT_OFF + C.wave * OT_WAVE);
#pragma unroll
        for (int k = 0; k < 4; ++k) { const int rowq = 8 * k + (C.lane >> 3), ch = C.lane & 7;
            const f32x4 a = *(const LAS f32x4*)(otw + rowq * OT_STR + ch * 8), c4 = *(const LAS f32x4*)(otw + rowq * OT_STR + ch * 8 + 4);
            u32x4 w; w.x = pk2(a[0], a[1]); w.y = pk2(a[2], a[3]); w.z = pk2(c4[0], c4[1]); w.w = pk2(c4[2], c4[3]);
            const size_t orow = (size_t)b * SEQ + 64 * i + 8 * C.wave + (rowq >> 2);
            *(u32x4*)(mix + orow * DM + 1024 + (g * 4 + (rowq & 3)) * 64 + ch * 8) = w; }
    }
    __syncthreads();
}
__device__ __forceinline__ void attn_phase(Frame& F) {
    for (int v = F.vcu; v < 256; v += F.G) {
        const int bg = v >> 4, s = v & 15;
#pragma unroll 1
        for (int k = 0; k < 4; ++k) { const int i = (k == 0) ? 63 - s : (k == 1) ? 32 + s : (k == 2) ? 31 - s : s; attn_unit(F, bg >> 2, bg & 3, i, k == 0); }
    }
}
}

__device__ __forceinline__ void final_norm_phase(Frame& F) {
    const int gw = F.vcu * NWAVES + F.wave, NGW = F.G * NWAVES, lane = F.lane;
    const float* ss = (const float*)(F.ws + CTL_SS2); const f32x4* nw = (const f32x4*)F.a->in[I_NFW] + 2 * lane;
    for (int mrow = gw; mrow < MTOK; mrow += NGW) {
        const float rs = __builtin_amdgcn_rsqf(ss[mrow] * (1.f / DM) + EPS);
        const u32x4* xr = (const u32x4*)((const bf16_t*)(F.ws + WS_MIX) + (size_t)mrow * DM) + lane;
        f32x4* orow = (f32x4*)(F.out + (size_t)mrow * DM) + 2 * lane;
#pragma unroll
        for (int j = 0; j < 4; ++j) { const u32x4 b = xr[64 * j]; const f32x4 w0 = nw[128 * j], w1 = nw[128 * j + 1];
            orow[128 * j] = (f32x4){bflo(b.x), bfhi(b.x), bflo(b.y), bfhi(b.y)} * rs * w0; orow[128 * j + 1] = (f32x4){bflo(b.z), bfhi(b.z), bflo(b.w), bfhi(b.w)} * rs * w1; }
    }
}

constexpr int N_PHASES = 9;
__global__ void __launch_bounds__(NWAVES * 64, 2) hymba_fwd(Args args) {
    extern __shared__ __attribute__((aligned(16))) unsigned char lds_raw[];
    Frame F;
    F.lds = (LAS unsigned char*)lds_raw;
    F.tid = threadIdx.x; F.lane = F.tid & 63; F.wave = __builtin_amdgcn_readfirstlane(F.tid >> 6);
    F.G = gridDim.x; { const int bx = blockIdx.x; F.vcu = (F.G % 8 == 0) ? (bx % 8) * (F.G / 8) + bx / 8 : bx; }
    F.a = &args; F.out = args.out; F.ws = args.ws;
    unsigned char* ws = args.ws;
    volatile LAS unsigned* MISC = (volatile LAS unsigned*)(F.lds + MISC_OFF);
    if (F.tid < 32) MISC[F.tid] = 0u;
    __syncthreads();
    XcdBarrier bar; bar.bar = (unsigned*)(ws + WS_CTL) + CW_BAR; bar.x = 0; bar.st = nullptr;
    const int lo = args.ph_lo, hi = args.ph_hi;
    const bool multi = (hi - lo) > 1;
    if (multi) bar = xcd_barrier_post((unsigned*)(ws + WS_CTL) + CW_BAR, MISC + 8);
#ifndef REPEAT_PHASE
#define REPEAT_PHASE -1
#endif
#define REP(k) for (int rep_ = 0; rep_ < ((REPEAT_PHASE == (k)) ? 2 : 1); ++rep_)
#ifndef ONLY_PHASE
#define ONLY_PHASE -1
#endif
#define IN(k) ((ONLY_PHASE < 0 || ONLY_PHASE == (k)) && lo <= (k) && (k) < hi)
#define SEAM(k) do { if (IN(k) && IN((k) + 1)) xcd_barrier(bar); } while (0)
    const int cblk = (int)blockIdx.x;

    if (IN(0)) { REP(0) { p0_prologue(F); } SEAM(0); }
    if (IN(1)) {
        pg8::Gemm g{(const bf16_t*)(ws + WS_XB), (const bf16_t*)(ws + WS_WIN), MTOK, NPROJ, DM, DM, 128, 0};
        pg8::StaticOrder S; S.init(MTOK, NPROJ, F.G, cblk);
        pg8::EpiProj E{(bf16_t*)(ws + WS_PROJ), (const float*)(ws + WS_R1), (bf16_t*)(ws + WS_VST), (bf16_t*)(ws + WS_VWT)};
        REP(1) { pg8::gemm_phase<pg8::EpiProj, pg8::StaticOrder, true>(F.lds, g, S, E); }
        cmp_bias_reduce(F);
        SEAM(1);
    }
    if (IN(2)) { REP(2) {
        {
            pg8::Gemm g{(const bf16_t*)(ws + WS_PROJ) + COL_KC, (const bf16_t*)(ws + WS_WC1K), 4096, 256, 2048, 16 * NPROJ, NPROJ * 2, 1};
            pg8::StaticOrder S; S.init(4096, 256, F.G, cblk);
            pg8::EpiCmp E{(bf16_t*)(ws + WS_HC), (const float*)(ws + WS_CBF)};
            pg8::gemm_phase<pg8::EpiCmp, pg8::StaticOrder, true>(F.lds, g, S, E);
        }
        {
            pg8::Gemm g{(const bf16_t*)(ws + WS_PROJ) + COL_VC, (const bf16_t*)(ws + WS_WC1V), 4096, 256, 2048, 16 * NPROJ, NPROJ * 2, 1};
            pg8::StaticOrder S; S.init(4096, 256, F.G, (cblk + F.G - 16) % F.G);
            pg8::EpiCmp E{(bf16_t*)(ws + WS_HC) + (size_t)4096 * 256, (const float*)(ws + WS_CBF) + 256};
            pg8::gemm_phase<pg8::EpiCmp, pg8::StaticOrder, true>(F.lds, g, S, E);
        }
        __syncthreads();
        s5_phase<false>(F);
        late_transposes(F, 0);
        __syncthreads(); }
        SEAM(2);
    }
    if (IN(3)) { REP(3) { if (REPEAT_PHASE != 31) s5_phase<true>(F); if (REPEAT_PHASE != 32) cmp2_phase(F); late_transposes(F, 1); __syncthreads(); } SEAM(3); }
    if (IN(4)) {
        __syncthreads();
        pg8::Gemm g{(const bf16_t*)(ws + WS_Z), (const bf16_t*)(ws + WS_WGLU), MTOK, 1024, 1024, 1024, 128, 0};
        pg8::StaticOrder S; S.init(MTOK, 1024, F.G, cblk);
        pg8::EpiGlu E{(bf16_t*)(ws + WS_MIX), (const bf16_t*)(ws + WS_Z), F.a->in[I_BGLU]};
        for (int rep_ = 0; rep_ < ((REPEAT_PHASE == 40) ? 2 : 1); ++rep_) pg8::gemm_phase<pg8::EpiGlu, pg8::StaticOrder, true>(F.lds, g, S, E);
        __syncthreads();
        REP(4) { att::attn_phase(F); __syncthreads(); }
        SEAM(4);
    }
    if (IN(5)) {
        __syncthreads();
        pg8::Gemm g{(const bf16_t*)(ws + WS_MIX), (const bf16_t*)(ws + WS_WOUT), MTOK, DM, DM, DM, 128, 0};
        pg8::StaticOrder S; S.init(MTOK, DM, F.G, cblk);
        pg8::EpiRes<false> E{F.a->in[I_X], (bf16_t*)(ws + WS_X1B), (float*)(ws + CTL_SS1)};
        pg8::gemm_phase<pg8::EpiRes<false>, pg8::StaticOrder, true>(F.lds, g, S, E);
        SEAM(5);
    }
    if (IN(6)) {
        pg8::Gemm g{(const bf16_t*)(ws + WS_X1B), (const bf16_t*)(ws + WS_WUP), MTOK, DFF, DM, DM, 128, 0};
        pg8::StaticOrder S; S.init(MTOK, DFF, F.G, cblk);
        pg8::EpiUp E{(bf16_t*)(ws + WS_HID), (const float*)(ws + CTL_SS1)};
        REP(6) { pg8::gemm_phase<pg8::EpiUp, pg8::StaticOrder, true>(F.lds, g, S, E); }
        SEAM(6);
    }
    if (IN(7)) {
        pg8::Gemm g{(const bf16_t*)(ws + WS_HID), (const bf16_t*)(ws + WS_WDOWN), MTOK, DM, DFF, DFF, 128, 0};
        pg8::StaticOrder S; S.init(MTOK, DM, F.G, cblk);
        pg8::EpiRes<true> E{(const bf16_t*)(ws + WS_X1B), (bf16_t*)(ws + WS_MIX), (float*)(ws + CTL_SS2)};
        pg8::gemm_phase<pg8::EpiRes<true>, pg8::StaticOrder, true>(F.lds, g, S, E);
        SEAM(7);
    }
    if (IN(8)) final_norm_phase(F);
#undef IN
#undef SEAM
}

extern "C" void kernel_launch(void* const* d_in, const int* in_sizes, int n_in, void* d_out, int out_size, void* d_ws, size_t ws_size, hipStream_t stream) {
    static int grid = 0;
    if (grid == 0) {
        if (n_in != 25 || in_sizes[0] != MTOK * DM || out_size != MTOK * DM || ws_size < WS_END) {
            fprintf(stderr, "kernel_launch: unexpected shapes (n_in %d, in0 %d, out %d, ws %zu < %zu); nothing launched\n", n_in, n_in > 0 ? in_sizes[0] : -1, out_size, ws_size, (size_t)WS_END); grid = -1; return; }
        int dev = 0, cus = 0, per_cu = 0;
        if (hipGetDevice(&dev) != hipSuccess || hipDeviceGetAttribute(&cus, hipDeviceAttributeMultiprocessorCount, dev) != hipSuccess) { grid = -1; return; }
        if (hipFuncSetAttribute((const void*)hymba_fwd, hipFuncAttributeMaxDynamicSharedMemorySize, LDS_BYTES) != hipSuccess) { fprintf(stderr, "kernel_launch: hipFuncSetAttribute failed\n"); grid = -1; return; }
        if (hipOccupancyMaxActiveBlocksPerMultiprocessor(&per_cu, (const void*)hymba_fwd, NWAVES * 64, LDS_BYTES) != hipSuccess || per_cu < 1) { fprintf(stderr, "kernel_launch: occupancy query says %d blocks per CU\n", per_cu); per_cu = 1; }
        (void)hipGetLastError();
        grid = cus;
    }
    if (grid < 0) return;
    if (MK_N_LAUNCHES == 1) { if (hipMemsetAsync((char*)d_ws + WS_CTL, 0, CTL_ZERO_BYTES, stream) != hipSuccess) return; }
    Args a{};
    for (int i = 0; i < 25; ++i) a.in[i] = (const float*)d_in[i];
    a.out = (float*)d_out; a.ws = (unsigned char*)d_ws;
    if (MK_N_LAUNCHES == 1) {
        a.ph_lo = 0; a.ph_hi = N_PHASES;
        void* kargs[] = {&a};
        hipError_t e = hipLaunchCooperativeKernel((const void*)hymba_fwd, dim3(grid), dim3(NWAVES * 64), kargs, LDS_BYTES, stream);
        if (e != hipSuccess) fprintf(stderr, "kernel_launch: cooperative launch failed: %s (grid %d)\n", hipGetErrorString(e), grid);
    } else {
        for (int p = 0; p < N_PHASES; ++p) { a.ph_lo = p; a.ph_hi = p + 1; hipLaunchKernelGGL(hymba_fwd, dim3(grid), dim3(NWAVES * 64), LDS_BYTES, stream, a); }
    }
}
```

```cpp
#include <hip/hip_runtime.h>
#include <cstdio>
#include <cstdint>

#ifndef MK_N_LAUNCHES
#define MK_N_LAUNCHES 1
#endif

#define LAS __attribute__((address_space(3)))
#define GAS __attribute__((address_space(1)))
typedef unsigned short bf16_t;
typedef short bf16x8 __attribute__((ext_vector_type(8)));
typedef float f32x2 __attribute__((ext_vector_type(2)));
typedef float f32x4 __attribute__((ext_vector_type(4)));
typedef float f32x16 __attribute__((ext_vector_type(16)));
typedef unsigned u32x2 __attribute__((ext_vector_type(2)));
typedef unsigned u32x4 __attribute__((ext_vector_type(4)));
typedef __bf16 bf16x2_t __attribute__((ext_vector_type(2)));

#define LDS_WAIT() asm volatile("s_waitcnt lgkmcnt(0)" ::: "memory")
#define VM_WAIT() asm volatile("s_waitcnt vmcnt(0)" ::: "memory")

constexpr int BATCH = 4, SEQ = 4096, DM = 2048, MTOK = BATCH * SEQ, DFF = 8192;
constexpr int D_IN = 3632, NPROJ = 3840;
constexpr int COL_U = 0, COL_Q = 1024, COL_KC = 2048, COL_VC = 2304, COL_KS = 2560, COL_VS = 2816, COL_KW = 3072, COL_VW = 3328, COL_GL = 3584;
constexpr float EPS = 1e-6f;
constexpr float LOG2E = 1.4426950408889634f;
constexpr float C2 = 0.125f * LOG2E;
constexpr int NWAVES = 8;

constexpr size_t MiB = 1u << 20;
constexpr size_t WS_CTL = 0, CTL_ZERO_BYTES = 1 * MiB;
constexpr int CW_BAR = 4096;
constexpr size_t CTL_SS1 = 256 * 1024, CTL_SS2 = 512 * 1024, CTL_CB = 768 * 1024;
constexpr size_t WS_R1 = 1 * MiB, WS_BTAB = 1 * MiB + 64 * 1024, WS_S5AB = 1 * MiB + 128 * 1024, WS_CBP = 1 * MiB + 256 * 1024  , WS_CBF = 1 * MiB + 384 * 1024  ;
constexpr size_t WS_BRE = 2 * MiB, WS_BIM = 2 * MiB + 128 * 1024, WS_CM = 2 * MiB + 256 * 1024;
constexpr size_t WS_SEG = 3 * MiB;
constexpr size_t WS_WIN = 4 * MiB, WS_WGLU = 19 * MiB, WS_WOUT = 21 * MiB, WS_WUP = 29 * MiB, WS_WDOWN = 61 * MiB, WS_WC1K = 93 * MiB, WS_WC1V = 94 * MiB,
                 WS_WC2K = 95 * MiB, WS_WC2V = 95 * MiB + 64 * 1024;
constexpr size_t WS_X1B = 100 * MiB, WS_MIX = 164 * MiB, WS_HID = 228 * MiB;
constexpr size_t WS_XB = 228 * MiB, WS_PROJ = 292 * MiB, WS_Z = 412 * MiB, WS_HC = 444 * MiB, WS_KCMP = 448 * MiB, WS_VCMP = 448 * MiB + 512 * 1024;
constexpr size_t WS_VST = 450 * MiB, WS_VWT = 458 * MiB, WS_VCT = 466 * MiB;
constexpr size_t WS_END = 484 * MiB;

constexpr int LDS_BYTES = 147456;
constexpr int MISC_OFF = 135168 + 4096;

__device__ __forceinline__ unsigned f2bf(float f) { unsigned u = __builtin_bit_cast(unsigned, f); return (u + 0x7fffu + ((u >> 16) & 1u)) >> 16; }
__device__ __forceinline__ unsigned pk2(float lo, float hi) { f32x2 v = {lo, hi}; bf16x2_t b = __builtin_convertvector(v, bf16x2_t); return __builtin_bit_cast(unsigned, b); }
__device__ __forceinline__ float bf2f(unsigned b) { return __builtin_bit_cast(float, b << 16); }
__device__ __forceinline__ float bflo(unsigned w) { return __builtin_bit_cast(float, w << 16); }
__device__ __forceinline__ float bfhi(unsigned w) { return __builtin_bit_cast(float, w & 0xffff0000u); }
__device__ __forceinline__ float fexp2(float x) { return __builtin_amdgcn_exp2f(x); }
__device__ __forceinline__ float frcp(float x) { return __builtin_amdgcn_rcpf(x); }
__device__ __forceinline__ float sigmoidf_(float x) { return frcp(1.f + fexp2(-x * LOG2E)); }
__device__ __forceinline__ float gelu_tanh(float x) {
    const float u = 0.7978845608028654f * (x + 0.044715f * x * x * x);
    return x * frcp(1.f + fexp2(-2.f * LOG2E * u));
}
__device__ __forceinline__ int crow(int r, int hi) { return (r & 3) + 8 * (r >> 2) + 4 * hi; }
__device__ __forceinline__ float wave_sum(float v) {
#pragma unroll
    for (int o = 1; o < 64; o <<= 1) v += __shfl_xor(v, o);
    return v;
}
__device__ __forceinline__ float pair_max(float v) {
    unsigned a = __builtin_bit_cast(unsigned, v), b = a; asm volatile("" : "+v"(b));
    auto rr = __builtin_amdgcn_permlane32_swap(a, b, false, false);
    unsigned r0 = rr[0], r1 = rr[1]; asm volatile("" : "+v"(r0), "+v"(r1));
    return fmaxf(__builtin_bit_cast(float, r0), __builtin_bit_cast(float, r1));
}
__device__ __forceinline__ float pair_sum(float v) {
    unsigned a = __builtin_bit_cast(unsigned, v), b = a; asm volatile("" : "+v"(b));
    auto rr = __builtin_amdgcn_permlane32_swap(a, b, false, false);
    unsigned r0 = rr[0], r1 = rr[1]; asm volatile("" : "+v"(r0), "+v"(r1));
    return __builtin_bit_cast(float, r0) + __builtin_bit_cast(float, r1);
}

__device__ const unsigned char T5B[128] = {0, 1, 2, 3, 4, 5, 6, 7, 8, 9, 10, 11, 12, 13, 14, 15, 16, 16, 16, 17, 17, 18, 18, 18, 19, 19, 19, 20, 20, 20, 20, 21, 21, 21, 21, 22, 22, 22, 22, 22, 23, 23, 23, 23, 23, 23,
    24, 24, 24, 24, 24, 24, 25, 25, 25, 25, 25, 25, 25, 26, 26, 26, 26, 26, 26, 26, 26, 27, 27, 27, 27, 27, 27, 27, 27, 27, 27, 28, 28, 28, 28, 28, 28, 28, 28, 28, 28, 29, 29, 29, 29, 29, 29, 29, 29, 29, 29, 29, 29,
    30, 30, 30, 30, 30, 30, 30, 30, 30, 30, 30, 30, 30, 30, 31, 31, 31, 31, 31, 31, 31, 31, 31, 31, 31, 31, 31, 31, 31};

namespace pg8 {
constexpr int BM = 256, BK = 64, HALF = 128, HTB = HALF * BK * 2, STAGE_BYTES = 8 * HTB, NXCD = 8, WGM = 8;
__host__ __device__ __forceinline__ int lds_byte(int r, int c) { const int st = (r >> 4) * 2 + (c >> 5), rr = r & 15, cc = c & 31, ob = rr * 64 + cc * 2; return st * 1024 + (ob ^ (((ob >> 9) & 1) << 5)); }
__host__ __device__ __forceinline__ void stage_rc(int b, int& R, int& C) { const int st = b / 1024, sb = b % 1024, swz = sb ^ (((sb >> 9) & 1) << 5); R = (st >> 1) * 16 + swz / 64; C = (st & 1) * 32 + (swz % 64) / 2; }
__host__ __device__ __forceinline__ int perm32(int rho) { const int n = rho >> 4, i = rho & 15; return 8 * (i >> 2) + 4 * n + (i & 3); }

struct Unit { int pm, pn; };
struct Gemm { const bf16_t* A; const bf16_t* Bt; int M, N, K; int lda; int a_kstep; int amode; };
__device__ __forceinline__ const char* a_base(const Gemm& g, int pm) {
    if (g.amode == 0) return (const char*)g.A + (size_t)pm * (size_t)BM * (size_t)g.lda * 2;
    return (const char*)g.A + ((size_t)(pm >> 2) * SEQ * NPROJ + (size_t)(pm & 3) * 64) * 2;
}

struct StaticOrder {
    int nM, nN, nwg, G, c;
    __host__ __device__ void init(int M, int N, int G_, int c_) { nM = M / BM; nN = N / BM; nwg = nM * nN; G = G_; c = c_; }
    __host__ __device__ bool next(int i, Unit& u) const {
        const long L = (long)i * G + c; if (L >= nwg) return false;
        int wgid = (int)L; { const int q = nwg / NXCD, r = nwg % NXCD, xcd = wgid % NXCD, off = wgid / NXCD; wgid = (xcd < r ? xcd * (q + 1) : r * (q + 1) + (xcd - r) * q) + off; }
        const int nig = WGM * nN, gid = wgid / nig, fm = gid * WGM, gsz = (nM - fm) < WGM ? (nM - fm) : WGM;
        u.pm = fm + ((wgid % nig) % gsz); u.pn = (wgid % nig) / gsz; return true;
    }
};

typedef f32x4 Acc[2][2][4][2];

template <class Epi, class Sched, bool ALIGN_EPI = true>
__device__ __forceinline__ void gemm_phase(LAS unsigned char* lds, const Gemm g, const Sched& S, const Epi& E) {
    const int tid = threadIdx.x, wid = __builtin_amdgcn_readfirstlane(tid >> 6), lane = tid & 63, wr = wid >> 2, wc = wid & 3, fr = lane & 15, fq = lane >> 4;
    const int K = g.K, nt = K / BK;
    unsigned voffA[2], voffB[2];
#pragma unroll
    for (int i = 0; i < 2; ++i) { int R, C; stage_rc(tid * 16 + i * 8192, R, C); const int Rb = (R & ~31) + perm32(R & 31);
        voffA[i] = (unsigned)(R * g.lda + C) * 2u; voffB[i] = (unsigned)(Rb * K + C) * 2u; }
    const size_t kstepA = (size_t)g.a_kstep, kstepB = (size_t)(BK * 2);
    const size_t hstepA = (size_t)HALF * g.lda * 2, hstepB = (size_t)HALF * K * 2;
    const size_t tstepB = 2 * hstepB;
    const unsigned ldsw = (unsigned)wid * 1024u;
    const int aoff = lds_byte(wr * 64 + fr, fq * 8), boff = lds_byte(wc * 32 + fr, fq * 8);
#define PG8_SA(b, h) (((b) * 2 + (h)) * HTB)
#define PG8_SB(b, h) ((4 + (b) * 2 + (h)) * HTB)
#define PG8_STAGE(bufoff, gbase, voff) do { _Pragma("unroll") for (int _i = 0; _i < 2; ++_i) \
        __builtin_amdgcn_global_load_lds((const unsigned*)((const char*)(gbase) + (voff)[_i]), (LAS unsigned*)(lds + (bufoff) + ldsw + _i * 8192), 16, 0, 0); } while (0)
#define PG8_LDA(dst, b, h) do { _Pragma("unroll") for (int m = 0; m < 4; ++m) _Pragma("unroll") for (int k = 0; k < 2; ++k) dst[m][k] = *(const LAS bf16x8*)(lds + PG8_SA(b, h) + aoff + m * 2048 + k * 1024); } while (0)
#define PG8_LDB(dst, b, h) do { _Pragma("unroll") for (int n = 0; n < 2; ++n) _Pragma("unroll") for (int k = 0; k < 2; ++k) dst[n][k] = *(const LAS bf16x8*)(lds + PG8_SB(b, h) + boff + n * 2048 + k * 1024); } while (0)
#define PG8_MMA(ai, bj, At, Bt) do { __builtin_amdgcn_s_setprio(1); _Pragma("unroll") for (int m = 0; m < 4; ++m) _Pragma("unroll") for (int n = 0; n < 2; ++n) _Pragma("unroll") for (int k = 0; k < 2; ++k) \
        acc[ai][bj][m][n] = __builtin_amdgcn_mfma_f32_16x16x32_bf16(Bt[n][k], At[m][k], acc[ai][bj][m][n], 0, 0, 0); __builtin_amdgcn_s_setprio(0); } while (0)
#define PG8_WAIT_V(n) asm volatile("s_waitcnt vmcnt(" #n ")" ::: "memory")
#define PG8_WAIT_L(n) asm volatile("s_waitcnt lgkmcnt(" #n ")" ::: "memory")
#define PG8_BAR __builtin_amdgcn_s_barrier()
#define PG8_SCHED __builtin_amdgcn_sched_barrier(0)
    Unit cur, nxt; int ui = 0;
    if (!S.next(0, cur)) return;
    f32x4 acc[2][2][4][2];
#pragma unroll
    for (int a = 0; a < 2; ++a)
#pragma unroll
        for (int b = 0; b < 2; ++b)
#pragma unroll
            for (int m = 0; m < 4; ++m)
#pragma unroll
                for (int n = 0; n < 2; ++n) acc[a][b][m][n] = (f32x4){0.f, 0.f, 0.f, 0.f};
    bf16x8 At[4][2], B0[2][2], B1[2][2];
    const char* cA = a_base(g, cur.pm); const char* cB = (const char*)g.Bt + (size_t)cur.pn * tstepB;
    PG8_STAGE(PG8_SB(0, 0), cB, voffB); PG8_STAGE(PG8_SB(0, 1), cB + hstepB, voffB); PG8_STAGE(PG8_SA(0, 0), cA, voffA); PG8_STAGE(PG8_SA(0, 1), cA + hstepA, voffA);
    if (wr == 1) PG8_BAR;
    PG8_WAIT_V(2); PG8_BAR;
    PG8_STAGE(PG8_SB(1, 0), cB + kstepB, voffB); PG8_STAGE(PG8_SA(1, 0), cA + kstepA, voffA); PG8_STAGE(PG8_SB(1, 1), cB + hstepB + kstepB, voffB);
    PG8_WAIT_V(6); PG8_BAR;
    for (;;) {
        const bool has_next = S.next(ui + 1, nxt);
        const char* nA = has_next ? a_base(g, nxt.pm) : cA; const char* nB = has_next ? (const char*)g.Bt + (size_t)nxt.pn * tstepB : cB;
        for (int t = 0; t < nt; t += 2) {
            const bool last = (t == nt - 2);
            const char* a1 = cA + (size_t)(t + 1) * kstepA;
            const char* a2 = last ? nA : cA + (size_t)(t + 2) * kstepA; const char* b2 = last ? nB : cB + (size_t)(t + 2) * kstepB;
            const char* a3 = a2 + kstepA; const char* b3 = b2 + kstepB;
            PG8_LDB(B0, 0, 0); PG8_LDB(B1, 0, 1); PG8_SCHED; PG8_LDA(At, 0, 0); PG8_STAGE(PG8_SA(1, 1), a1 + hstepA, voffA);
            PG8_WAIT_V(8); PG8_WAIT_L(0); PG8_BAR; PG8_MMA(0, 0, At, B0); PG8_MMA(0, 1, At, B1); PG8_BAR; PG8_SCHED;
            PG8_LDA(At, 0, 1); PG8_STAGE(PG8_SB(0, 0), b2, voffB); PG8_STAGE(PG8_SB(0, 1), b2 + hstepB, voffB); PG8_STAGE(PG8_SA(0, 0), a2, voffA);
            PG8_WAIT_V(8); PG8_WAIT_L(0); PG8_BAR; PG8_MMA(1, 0, At, B0); PG8_MMA(1, 1, At, B1); PG8_BAR; PG8_SCHED;
            PG8_LDB(B0, 1, 0); PG8_LDB(B1, 1, 1); PG8_SCHED; PG8_LDA(At, 1, 0); PG8_STAGE(PG8_SA(0, 1), a2 + hstepA, voffA);
            PG8_WAIT_V(8); PG8_WAIT_L(0); PG8_BAR; PG8_MMA(0, 0, At, B0); PG8_MMA(0, 1, At, B1); PG8_BAR; PG8_SCHED;
            PG8_LDA(At, 1, 1); PG8_STAGE(PG8_SB(1, 0), b3, voffB); PG8_STAGE(PG8_SB(1, 1), b3 + hstepB, voffB); PG8_STAGE(PG8_SA(1, 0), a3, voffA);
            PG8_WAIT_V(8); PG8_WAIT_L(0); PG8_BAR; PG8_MMA(1, 0, At, B0); PG8_MMA(1, 1, At, B1); PG8_BAR; PG8_SCHED;
        }
        if constexpr (ALIGN_EPI) { if (wr == 0) PG8_BAR; }
        E(acc, cur, wr, wc, fr, fq);
        if (!has_next) break;
#pragma unroll
        for (int a = 0; a < 2; ++a)
#pragma unroll
            for (int b = 0; b < 2; ++b)
#pragma unroll
                for (int m = 0; m < 4; ++m)
#pragma unroll
                    for (int n = 0; n < 2; ++n) acc[a][b][m][n] = (f32x4){0.f, 0.f, 0.f, 0.f};
        cur = nxt; cA = nA; cB = nB; ++ui;
        if constexpr (ALIGN_EPI) { if (wr == 1) PG8_BAR; }
    }
    PG8_WAIT_V(0);
    if constexpr (!ALIGN_EPI) { if (wr == 0) PG8_BAR; }
    PG8_BAR;
#undef PG8_SA
#undef PG8_SB
#undef PG8_STAGE
#undef PG8_LDA
#undef PG8_LDB
#undef PG8_MMA
#undef PG8_WAIT_V
#undef PG8_WAIT_L
#undef PG8_BAR
#undef PG8_SCHED
}

#define EPI_ROWS_BEGIN const int row0 = u.pm * BM + wr * 64 + fr; const int col0 = u.pn * BM + wc * 32 + 8 * fq; \
    _Pragma("unroll") for (int ai = 0; ai < 2; ++ai) _Pragma("unroll") for (int m = 0; m < 4; ++m) { const int row = row0 + ai * HALF + m * 16;
#define EPI_ROWS_END }

struct EpiProj {
    bf16_t* O; const float* r1; bf16_t* vst; bf16_t* vwt;
    __device__ __forceinline__ void operator()(const Acc& acc, const Unit& u, int wr, int wc, int fr, int fq) const {
        const float sc = (u.pn >= 4 && u.pn < 8) ? C2 : 1.f;
        if (u.pn == 11 || u.pn == 13) {
            bf16_t* vt = (u.pn == 11) ? vst : vwt;
            const int cl = wc * 32 + 8 * fq;
            EPI_ROWS_BEGIN
                const float rs = r1[row]; const int bb = row >> 12, tok = row & (SEQ - 1);
#pragma unroll
                for (int bj = 0; bj < 2; ++bj) { const int c0 = cl + bj * HALF; bf16_t* bp = vt + ((size_t)(bb * 4 + (c0 >> 6)) * 64 + (c0 & 63)) * SEQ + tok;
#pragma unroll
                    for (int e = 0; e < 4; ++e) { bp[(size_t)e * SEQ] = (bf16_t)f2bf(acc[ai][bj][m][0][e] * rs); bp[(size_t)(4 + e) * SEQ] = (bf16_t)f2bf(acc[ai][bj][m][1][e] * rs); } }
            EPI_ROWS_END
            (void)col0;
            return;
        }
        EPI_ROWS_BEGIN
            const float rs = r1[row] * sc; bf16_t* rowp = O + (size_t)row * NPROJ + col0;
#pragma unroll
            for (int bj = 0; bj < 2; ++bj) { const f32x4 v0 = acc[ai][bj][m][0] * rs, v1 = acc[ai][bj][m][1] * rs;
                u32x4 w; w.x = pk2(v0[0], v0[1]); w.y = pk2(v0[2], v0[3]); w.z = pk2(v1[0], v1[1]); w.w = pk2(v1[2], v1[3]);
                *(u32x4*)(rowp + bj * HALF) = w; }
        EPI_ROWS_END
    }
};
struct EpiCmp {
    bf16_t* O; const float* bias;
    __device__ __forceinline__ void operator()(const Acc& acc, const Unit& u, int wr, int wc, int fr, int fq) const {
        const int bc = wc * 32 + 8 * fq;
        f32x4 bv[2][2];
#pragma unroll
        for (int bj = 0; bj < 2; ++bj)
#pragma unroll
            for (int n = 0; n < 2; ++n) bv[bj][n] = *(const f32x4*)(bias + bc + bj * HALF + 4 * n);
        EPI_ROWS_BEGIN
            bf16_t* rowp = O + (size_t)row * 256 + col0;
#pragma unroll
            for (int bj = 0; bj < 2; ++bj) { const f32x4 v0 = acc[ai][bj][m][0] + bv[bj][0], v1 = acc[ai][bj][m][1] + bv[bj][1];
                u32x4 w; w.x = pk2(gelu_tanh(v0[0]), gelu_tanh(v0[1])); w.y = pk2(gelu_tanh(v0[2]), gelu_tanh(v0[3])); w.z = pk2(gelu_tanh(v1[0]), gelu_tanh(v1[1])); w.w = pk2(gelu_tanh(v1[2]), gelu_tanh(v1[3]));
                *(u32x4*)(rowp + bj * HALF) = w; }
        EPI_ROWS_END
    }
};
struct EpiGlu {
    bf16_t* O; const bf16_t* Z; const float* bias;
    __device__ __forceinline__ void operator()(const Acc& acc, const Unit& u, int wr, int wc, int fr, int fq) const {
        f32x4 bv[2][2];
#pragma unroll
        for (int bj = 0; bj < 2; ++bj)
#pragma unroll
            for (int n = 0; n < 2; ++n) bv[bj][n] = *(const f32x4*)(bias + u.pn * BM + wc * 32 + 8 * fq + bj * HALF + 4 * n);
        EPI_ROWS_BEGIN
            bf16_t* rowp = O + (size_t)row * DM + col0; const bf16_t* zp = Z + (size_t)row * 1024 + col0;
#pragma unroll
            for (int bj = 0; bj < 2; ++bj) { const f32x4 v0 = acc[ai][bj][m][0] + bv[bj][0], v1 = acc[ai][bj][m][1] + bv[bj][1];
                const u32x4 zz = *(const u32x4*)(zp + bj * HALF);
                u32x4 w; w.x = pk2(bflo(zz.x) * sigmoidf_(v0[0]), bfhi(zz.x) * sigmoidf_(v0[1])); w.y = pk2(bflo(zz.y) * sigmoidf_(v0[2]), bfhi(zz.y) * sigmoidf_(v0[3]));
                w.z = pk2(bflo(zz.z) * sigmoidf_(v1[0]), bfhi(zz.z) * sigmoidf_(v1[1])); w.w = pk2(bflo(zz.w) * sigmoidf_(v1[2]), bfhi(zz.w) * sigmoidf_(v1[3]));
                *(u32x4*)(rowp + bj * HALF) = w; }
        EPI_ROWS_END
    }
};
template <bool BF> struct EpiRes {
    const void* base; bf16_t* ob; float* ss;
    __device__ __forceinline__ void operator()(const Acc& acc, const Unit& u, int wr, int wc, int fr, int fq) const {
        EPI_ROWS_BEGIN
            const size_t off = (size_t)row * DM + col0; float q = 0.f;
#pragma unroll
            for (int bj = 0; bj < 2; ++bj) { f32x4 b0, b1;
                if (BF) { const u32x4 bb = *(const u32x4*)((const bf16_t*)base + off + bj * HALF); b0 = (f32x4){bflo(bb.x), bfhi(bb.x), bflo(bb.y), bfhi(bb.y)}; b1 = (f32x4){bflo(bb.z), bfhi(bb.z), bflo(bb.w), bfhi(bb.w)}; }
                else { b0 = *(const f32x4*)((const float*)base + off + bj * HALF); b1 = *(const f32x4*)((const float*)base + off + bj * HALF + 4); }
                const f32x4 v0 = acc[ai][bj][m][0] + b0, v1 = acc[ai][bj][m][1] + b1;
                q += (v0[0] * v0[0] + v0[1] * v0[1]) + (v0[2] * v0[2] + v0[3] * v0[3]) + (v1[0] * v1[0] + v1[1] * v1[1]) + (v1[2] * v1[2] + v1[3] * v1[3]);
                u32x4 w; w.x = pk2(v0[0], v0[1]); w.y = pk2(v0[2], v0[3]); w.z = pk2(v1[0], v1[1]); w.w = pk2(v1[2], v1[3]); *(u32x4*)(ob + off + bj * HALF) = w; }
            q += __shfl_xor(q, 16); q += __shfl_xor(q, 32);
            if (fq == 0) atomicAdd(ss + row, q);
        EPI_ROWS_END
    }
};
struct EpiUp {
    bf16_t* O; const float* ss;
    __device__ __forceinline__ void operator()(const Acc& acc, const Unit& u, int wr, int wc, int fr, int fq) const {
        EPI_ROWS_BEGIN
            const float rs = __builtin_amdgcn_rsqf(ss[row] * (1.f / DM) + EPS); bf16_t* rowp = O + (size_t)row * DFF + col0;
#pragma unroll
            for (int bj = 0; bj < 2; ++bj) { f32x4 v0 = acc[ai][bj][m][0] * rs, v1 = acc[ai][bj][m][1] * rs;
#pragma unroll
                for (int e = 0; e < 4; ++e) { const float a = fmaxf(v0[e], 0.f), b = fmaxf(v1[e], 0.f); v0[e] = a * a; v1[e] = b * b; }
                u32x4 w; w.x = pk2(v0[0], v0[1]); w.y = pk2(v0[2], v0[3]); w.z = pk2(v1[0], v1[1]); w.w = pk2(v1[2], v1[3]);
                *(u32x4*)(rowp + bj * HALF) = w; }
        EPI_ROWS_END
    }
};
}

typedef GAS unsigned gu32;
#define RLX_AGENT __ATOMIC_RELAXED, __HIP_MEMORY_SCOPE_AGENT
#define XB_TMO      128
#define XB_XCNT(j)  (256  + 64 * (j))
#define XB_XSUB(j)  (1280 + 64 * (j))
#define XB_XGEN(j)  (2304 + 64 * (j))
#define XB_TOP      3328
#define XB_TOPGEN   3392
#define XCD_BAR_WORDS 3456
#define XB_SPIN_CAP (1u << 22)
__device__ __forceinline__ unsigned xb_ld(unsigned* p)              { return __hip_atomic_load(p, __ATOMIC_RELAXED, __HIP_MEMORY_SCOPE_AGENT); }
__device__ __forceinline__ unsigned xb_add(unsigned* p, unsigned v) { return __hip_atomic_fetch_add(p, v, __ATOMIC_RELAXED, __HIP_MEMORY_SCOPE_AGENT); }
__device__ __forceinline__ unsigned xb_xcc_id() { return (unsigned)__builtin_amdgcn_s_getreg((3 << 11) | 20) & 0xFu; }
#define XB_SPIN(cond, bar) do { unsigned _sp = 0; while (cond) { __builtin_amdgcn_s_sleep(1); \
    if ((++_sp & 255u) == 0u) { if (xb_ld(&(bar)[XB_TMO])) break; if (_sp > XB_SPIN_CAP) { atomicAdd(&(bar)[XB_TMO], 1u); break; } } } } while (0)
struct XcdBarrier { unsigned* bar; unsigned x; volatile LAS unsigned* st; };
__device__ __forceinline__ XcdBarrier xcd_barrier_post(unsigned* bar, volatile LAS unsigned* st) {
    XcdBarrier b; b.bar = bar; b.x = xb_xcc_id(); b.st = st;
    if (threadIdx.x == 0) (void)xb_add(&bar[XB_XCNT(b.x)], 1u);
    return b;
}
__device__ __forceinline__ void xcd_barrier_complete(unsigned* bar, unsigned x, unsigned& nloc, unsigned& nx) {
    const unsigned G = gridDim.x * gridDim.y * gridDim.z;
    unsigned sum, cnt, mine, sp = 0u;
    for (;;) {
        sum = 0u; cnt = 0u; mine = 0u;
#pragma unroll
        for (unsigned j = 0; j < 16; ++j) { const unsigned c = xb_ld(&bar[XB_XCNT(j)]); sum += c; cnt += (c > 0u) ? 1u : 0u; mine = (j == x) ? c : mine; }
        if (sum == G) break;
        __builtin_amdgcn_s_sleep(1);
        if ((++sp & 255u) == 0u) { if (xb_ld(&bar[XB_TMO])) break; if (sp > XB_SPIN_CAP) { atomicAdd(&bar[XB_TMO], 1u); break; } }
    }
    nloc = mine > 0u ? mine : 1u; nx = cnt > 0u ? cnt : 1u;
}
__device__ __forceinline__ void xcd_barrier(const XcdBarrier& b) {
    asm volatile("s_waitcnt vmcnt(0)" ::: "memory");
    __syncthreads();
    if (threadIdx.x == 0) {
        unsigned* bar = b.bar;
        __builtin_amdgcn_s_waitcnt(0);
        unsigned nloc = b.st[0], nx = b.st[1];
        if (nloc == 0u) { xcd_barrier_complete(bar, b.x, nloc, nx); b.st[0] = nloc; b.st[1] = nx; }
        const unsigned old = xb_add(&bar[XB_XSUB(b.x)], 1u);
        const unsigned gen = old / nloc;
        if (old + 1u == (gen + 1u) * nloc) {
            __builtin_amdgcn_fence(__ATOMIC_RELEASE, "agent");
            asm volatile("s_waitcnt vmcnt(0)" ::: "memory");
            const unsigned og = xb_add(&bar[XB_TOP], 1u);
            const unsigned tg = og / nx;
            if (og + 1u == (tg + 1u) * nx) xb_add(&bar[XB_TOPGEN], 1u);
            else XB_SPIN(xb_ld(&bar[XB_TOPGEN]) == tg, bar);
            __builtin_amdgcn_fence(__ATOMIC_ACQUIRE, "agent");
            xb_add(&bar[XB_XGEN(b.x)], 1u);
            asm volatile("s_waitcnt vmcnt(0)" ::: "memory");
        } else {
            XB_SPIN(xb_ld(&bar[XB_XGEN(b.x)]) == gen, bar);
            __builtin_amdgcn_fence(__ATOMIC_ACQUIRE, "agent");
            asm volatile("s_waitcnt vmcnt(0)" ::: "memory");
        }
    }
    __syncthreads();
}

struct Args { const float* in[25]; float* out; unsigned char* ws; int ph_lo, ph_hi; };
struct Frame {
    LAS unsigned char* lds;
    int tid, lane, wave, vcu, G;
    const Args* a; float* out; unsigned char* ws;
};
enum { I_X = 0, I_N1W, I_WIN, I_ARE, I_AIM, I_LOGDT, I_BRE, I_BIM, I_CRE, I_CIM, I_D, I_WGLU, I_BGLU, I_PECK, I_WCK1, I_WCK2, I_PECV, I_WCV1, I_WCV2, I_WOUT, I_N2W, I_WUP, I_WDOWN, I_REL, I_NFW };

__device__ __forceinline__ void p0_transpose_item(const float* W, int K, int N, int Npad, bf16_t* WT, const float* scale, LAS float* scr, int item, int lane) {
    const int nblk = Npad / 64, kb = item / nblk, nb = item % nblk, k0 = 64 * kb, n0 = 64 * nb;
    const int rr = lane >> 4, cc = lane & 15, n = n0 + 4 * cc;
    f32x4 v[16];
#pragma unroll
    for (int i = 0; i < 16; ++i) { v[i] = (f32x4){0.f, 0.f, 0.f, 0.f}; if (n < N) v[i] = *(const f32x4*)(W + (size_t)(k0 + 4 * i + rr) * N + n); }
#pragma unroll
    for (int i = 0; i < 16; ++i) { const int kk = 4 * i + rr; f32x4 x = v[i]; if (scale) x = x * scale[k0 + kk];
        LAS float* d = scr + kk * 65 + 4 * cc; d[0] = x[0]; d[1] = x[1]; d[2] = x[2]; d[3] = x[3]; }
    LDS_WAIT();
    const int c = lane & 7;
#pragma unroll
    for (int j = 0; j < 8; ++j) { const int nn = (lane >> 3) + 8 * j; const LAS float* s = scr + (8 * c) * 65 + nn;
        u32x4 o; o.x = pk2(s[0 * 65], s[1 * 65]); o.y = pk2(s[2 * 65], s[3 * 65]); o.z = pk2(s[4 * 65], s[5 * 65]); o.w = pk2(s[6 * 65], s[7 * 65]);
        *(u32x4*)(WT + (size_t)(n0 + nn) * K + k0 + 8 * c) = o; }
    LDS_WAIT();
}
__device__ __forceinline__ void late_transposes(Frame& F, int part) {
    LAS float* scr = (LAS float*)(F.lds + F.wave * 16896);
    const int gw = F.vcu * NWAVES + F.wave, NGW = F.G * NWAVES, lane = F.lane;
    unsigned char* ws = F.ws;
    constexpr int T_GLU = (1024 / 64) * (1024 / 64), T_OUT = (DM / 64) * (DM / 64), T_UP = (DM / 64) * (DFF / 64), T_DOWN = (DFF / 64) * (DM / 64);
    if (part == 0) {
        int g2 = gw, n2 = NGW;
        if (F.G > 64) { if (blockIdx.x < 32) return; g2 = ((int)blockIdx.x - 32) * NWAVES + F.wave; n2 = (F.G - 32) * NWAVES; }
        for (int it = g2; it < T_GLU + T_OUT + T_UP; it += n2) {
            if (it < T_UP) p0_transpose_item(F.a->in[I_WUP], DM, DFF, DFF, (bf16_t*)(ws + WS_WUP), F.a->in[I_N2W], scr, it, lane);
            else if (it < T_UP + T_OUT) p0_transpose_item(F.a->in[I_WOUT], DM, DM, DM, (bf16_t*)(ws + WS_WOUT), nullptr, scr, it - T_UP, lane);
            else p0_transpose_item(F.a->in[I_WGLU], 1024, 1024, 1024, (bf16_t*)(ws + WS_WGLU), nullptr, scr, it - T_UP - T_OUT, lane);
        }
    } else {
        for (int it = gw; it < T_DOWN; it += NGW) p0_transpose_item(F.a->in[I_WDOWN], DFF, DM, DM, (bf16_t*)(ws + WS_WDOWN), nullptr, scr, it, lane);
    }
}
__device__ __forceinline__ void p0_prologue(Frame& F) {
    LAS float* scr = (LAS float*)(F.lds + F.wave * 16896);
    const int gw = F.vcu * NWAVES + F.wave, NGW = F.G * NWAVES, lane = F.lane;
    unsigned char* ws = F.ws;
    constexpr int T_IN = (DM / 64) * (NPROJ / 64), T_C1 = (2048 / 64) * (256 / 64), T_C2 = (256 / 64) * (64 / 64);
    constexpr int NITEMS = T_IN + 2 * T_C1 + 2 * T_C2;
    for (int it = gw; it < NITEMS; it += NGW) {
        int r = it;
        if (r < T_IN) { p0_transpose_item(F.a->in[I_WIN], DM, D_IN, NPROJ, (bf16_t*)(ws + WS_WIN), F.a->in[I_N1W], scr, r, lane); continue; } r -= T_IN;
        if (r < T_C1) { p0_transpose_item(F.a->in[I_WCK1], 2048, 256, 256, (bf16_t*)(ws + WS_WC1K), nullptr, scr, r, lane); continue; } r -= T_C1;
        if (r < T_C1) { p0_transpose_item(F.a->in[I_WCV1], 2048, 256, 256, (bf16_t*)(ws + WS_WC1V), nullptr, scr, r, lane); continue; } r -= T_C1;
        if (r < T_C2) { p0_transpose_item(F.a->in[I_WCK2], 256, 64, 64, (bf16_t*)(ws + WS_WC2K), nullptr, scr, r, lane); continue; } r -= T_C2;
        p0_transpose_item(F.a->in[I_WCV2], 256, 64, 64, (bf16_t*)(ws + WS_WC2V), nullptr, scr, r, lane);
    }
    {
        const float* x = F.a->in[I_X]; bf16_t* xb = (bf16_t*)(ws + WS_XB); float* r1 = (float*)(ws + WS_R1);
        for (int mrow = gw; mrow < MTOK; mrow += NGW) {
            const f32x4* xr = (const f32x4*)(x + (size_t)mrow * DM) + lane; u32x2* o8 = (u32x2*)(xb + (size_t)mrow * DM) + lane;
            f32x4 v[8]; float s = 0.f;
#pragma unroll
            for (int j = 0; j < 8; ++j) { v[j] = xr[64 * j]; s += (v[j].x * v[j].x + v[j].y * v[j].y) + (v[j].z * v[j].z + v[j].w * v[j].w); }
            s = wave_sum(s);
#pragma unroll
            for (int j = 0; j < 8; ++j) { u32x2 w; w.x = pk2(v[j].x, v[j].y); w.y = pk2(v[j].z, v[j].w); o8[64 * j] = w; }
            if (lane == 0) r1[mrow] = __builtin_amdgcn_rsqf(s * (1.f / DM) + EPS);
        }
    }
    {
        const int idx = gw * 64 + lane;
        if (idx < 4096) {
            const int g = idx >> 6;
            const float dt = expf(F.a->in[I_LOGDT][g]); const float ar = F.a->in[I_ARE][idx], ai = F.a->in[I_AIM][idx];
            const float em1 = expm1f(dt * ar), th = dt * ai, c = cosf(th), s = sinf(th), sh = sinf(0.5f * th);
            const float mag = em1 + 1.f, abr = mag * c, abi = mag * s;
            const float zr = em1 * c - 2.f * sh * sh, zi = abi;
            const float den = ar * ar + ai * ai;
            const float cr = (zr * ar + zi * ai) / den, ci = (zi * ar - zr * ai) / den;
            const float magS = expf(512.f * dt * ar), thS = 512.f * th;
            f32x4 ab; ab.x = abr; ab.y = abi; ab.z = magS * cosf(thS); ab.w = magS * sinf(thS);
            ((f32x4*)(ws + WS_S5AB))[idx] = ab;
            bf16_t* bre = (bf16_t*)(ws + WS_BRE) + (size_t)idx * 16; bf16_t* bim = (bf16_t*)(ws + WS_BIM) + (size_t)idx * 16;
            const float* sbr = F.a->in[I_BRE] + (size_t)idx * 16; const float* sbi = F.a->in[I_BIM] + (size_t)idx * 16;
#pragma unroll
            for (int h = 0; h < 16; ++h) { const float br = sbr[h], bi = sbi[h]; bre[h] = (bf16_t)f2bf(cr * br - ci * bi); bim[h] = (bf16_t)f2bf(cr * bi + ci * br); }
        }
        const int i2 = gw * 64 + lane;
        if (i2 < 64 * 16 * 64) { bf16_t* cm = (bf16_t*)(ws + WS_CM); ((unsigned*)cm)[i2] = pk2(F.a->in[I_CRE][i2], -F.a->in[I_CIM][i2]); }
        if (i2 < 2048) { const int h = i2 >> 7, d = i2 & 127; ((float*)(ws + WS_BTAB))[i2] = F.a->in[I_REL][(int)T5B[d] * 16 + h] * LOG2E; }
    }
    for (int it = gw; it < 2 * 32 * 4; it += NGW) {
        const int which = it >> 7, ks = (it >> 2) & 31, jg = it & 3;
        const float* pe = F.a->in[which ? I_PECV : I_PECK] + ks * 64; const float* w1 = F.a->in[which ? I_WCV1 : I_WCK1] + (size_t)(ks * 64) * 256 + jg * 64 + lane;
        float a = 0.f;
#pragma unroll 16
        for (int k = 0; k < 64; ++k) a += pe[k] * w1[(size_t)k * 256];
        ((float*)(ws + WS_CBP))[(which * 32 + ks) * 256 + jg * 64 + lane] = a;
    }
    for (int idx = gw * 64 + lane; idx < MTOK; idx += NGW * 64) { ((float*)(ws + CTL_SS1))[idx] = 0.f; ((float*)(ws + CTL_SS2))[idx] = 0.f; }
}
__device__ __forceinline__ void cmp_bias_reduce(Frame& F) {
    if (blockIdx.x != 0) return;
    const float* p = (const float*)(F.ws + WS_CBP); float* o = (float*)(F.ws + WS_CBF);
    const int which = F.tid >> 8, col = F.tid & 255; float a = 0.f;
    for (int ks = 0; ks < 32; ++ks) a += p[(which * 32 + ks) * 256 + col];
    o[which * 256 + col] = a;
}

template <bool FINAL>
__device__ __forceinline__ void s5_item(Frame& F, int b, int g, int seg) {
    const int lane = F.lane, pp = lane & 31, hi = lane >> 5;
    unsigned char* ws = F.ws;
    LAS unsigned char* L = F.lds + F.wave * 16896;
    const bf16_t* proj = (const bf16_t*)(ws + WS_PROJ);
    const f32x4 ab = ((const f32x4*)(ws + WS_S5AB))[g * 64 + lane];
    const float ar = ab.x, ai = ab.y;
    const bf16_t* bre = (const bf16_t*)(ws + WS_BRE) + (size_t)g * 64 * 16; const bf16_t* bim = (const bf16_t*)(ws + WS_BIM) + (size_t)g * 64 * 16;
    const bf16x8 bre0 = *(const bf16x8*)(bre + pp * 16 + 8 * hi), bre1 = *(const bf16x8*)(bre + (32 + pp) * 16 + 8 * hi);
    const bf16x8 bim0 = *(const bf16x8*)(bim + pp * 16 + 8 * hi), bim1 = *(const bf16x8*)(bim + (32 + pp) * 16 + 8 * hi);
    f32x2* segend = (f32x2*)(ws + WS_SEG) + (size_t)((b * 64 + g) * 8) * 64;
    float sr = 0.f, si = 0.f;
    bf16x8 cf[4]; f32x4 dv = {0.f, 0.f, 0.f, 0.f};
    if (FINAL) {
        for (int s2 = 0; s2 < seg; ++s2) { const f32x2 e = segend[s2 * 64 + lane]; const float nr = ab.z * sr - ab.w * si + e.x, ni = ab.z * si + ab.w * sr + e.y; sr = nr; si = ni; }
        const bf16_t* cm = (const bf16_t*)(ws + WS_CM) + (size_t)(g * 16 + (lane & 15)) * 128 + 8 * (lane >> 4);
#pragma unroll
        for (int ks = 0; ks < 4; ++ks) cf[ks] = *(const bf16x8*)(cm + 32 * ks);
        dv = *(const f32x4*)(F.a->in[I_D] + g * 16 + 4 * (lane >> 4));
    }
    bf16_t* zb = (bf16_t*)(ws + WS_Z);
    const bf16_t* up = proj + ((size_t)b * SEQ + seg * 512 + pp) * NPROJ + COL_U + g * 16 + 8 * hi;
    asm volatile("" :: "v"(bre0), "v"(bre1), "v"(bim0), "v"(bim1), "v"(ab));
    if (FINAL) asm volatile("" :: "v"(cf[0]), "v"(cf[1]), "v"(cf[2]), "v"(cf[3]), "v"(dv));
    const bf16_t* up2 = proj + ((size_t)b * SEQ + seg * 512 + (lane & 15)) * NPROJ + COL_U + g * 16 + 4 * (lane >> 4);
    u32x2 uu_next0 = {0u, 0u}, uu_next1 = {0u, 0u};
    if (FINAL) { uu_next0 = *(const u32x2*)up2; uu_next1 = *(const u32x2*)(up2 + (size_t)16 * NPROJ); }
    bf16x8 ua_next = *(const bf16x8*)up;
    for (int ch = 0; ch < 16; ++ch) {
        const size_t row0 = (size_t)b * SEQ + seg * 512 + ch * 32;
        const bf16x8 ua = ua_next;
        ua_next = *(const bf16x8*)(up + (size_t)(ch < 15 ? ch + 1 : 15) * 32 * NPROJ);
        const u32x2 uu_cur[2] = {uu_next0, uu_next1};
        if (FINAL) { const bf16_t* q2 = up2 + (size_t)(ch < 15 ? ch + 1 : 15) * 32 * NPROJ; uu_next0 = *(const u32x2*)q2; uu_next1 = *(const u32x2*)(q2 + (size_t)16 * NPROJ); }
        const f32x16 z16 = {};
        const f32x16 re0 = __builtin_amdgcn_mfma_f32_32x32x16_bf16(ua, bre0, z16, 0, 0, 0), im0 = __builtin_amdgcn_mfma_f32_32x32x16_bf16(ua, bim0, z16, 0, 0, 0);
        const f32x16 re1 = __builtin_amdgcn_mfma_f32_32x32x16_bf16(ua, bre1, z16, 0, 0, 0), im1 = __builtin_amdgcn_mfma_f32_32x32x16_bf16(ua, bim1, z16, 0, 0, 0);
#pragma unroll
        for (int r = 0; r < 16; ++r) { const int t = crow(r, hi);
            *(LAS f32x2*)(L + t * 528 + 8 * pp) = (f32x2){re0[r], im0[r]};
            *(LAS f32x2*)(L + t * 528 + 8 * (32 + pp)) = (f32x2){re1[r], im1[r]}; }
        LDS_WAIT();
#pragma unroll 8
        for (int t = 0; t < 32; ++t) {
            const f32x2 xv = *(const LAS f32x2*)(L + t * 528 + 8 * lane);
            const float nr = ar * sr - ai * si + xv.x, ni = ar * si + ai * sr + xv.y; sr = nr; si = ni;
            if (FINAL) *(LAS unsigned*)(L + t * 528 + 4 * lane) = pk2(sr, si);
        }
        if (FINAL) {
            LDS_WAIT();
#pragma unroll
            for (int tt = 0; tt < 2; ++tt) {
                f32x4 acc = {0.f, 0.f, 0.f, 0.f};
#pragma unroll
                for (int ks = 0; ks < 4; ++ks) { const bf16x8 sb = *(const LAS bf16x8*)(L + (16 * tt + (lane & 15)) * 528 + (32 * ks + 8 * (lane >> 4)) * 2);
                    acc = __builtin_amdgcn_mfma_f32_16x16x32_bf16(cf[ks], sb, acc, 0, 0, 0); }
                const size_t row = row0 + 16 * tt + (lane & 15);
                const u32x2 uu = uu_cur[tt];
                const float y0 = acc[0] + dv[0] * bflo(uu.x), y1 = acc[1] + dv[1] * bfhi(uu.x), y2 = acc[2] + dv[2] * bflo(uu.y), y3 = acc[3] + dv[3] * bfhi(uu.y);
                u32x2 w; w.x = pk2(gelu_tanh(y0), gelu_tanh(y1)); w.y = pk2(gelu_tanh(y2), gelu_tanh(y3));
                *(u32x2*)(zb + row * 1024 + g * 16 + 4 * (lane >> 4)) = w;
            }
        }
        LDS_WAIT();
    }
    if (!FINAL) segend[seg * 64 + lane] = (f32x2){sr, si};
}
__device__ __forceinline__ void cmul(float& cr, float& ci, float ar, float ai, float br, float bi) { cr = ar * br - ai * bi; ci = ar * bi + ai * br; }
__device__ __forceinline__ void s5_pass1_item(Frame& F, int b, int g, int seg) {
    const int lane = F.lane, pp = lane & 31, hi = lane >> 5;
    unsigned char* ws = F.ws;
    const bf16_t* proj = (const bf16_t*)(ws + WS_PROJ);
    const bf16_t* bre = (const bf16_t*)(ws + WS_BRE) + (size_t)g * 64 * 16; const bf16_t* bim = (const bf16_t*)(ws + WS_BIM) + (size_t)g * 64 * 16;
    const bf16x8 bre0 = *(const bf16x8*)(bre + pp * 16 + 8 * hi), bre1 = *(const bf16x8*)(bre + (32 + pp) * 16 + 8 * hi);
    const bf16x8 bim0 = *(const bf16x8*)(bim + pp * 16 + 8 * hi), bim1 = *(const bf16x8*)(bim + (32 + pp) * 16 + 8 * hi);
    float wr[2][16], wi[2][16], a32r[2], a32i[2];
#pragma unroll
    for (int T = 0; T < 2; ++T) {
        const f32x4 ab = ((const f32x4*)(ws + WS_S5AB))[g * 64 + 32 * T + pp];
        float pr[4], pi[4];
        pr[0] = 1.f; pi[0] = 0.f; pr[1] = ab.x; pi[1] = ab.y; cmul(pr[2], pi[2], ab.x, ab.y, ab.x, ab.y); cmul(pr[3], pi[3], pr[2], pi[2], ab.x, ab.y);
        float q4r, q4i, q8r, q8i, q16r, q16i, q24r, q24i;
        cmul(q4r, q4i, pr[2], pi[2], pr[2], pi[2]); cmul(q8r, q8i, q4r, q4i, q4r, q4i); cmul(q16r, q16i, q8r, q8i, q8r, q8i); cmul(q24r, q24i, q16r, q16i, q8r, q8i);
        const float fr = hi ? 1.f : q4r, fi = hi ? 0.f : q4i;
        const float br_[4] = {1.f, q8r, q16r, q24r}, bi_[4] = {0.f, q8i, q16i, q24i};
#pragma unroll
        for (int r = 0; r < 16; ++r) {
            float tr, ti; cmul(tr, ti, br_[3 - (r >> 2)], bi_[3 - (r >> 2)], pr[3 - (r & 3)], pi[3 - (r & 3)]);
            cmul(wr[T][r], wi[T][r], tr, ti, fr, fi);
        }
        float t28r, t28i; cmul(t28r, t28i, q24r, q24i, q4r, q4i); cmul(a32r[T], a32i[T], t28r, t28i, q4r, q4i);
    }
    float sr[2] = {0.f, 0.f}, si[2] = {0.f, 0.f};
    const bf16_t* up = proj + ((size_t)b * SEQ + seg * 512 + pp) * NPROJ + COL_U + g * 16 + 8 * hi;
    asm volatile("" :: "v"(bre0), "v"(bre1), "v"(bim0), "v"(bim1));
    bf16x8 ua_next = *(const bf16x8*)up;
    for (int ch = 0; ch < 16; ++ch) {
        const bf16x8 ua = ua_next;
        ua_next = *(const bf16x8*)(up + (size_t)(ch < 15 ? ch + 1 : 15) * 32 * NPROJ);
        const f32x16 z16 = {};
        const f32x16 re0 = __builtin_amdgcn_mfma_f32_32x32x16_bf16(ua, bre0, z16, 0, 0, 0), im0 = __builtin_amdgcn_mfma_f32_32x32x16_bf16(ua, bim0, z16, 0, 0, 0);
        const f32x16 re1 = __builtin_amdgcn_mfma_f32_32x32x16_bf16(ua, bre1, z16, 0, 0, 0), im1 = __builtin_amdgcn_mfma_f32_32x32x16_bf16(ua, bim1, z16, 0, 0, 0);
        float e0r = 0.f, e0i = 0.f, e1r = 0.f, e1i = 0.f;
#pragma unroll
        for (int r = 0; r < 16; ++r) {
            e0r += wr[0][r] * re0[r] - wi[0][r] * im0[r]; e0i += wr[0][r] * im0[r] + wi[0][r] * re0[r];
            e1r += wr[1][r] * re1[r] - wi[1][r] * im1[r]; e1i += wr[1][r] * im1[r] + wi[1][r] * re1[r];
        }
        e0r = pair_sum(e0r); e0i = pair_sum(e0i); e1r = pair_sum(e1r); e1i = pair_sum(e1i);
        float nr, ni;
        cmul(nr, ni, a32r[0], a32i[0], sr[0], si[0]); sr[0] = nr + e0r; si[0] = ni + e0i;
        cmul(nr, ni, a32r[1], a32i[1], sr[1], si[1]); sr[1] = nr + e1r; si[1] = ni + e1i;
    }
    f32x2* segend = (f32x2*)(ws + WS_SEG) + (size_t)((b * 64 + g) * 8) * 64;
    segend[seg * 64 + 32 * hi + pp] = hi ? (f32x2){sr[1], si[1]} : (f32x2){sr[0], si[0]};
}
template <bool FINAL> __device__ __forceinline__ void s5_phase(Frame& F) {
    int gw = F.vcu * NWAVES + F.wave, NGW = F.G * NWAVES;
    if (!FINAL && F.G > 64) { if (blockIdx.x < 32) return; gw = ((int)blockIdx.x - 32) * NWAVES + F.wave; NGW = (F.G - 32) * NWAVES; }
    for (int it = gw; it < BATCH * 64 * 8; it += NGW) { const int g = it & 63, bs = it >> 6; if (FINAL) s5_item<true>(F, bs >> 3, g, bs & 7); else s5_pass1_item(F, bs >> 3, g, bs & 7); }
}

__device__ __forceinline__ void cmp2_phase(Frame& F) {
    const int gw = F.vcu * NWAVES + F.wave, NGW = F.G * NWAVES, lane = F.lane, pp = lane & 31, hi = lane >> 5;
    unsigned char* ws = F.ws;
    for (int it = gw; it < 256; it += NGW) {
        const int which = it >> 7, rt = it & 127;
        const bf16_t* Hc = (const bf16_t*)(ws + WS_HC) + (size_t)which * 4096 * 256 + (size_t)(32 * rt + pp) * 256 + 8 * hi;
        const bf16_t* W2 = (const bf16_t*)(ws + (which ? WS_WC2V : WS_WC2K)) + (size_t)pp * 256 + 8 * hi;
        bf16_t* O = (bf16_t*)(ws + (which ? WS_VCMP : WS_KCMP));
        f32x16 a0 = {}, a1 = {};
#pragma unroll 4
        for (int ks = 0; ks < 16; ++ks) { const bf16x8 a = *(const bf16x8*)(Hc + 16 * ks), b0 = *(const bf16x8*)(W2 + 16 * ks), b1 = *(const bf16x8*)(W2 + 32 * 256 + 16 * ks);
            a0 = __builtin_amdgcn_mfma_f32_32x32x16_bf16(a, b0, a0, 0, 0, 0); a1 = __builtin_amdgcn_mfma_f32_32x32x16_bf16(a, b1, a1, 0, 0, 0); }
        if (which == 0) {
#pragma unroll
            for (int r = 0; r < 16; ++r) { const int row = 32 * rt + crow(r, hi); const bool zero = (row & 255) == 255;
                O[(size_t)row * 64 + pp] = zero ? (bf16_t)0 : (bf16_t)f2bf(a0[r]); O[(size_t)row * 64 + 32 + pp] = zero ? (bf16_t)0 : (bf16_t)f2bf(a1[r]); }
        } else {
            bf16_t* OT = (bf16_t*)(ws + WS_VCT);
#pragma unroll
            for (int c = 0; c < 4; ++c) { const int row = 32 * rt + 8 * c + 4 * hi; const int bgx = row >> 8, n = row & 255;
                float x0[4], x1[4];
#pragma unroll
                for (int e = 0; e < 4; ++e) { const bool zero = (n + e) == 255; x0[e] = zero ? 0.f : a0[4 * c + e]; x1[e] = zero ? 0.f : a1[4 * c + e]; }
                *(u32x2*)(OT + ((size_t)bgx * 64 + pp) * 256 + n) = (u32x2){pk2(x0[0], x0[1]), pk2(x0[2], x0[3])};
                *(u32x2*)(OT + ((size_t)bgx * 64 + 32 + pp) * 256 + n) = (u32x2){pk2(x1[0], x1[1]), pk2(x1[2], x1[3])}; }
        }
    }
}

namespace att {
constexpr int KSTR = 144, VSTR = 136, KVB = 64 * KSTR + 64 * VSTR;
constexpr int BIAS_OFF = 2 * KVB, WSCR_OFF = BIAS_OFF + 2048, IMP_OFF = WSCR_OFF + 8 * 256, SEL_OFF = IMP_OFF + 64 * 65 * 4, OT_OFF = SEL_OFF + 512, OT_STR = 68, OT_WAVE = 32 * OT_STR * 4, TAB2_OFF = OT_OFF + 8 * OT_WAVE, TAB2_N = 640, END_OFF = TAB2_OFF + 4 * TAB2_N * 4;
static_assert(END_OFF <= MISC_OFF, "attention LDS map");
constexpr float NEG = -1e30f, MFLOOR = -1e20f, THR = 6.f;
enum { CMP_A = 0, CMP_B = 1, SLC = 2, WIN = 3 };
struct TileRegs { u32x4 k, v; };
struct Src { const bf16_t* k; size_t kstride; const bf16_t* vt; size_t vstride; };
struct Ctx {
    LAS unsigned char* lds; int tid, lane, wave, q, hi, tl, head, t, i;
    bf16x8 qr[4];
};
__device__ __forceinline__ void load_tile(TileRegs& R, const Src& S, int key0, int tid) {
    const unsigned r = (unsigned)tid >> 3, c = (unsigned)tid & 7u;
    const unsigned koff = (r * (unsigned)S.kstride + c * 8u) * 2u, voff = (r * (unsigned)S.vstride + c * 8u) * 2u;
    const char* kb = (const char*)S.k + (size_t)key0 * S.kstride * 2; const char* vb = (const char*)S.vt + (size_t)key0 * 2;
    R.k = *(const u32x4*)(kb + koff);
    R.v = *(const u32x4*)(vb + voff);
}
__device__ __forceinline__ void store_tile(const TileRegs& R, LAS unsigned char* lds, int buf, int tid) {
    const int r = tid >> 3, c = tid & 7;
    LAS unsigned char* b = lds + buf * KVB;
    *(LAS u32x4*)(b + r * KSTR + c * 16) = R.k;
    *(LAS u32x2*)(b + 64 * KSTR + r * VSTR + c * 16) = (u32x2){R.v.x, R.v.y};
    *(LAS u32x2*)(b + 64 * KSTR + r * VSTR + c * 16 + 8) = (u32x2){R.v.z, R.v.w};
}
__device__ __forceinline__ void qk_tile(f32x16& p0, f32x16& p1, const f32x16& cin, const Ctx& C, int buf) {
    const LAS unsigned char* kl = C.lds + buf * KVB + C.q * KSTR + 16 * C.hi;
    bf16x8 kf[8];
#pragma unroll
    for (int d0 = 0; d0 < 4; ++d0) { kf[2 * d0] = *(const LAS bf16x8*)(kl + 32 * d0); kf[2 * d0 + 1] = *(const LAS bf16x8*)(kl + 32 * KSTR + 32 * d0); }
    __builtin_amdgcn_sched_barrier(0);
    p0 = __builtin_amdgcn_mfma_f32_32x32x16_bf16(kf[0], C.qr[0], cin, 0, 0, 0); p1 = __builtin_amdgcn_mfma_f32_32x32x16_bf16(kf[1], C.qr[0], cin, 0, 0, 0);
#pragma unroll
    for (int d0 = 1; d0 < 4; ++d0) { p0 = __builtin_amdgcn_mfma_f32_32x32x16_bf16(kf[2 * d0], C.qr[d0], p0, 0, 0, 0); p1 = __builtin_amdgcn_mfma_f32_32x32x16_bf16(kf[2 * d0 + 1], C.qr[d0], p1, 0, 0, 0); }
}
template <int MODE> __device__ __forceinline__ void mask_bias(f32x16& p0, f32x16& p1, const Ctx& C, int kbase, bool sel) {
    const LAS float* bt = (const LAS float*)(C.lds + BIAS_OFF) + C.head * 128;
    const int d00 = (MODE == CMP_A || MODE == CMP_B) ? (C.t - 31 - 16 * (kbase + 4 * C.hi)) : (C.t - kbase - 4 * C.hi);
    float bv[2][16];
#pragma unroll
    for (int T = 0; T < 2; ++T)
#pragma unroll
        for (int r = 0; r < 16; ++r) {
            const int ko = 32 * T + (r & 3) + 8 * (r >> 2);
            const int dist = (MODE == CMP_A || MODE == CMP_B) ? (d00 - 16 * ko) : (d00 - ko);
            const int di = dist < 0 ? 0 : (dist > 127 ? 127 : dist);
            bv[T][r] = bt[di];
        }
    __builtin_amdgcn_sched_barrier(0);
#pragma unroll
    for (int T = 0; T < 2; ++T)
#pragma unroll
        for (int r = 0; r < 16; ++r) {
            const int ko = 32 * T + (r & 3) + 8 * (r >> 2);
            const int dist = (MODE == CMP_A || MODE == CMP_B) ? (d00 - 16 * ko) : (d00 - ko);
            bool valid = dist >= 0; if (MODE == WIN) valid = valid && dist < 512; if (MODE == SLC) valid = valid && sel;
            if (T == 0) p0[r] = valid ? p0[r] + bv[T][r] : NEG; else p1[r] = valid ? p1[r] + bv[T][r] : NEG;
        }
}
__device__ __forceinline__ void mask_bias2(f32x16& p0, f32x16& p1, const Ctx& C, int kbase) {
    const int d00 = C.t - kbase - 4 * C.hi;
    const LAS float* bp = (const LAS float*)(C.lds + TAB2_OFF) + C.head * TAB2_N + (d00 + 4);
#pragma unroll
    for (int T = 0; T < 2; ++T) {
        float bv[16];
#pragma unroll
        for (int r = 0; r < 16; ++r) bv[r] = bp[59 - (32 * T + (r & 3) + 8 * (r >> 2))];
        __builtin_amdgcn_sched_barrier(0);
#pragma unroll
        for (int r = 0; r < 16; ++r) { if (T == 0) p0[r] += bv[r]; else p1[r] += bv[r]; }
        __builtin_amdgcn_sched_barrier(0);
    }
}
__device__ __forceinline__ float quad_sum(float v) {
    v += __builtin_bit_cast(float, __builtin_amdgcn_mov_dpp(__builtin_bit_cast(int, v), 0xB1, 0xF, 0xF, true));
    v += __builtin_bit_cast(float, __builtin_amdgcn_mov_dpp(__builtin_bit_cast(int, v), 0x4E, 0xF, 0xF, true));
    return v;
}
__device__ __forceinline__ float tile_max(const f32x16& p0, const f32x16& p1) {
    float a = fmaxf(fmaxf(p0[0], p1[0]), p0[1]), b = fmaxf(fmaxf(p1[1], p0[2]), p1[2]);
#pragma unroll
    for (int r = 3; r < 15; r += 2) { a = fmaxf(fmaxf(a, p0[r]), p1[r]); b = fmaxf(fmaxf(b, p0[r + 1]), p1[r + 1]); }
    a = fmaxf(fmaxf(a, p0[15]), p1[15]);
    return pair_max(fmaxf(a, b));
}
__device__ __forceinline__ void v_load(bf16x8 (&vf)[8], const Ctx& C, int buf) {
    const LAS unsigned char* vl = C.lds + buf * KVB + 64 * KSTR + C.q * VSTR + 8 * C.hi;
#pragma unroll
    for (int db = 0; db < 2; ++db)
#pragma unroll
        for (int T = 0; T < 2; ++T)
#pragma unroll
            for (int s = 0; s < 2; ++s) {
                const LAS unsigned char* a = vl + db * 32 * VSTR + (32 * T + 16 * s) * 2;
                const u32x2 lo = *(const LAS u32x2*)a, hi2 = *(const LAS u32x2*)(a + 16);
                const u32x4 vv = {lo.x, lo.y, hi2.x, hi2.y};
                vf[db * 4 + T * 2 + s] = __builtin_bit_cast(bf16x8, vv);
            }
}
__device__ __forceinline__ void pv_mma(f32x16 (&o)[2], const f32x16& p0, const f32x16& p1, const bf16x8 (&vf)[8]) {
    bf16x8 pa[2][2];
#pragma unroll
    for (int s = 0; s < 2; ++s) {
        u32x4 w0, w1;
        w0.x = pk2(p0[8 * s + 0], p0[8 * s + 1]); w0.y = pk2(p0[8 * s + 2], p0[8 * s + 3]); w0.z = pk2(p0[8 * s + 4], p0[8 * s + 5]); w0.w = pk2(p0[8 * s + 6], p0[8 * s + 7]);
        w1.x = pk2(p1[8 * s + 0], p1[8 * s + 1]); w1.y = pk2(p1[8 * s + 2], p1[8 * s + 3]); w1.z = pk2(p1[8 * s + 4], p1[8 * s + 5]); w1.w = pk2(p1[8 * s + 6], p1[8 * s + 7]);
        pa[0][s] = __builtin_bit_cast(bf16x8, w0); pa[1][s] = __builtin_bit_cast(bf16x8, w1);
    }
#pragma unroll
    for (int T = 0; T < 2; ++T)
#pragma unroll
        for (int s = 0; s < 2; ++s)
#pragma unroll
            for (int db = 0; db < 2; ++db) o[db] = __builtin_amdgcn_mfma_f32_32x32x16_bf16(pa[T][s], vf[db * 4 + T * 2 + s], o[db], 0, 0, 0);
}
__device__ __forceinline__ void row_scale(f32x16 (&o)[2], float fq_, const Ctx& C) {
    LAS float* wsc = (LAS float*)(C.lds + WSCR_OFF + C.wave * 256);
    wsc[C.q] = fq_; LDS_WAIT();
#pragma unroll
    for (int r = 0; r < 16; ++r) { const float f = wsc[crow(r, C.hi)]; o[0][r] *= f; o[1][r] *= f; }
    LDS_WAIT();
}
template <bool FIRST> __device__ __forceinline__ void row_fma(const f32x16 (&o)[2], float fq_, const Ctx& C) {
    LAS float* wsc = (LAS float*)(C.lds + WSCR_OFF + C.wave * 256);
    LAS float* otl = (LAS float*)(C.lds + OT_OFF + C.wave * OT_WAVE) + C.q;
    wsc[C.q] = fq_; LDS_WAIT();
#pragma unroll
    for (int r = 0; r < 16; ++r) { const int row = crow(r, C.hi); const float f = wsc[row];
        if (FIRST) { otl[row * OT_STR] = o[0][r] * f; otl[row * OT_STR + 32] = o[1][r] * f; }
        else { otl[row * OT_STR] += o[0][r] * f; otl[row * OT_STR + 32] += o[1][r] * f; } }
    LDS_WAIT();
}
struct Soft { float mref, l; bool set; f32x16 negm; };

template <int MODE>
__device__ __forceinline__ void branch(const Ctx& C, const Src& S, int jlo, int jhi, Soft& st, float& m, float& l, f32x16 (&o)[2], float inv_l, unsigned sel_lo, unsigned sel_hi) {
    TileRegs R; load_tile(R, S, 64 * jlo, C.tid);
    const float far_bias = ((const LAS float*)(C.lds + BIAS_OFF))[C.head * 128 + 127];
    store_tile(R, C.lds, 0, C.tid);
    __syncthreads();
    if (jlo + 1 <= jhi) load_tile(R, S, 64 * (jlo + 1), C.tid);
#pragma unroll 1
    for (int j = jlo; j <= jhi; ++j) {
        const int buf = (j - jlo) & 1;
        f32x16 p0, p1;
        const bool cfar = (MODE == CMP_A || MODE == CMP_B) && (1024 * j + 1167 <= 64 * C.i);
        if (MODE == CMP_A) {
            if (cfar) { f32x16 cin;
#pragma unroll
                for (int r = 0; r < 16; ++r) cin[r] = far_bias;
                qk_tile(p0, p1, cin, C, buf); }
            else { const f32x16 z = {}; qk_tile(p0, p1, z, C, buf); mask_bias<MODE>(p0, p1, C, 64 * j, true); }
            const float mt = tile_max(p0, p1), mn = fmaxf(m, mt), alpha = fexp2(m - mn);
            float s = 0.f;
#pragma unroll
            for (int r = 0; r < 16; ++r) s += fexp2(p0[r] - mn) + fexp2(p1[r] - mn);
            l = l * alpha + s; m = mn;
        } else if (MODE == CMP_B) {
            f32x16 cin;
#pragma unroll
            for (int r = 0; r < 16; ++r) cin[r] = cfar ? far_bias - m : -m;
            qk_tile(p0, p1, cin, C, buf);
            bf16x8 vf[8]; v_load(vf, C, buf);
            if (!cfar) mask_bias<MODE>(p0, p1, C, 64 * j, true);
#pragma unroll
            for (int r = 0; r < 16; ++r) { p0[r] = fexp2(p0[r]) * inv_l; p1[r] = fexp2(p1[r]) * inv_l; }
            LAS float* imp = (LAS float*)(C.lds + IMP_OFF) + C.tl * 65;
#pragma unroll
            for (int T = 0; T < 2; ++T)
#pragma unroll
                for (int c = 0; c < 4; ++c) {
                    const float e0 = T ? p1[4 * c] : p0[4 * c], e1 = T ? p1[4 * c + 1] : p0[4 * c + 1], e2 = T ? p1[4 * c + 2] : p0[4 * c + 2], e3 = T ? p1[4 * c + 3] : p0[4 * c + 3];
                    float mainv = (e0 + e1) + (e2 + 0.5f * e3), carry = 0.5f * e3;
                    mainv = quad_sum(mainv); carry = quad_sum(carry);
                    const int sb = 16 * j + 8 * T + 2 * c + C.hi;
                    if (C.head == 0) { (void)__hip_atomic_fetch_add(imp + sb, mainv, __ATOMIC_RELAXED, __HIP_MEMORY_SCOPE_WORKGROUP); if (sb + 1 < 64) (void)__hip_atomic_fetch_add(imp + sb + 1, carry, __ATOMIC_RELAXED, __HIP_MEMORY_SCOPE_WORKGROUP); }
                }
            pv_mma(o, p0, p1, vf);
        } else {
            const int delta = C.i - j;
            const bool sel = (MODE == SLC) ? (((j < 32 ? (sel_lo >> j) : (sel_hi >> (j - 32))) & 1u) != 0u) : true;
            if (MODE != SLC || __any(sel)) {
                const bool near = delta <= 2 || (MODE == WIN && delta >= 8);
                if (near) {
                    const float c = sel ? -st.mref : NEG;
                    f32x16 cin;
#pragma unroll
                    for (int r = 0; r < 16; ++r) cin[r] = c;
                    qk_tile(p0, p1, cin, C, buf);
                    mask_bias2(p0, p1, C, 64 * j);
                } else if (MODE == SLC && !__all(sel)) {
                    f32x16 cin;
#pragma unroll
                    for (int r = 0; r < 16; ++r) cin[r] = sel ? st.negm[r] : NEG;
                    qk_tile(p0, p1, cin, C, buf);
                } else qk_tile(p0, p1, st.negm, C, buf);
                bf16x8 vf[8]; v_load(vf, C, buf);
                __builtin_amdgcn_sched_barrier(0);
                const float mx = tile_max(p0, p1);
                const bool need = st.set ? (mx > THR) : (mx > 0.5f * NEG);
                if (__any(need)) {
                    const float dl = need ? mx : 0.f;
                    const float f = (need && st.set) ? fexp2(-dl) : 1.f;
                    st.mref += dl; st.l *= f; st.set = st.set || need;
#pragma unroll
                    for (int r = 0; r < 16; ++r) { p0[r] -= dl; p1[r] -= dl; st.negm[r] = far_bias - st.mref; }
                    row_scale(o, f, C);
                }
                float s = 0.f;
#pragma unroll
                for (int r = 0; r < 16; ++r) { p0[r] = fexp2(p0[r]); p1[r] = fexp2(p1[r]); s += p0[r] + p1[r]; }
                st.l += s;
                pv_mma(o, p0, p1, vf);
            }
        }
        if (j < jhi) store_tile(R, C.lds, buf ^ 1, C.tid);
        __syncthreads();
        if (j + 2 <= jhi) load_tile(R, S, 64 * (j + 2), C.tid);
    }
}

__device__ __forceinline__ void attn_unit(Frame& F, int b, int g, int i, bool tables) {
    unsigned char* ws = F.ws;
    const bf16_t* proj = (const bf16_t*)(ws + WS_PROJ);
    int tid_ = threadIdx.x; asm volatile("" : "+v"(tid_));
    Ctx C; C.lds = F.lds; C.tid = tid_; C.lane = tid_ & 63; C.wave = F.wave; C.q = C.lane & 31; C.hi = C.lane >> 5; C.tl = 8 * F.wave + (C.q >> 2); C.head = C.q & 3; C.i = i; C.t = 64 * i + C.tl;
    const size_t row = (size_t)b * SEQ + C.t;
    const int hq = g * 4 + C.head;
#pragma unroll
    for (int d0 = 0; d0 < 4; ++d0) C.qr[d0] = *(const bf16x8*)(proj + row * NPROJ + COL_Q + hq * 64 + 16 * d0 + 8 * C.hi);
    float gate[3];
#pragma unroll
    for (int j = 0; j < 3; ++j) gate[j] = sigmoidf_(bf2f(proj[row * NPROJ + COL_GL + hq * 3 + j]));
    for (int idx = C.tid; idx < 64 * 65; idx += 512) ((LAS float*)(C.lds + IMP_OFF))[idx] = 0.f;
    if (tables) {
        ((LAS float*)(C.lds + BIAS_OFF))[C.tid] = ((const float*)(ws + WS_BTAB))[(g * 4 + (C.tid >> 7)) * 128 + (C.tid & 127)];
        for (int idx = C.tid; idx < 4 * TAB2_N; idx += 512) { const int h = idx / TAB2_N, d = idx % TAB2_N - 63;
            ((LAS float*)(C.lds + TAB2_OFF))[idx] = (d < 0 || d >= 512) ? NEG : ((const float*)(ws + WS_BTAB))[(g * 4 + h) * 128 + (d > 127 ? 127 : d)]; }
    }
    __syncthreads();
    const float far_bias = ((const LAS float*)(C.lds + BIAS_OFF))[C.head * 128 + 127];
    f32x16 o[2];
    float m, l;
    Soft st;
    const int bg = b * 4 + g;
    {
        const Src S{(const bf16_t*)(ws + WS_KCMP) + (size_t)(bg * 256) * 64, 64, (const bf16_t*)(ws + WS_VCT) + (size_t)(bg * 64) * 256, 256};
        const int nkt = (4 * i + 2) / 64 + 1;
        m = MFLOOR; l = 0.f; o[0] = f32x16{}; o[1] = f32x16{};
        branch<CMP_A>(C, S, 0, nkt - 1, st, m, l, o, 0.f, 0u, 0u);
        const float lt = pair_sum(l), inv = lt > 0.f ? 1.f / lt : 0.f;
        branch<CMP_B>(C, S, 0, nkt - 1, st, m, l, o, inv, 0u, 0u);
        row_fma<true>(o, gate[0], C);
    }
    {
        LDS_WAIT();
        LAS unsigned char* selb = C.lds + SEL_OFF;
        if (i >= 16) {
            const int tk = C.lane >> 3, cg = C.lane & 7;
            LAS unsigned* rowb = (LAS unsigned*)(C.lds + IMP_OFF) + (8 * C.wave + tk) * 65;
            unsigned long long kc[8]; unsigned cnt[8];
#pragma unroll
            for (int c = 0; c < 8; ++c) { const int s = cg * 8 + c; unsigned xb = rowb[s];
                xb = (s == 0 || s == i || s == i - 1) ? 0x461c4000u   : xb;
                rowb[s] = xb; kc[c] = ((unsigned long long)xb << 6) | (unsigned)(63 - s); cnt[c] = 0u; }
            LDS_WAIT();
            for (int s2 = 0; s2 <= i; ++s2) {
                const unsigned long long k2 = ((unsigned long long)rowb[s2] << 6) | (unsigned)(63 - s2);
#pragma unroll
                for (int c = 0; c < 8; ++c) cnt[c] += (k2 > kc[c]) ? 1u : 0u;
            }
            unsigned bits = 0;
#pragma unroll
            for (int c = 0; c < 8; ++c) { const int s = cg * 8 + c; if (cnt[c] < 16u && s <= i) bits |= 1u << c; }
            selb[(8 * C.wave + tk) * 8 + cg] = (unsigned char)bits;
        } else {
            if (C.lane < 8) { const unsigned long long mk = (2ull << i) - 1ull; *(LAS unsigned long long*)(selb + (8 * C.wave + C.lane) * 8) = mk; }
        }
        LDS_WAIT();
    }
    const u32x2 selw = *(const LAS u32x2*)(C.lds + SEL_OFF + C.tl * 8);
    {
        const Src S{proj + (size_t)b * SEQ * NPROJ + COL_KS + g * 64, NPROJ, (const bf16_t*)(ws + WS_VST) + (size_t)(bg * 64) * SEQ, SEQ};
        st.mref = 0.f; st.l = 0.f; st.set = false; o[0] = f32x16{}; o[1] = f32x16{};
#pragma unroll
        for (int r = 0; r < 16; ++r) st.negm[r] = far_bias;
        branch<SLC>(C, S, 0, i, st, m, l, o, 0.f, selw.x, selw.y);
        const float lt = pair_sum(st.l);
        row_fma<false>(o, gate[1] / lt, C);
    }
    {
        const Src S{proj + (size_t)b * SEQ * NPROJ + COL_KW + g * 64, NPROJ, (const bf16_t*)(ws + WS_VWT) + (size_t)(bg * 64) * SEQ, SEQ};
        st.mref = 0.f; st.l = 0.f; st.set = false; o[0] = f32x16{}; o[1] = f32x16{};
#pragma unroll
        for (int r = 0; r < 16; ++r) st.negm[r] = far_bias;
        branch<WIN>(C, S, i >= 8 ? i - 8 : 0, i, st, m, l, o, 0.f, 0u, 0u);
        const float lt = pair_sum(st.l);
        row_fma<false>(o, gate[2] / lt, C);
    }
    {
        bf16_t* mix = (bf16_t*)(ws + WS_MIX);
        const LAS float* otw = (const LAS float*)(C.lds + OT_OFF + C.wave * OT_WAVE);
#pragma unroll
        for (int k = 0; k < 4; ++k) { const int rowq = 8 * k + (C.lane >> 3), ch = C.lane & 7;
            const f32x4 a = *(const LAS f32x4*)(otw + rowq * OT_STR + ch * 8), c4 = *(const LAS f32x4*)(otw + rowq * OT_STR + ch * 8 + 4);
            u32x4 w; w.x = pk2(a[0], a[1]); w.y = pk2(a[2], a[3]); w.z = pk2(c4[0], c4[1]); w.w = pk2(c4[2], c4[3]);
            const size_t orow = (size_t)b * SEQ + 64 * i + 8 * C.wave + (rowq >> 2);
            *(u32x4*)(mix + orow * DM + 1024 + (g * 4 + (rowq & 3)) * 64 + ch * 8) = w; }
    }
    __syncthreads();
}
__device__ __forceinline__ void attn_phase(Frame& F) {
    for (int v = F.vcu; v < 256; v += F.G) {
        const int bg = v >> 4, s = v & 15;
#pragma unroll 1
        for (int k = 0; k < 4; ++k) { const int i = (k == 0) ? 63 - s : (k == 1) ? 32 + s : (k == 2) ? 31 - s : s; attn_unit(F, bg >> 2, bg & 3, i, k == 0); }
    }
}
}

__device__ __forceinline__ void final_norm_phase(Frame& F) {
    const int gw = F.vcu * NWAVES + F.wave, NGW = F.G * NWAVES, lane = F.lane;
    const float* ss = (const float*)(F.ws + CTL_SS2); const f32x4* nw = (const f32x4*)F.a->in[I_NFW] + 2 * lane;
    for (int mrow = gw; mrow < MTOK; mrow += NGW) {
        const float rs = __builtin_amdgcn_rsqf(ss[mrow] * (1.f / DM) + EPS);
        const u32x4* xr = (const u32x4*)((const bf16_t*)(F.ws + WS_MIX) + (size_t)mrow * DM) + lane;
        f32x4* orow = (f32x4*)(F.out + (size_t)mrow * DM) + 2 * lane;
#pragma unroll
        for (int j = 0; j < 4; ++j) { const u32x4 b = xr[64 * j]; const f32x4 w0 = nw[128 * j], w1 = nw[128 * j + 1];
            orow[128 * j] = (f32x4){bflo(b.x), bfhi(b.x), bflo(b.y), bfhi(b.y)} * rs * w0; orow[128 * j + 1] = (f32x4){bflo(b.z), bfhi(b.z), bflo(b.w), bfhi(b.w)} * rs * w1; }
    }
}

constexpr int N_PHASES = 9;
__global__ void __launch_bounds__(NWAVES * 64, 2) hymba_fwd(Args args) {
    extern __shared__ __attribute__((aligned(16))) unsigned char lds_raw[];
    Frame F;
    F.lds = (LAS unsigned char*)lds_raw;
    F.tid = threadIdx.x; F.lane = F.tid & 63; F.wave = __builtin_amdgcn_readfirstlane(F.tid >> 6);
    F.G = gridDim.x; { const int bx = blockIdx.x; F.vcu = (F.G % 8 == 0) ? (bx % 8) * (F.G / 8) + bx / 8 : bx; }
    F.a = &args; F.out = args.out; F.ws = args.ws;
    unsigned char* ws = args.ws;
    volatile LAS unsigned* MISC = (volatile LAS unsigned*)(F.lds + MISC_OFF);
    if (F.tid < 32) MISC[F.tid] = 0u;
    __syncthreads();
    XcdBarrier bar; bar.bar = (unsigned*)(ws + WS_CTL) + CW_BAR; bar.x = 0; bar.st = nullptr;
    const int lo = args.ph_lo, hi = args.ph_hi;
    const bool multi = (hi - lo) > 1;
    if (multi) bar = xcd_barrier_post((unsigned*)(ws + WS_CTL) + CW_BAR, MISC + 8);
#ifndef REPEAT_PHASE
#define REPEAT_PHASE -1
#endif
#define REP(k) for (int rep_ = 0; rep_ < ((REPEAT_PHASE == (k)) ? 2 : 1); ++rep_)
#ifndef ONLY_PHASE
#define ONLY_PHASE -1
#endif
#define IN(k) ((ONLY_PHASE < 0 || ONLY_PHASE == (k)) && lo <= (k) && (k) < hi)
#define SEAM(k) do { if (IN(k) && IN((k) + 1)) xcd_barrier(bar); } while (0)
    const int cblk = (int)blockIdx.x;

    if (IN(0)) { REP(0) { p0_prologue(F); } SEAM(0); }
    if (IN(1)) {
        pg8::Gemm g{(const bf16_t*)(ws + WS_XB), (const bf16_t*)(ws + WS_WIN), MTOK, NPROJ, DM, DM, 128, 0};
        pg8::StaticOrder S; S.init(MTOK, NPROJ, F.G, cblk);
        pg8::EpiProj E{(bf16_t*)(ws + WS_PROJ), (const float*)(ws + WS_R1), (bf16_t*)(ws + WS_VST), (bf16_t*)(ws + WS_VWT)};
        REP(1) { pg8::gemm_phase<pg8::EpiProj, pg8::StaticOrder, true>(F.lds, g, S, E); }
        cmp_bias_reduce(F);
        SEAM(1);
    }
    if (IN(2)) { REP(2) {
        {
            pg8::Gemm g{(const bf16_t*)(ws + WS_PROJ) + COL_KC, (const bf16_t*)(ws + WS_WC1K), 4096, 256, 2048, 16 * NPROJ, NPROJ * 2, 1};
            pg8::StaticOrder S; S.init(4096, 256, F.G, cblk);
            pg8::EpiCmp E{(bf16_t*)(ws + WS_HC), (const float*)(ws + WS_CBF)};
            pg8::gemm_phase<pg8::EpiCmp, pg8::StaticOrder, true>(F.lds, g, S, E);
        }
        {
            pg8::Gemm g{(const bf16_t*)(ws + WS_PROJ) + COL_VC, (const bf16_t*)(ws + WS_WC1V), 4096, 256, 2048, 16 * NPROJ, NPROJ * 2, 1};
            pg8::StaticOrder S; S.init(4096, 256, F.G, (cblk + F.G - 16) % F.G);
            pg8::EpiCmp E{(bf16_t*)(ws + WS_HC) + (size_t)4096 * 256, (const float*)(ws + WS_CBF) + 256};
            pg8::gemm_phase<pg8::EpiCmp, pg8::StaticOrder, true>(F.lds, g, S, E);
        }
        __syncthreads();
        s5_phase<false>(F);
        late_transposes(F, 0);
        __syncthreads(); }
        SEAM(2);
    }
    if (IN(3)) { REP(3) { if (REPEAT_PHASE != 31) s5_phase<true>(F); if (REPEAT_PHASE != 32) cmp2_phase(F); late_transposes(F, 1); __syncthreads(); } SEAM(3); }
    if (IN(4)) {
        __syncthreads();
        pg8::Gemm g{(const bf16_t*)(ws + WS_Z), (const bf16_t*)(ws + WS_WGLU), MTOK, 1024, 1024, 1024, 128, 0};
        pg8::StaticOrder S; S.init(MTOK, 1024, F.G, cblk);
        pg8::EpiGlu E{(bf16_t*)(ws + WS_MIX), (const bf16_t*)(ws + WS_Z), F.a->in[I_BGLU]};
        for (int rep_ = 0; rep_ < ((REPEAT_PHASE == 40) ? 2 : 1); ++rep_) pg8::gemm_phase<pg8::EpiGlu, pg8::StaticOrder, true>(F.lds, g, S, E);
        __syncthreads();
        REP(4) { att::attn_phase(F); __syncthreads(); }
        SEAM(4);
    }
    if (IN(5)) {
        __syncthreads();
        pg8::Gemm g{(const bf16_t*)(ws + WS_MIX), (const bf16_t*)(ws + WS_WOUT), MTOK, DM, DM, DM, 128, 0};
        pg8::StaticOrder S; S.init(MTOK, DM, F.G, cblk);
        pg8::EpiRes<false> E{F.a->in[I_X], (bf16_t*)(ws + WS_X1B), (float*)(ws + CTL_SS1)};
        pg8::gemm_phase<pg8::EpiRes<false>, pg8::StaticOrder, true>(F.lds, g, S, E);
        SEAM(5);
    }
    if (IN(6)) {
        pg8::Gemm g{(const bf16_t*)(ws + WS_X1B), (const bf16_t*)(ws + WS_WUP), MTOK, DFF, DM, DM, 128, 0};
        pg8::StaticOrder S; S.init(MTOK, DFF, F.G, cblk);
        pg8::EpiUp E{(bf16_t*)(ws + WS_HID), (const float*)(ws + CTL_SS1)};
        REP(6) { pg8::gemm_phase<pg8::EpiUp, pg8::StaticOrder, true>(F.lds, g, S, E); }
        SEAM(6);
    }
    if (IN(7)) {
        pg8::Gemm g{(const bf16_t*)(ws + WS_HID), (const bf16_t*)(ws + WS_WDOWN), MTOK, DM, DFF, DFF, 128, 0};
        pg8::StaticOrder S; S.init(MTOK, DM, F.G, cblk);
        pg8::EpiRes<true> E{(const bf16_t*)(ws + WS_X1B), (bf16_t*)(ws + WS_MIX), (float*)(ws + CTL_SS2)};
        pg8::gemm_phase<pg8::EpiRes<true>, pg8::StaticOrder, true>(F.lds, g, S, E);
        SEAM(7);
    }
    if (IN(8)) final_norm_phase(F);
#undef IN
#undef SEAM
}

extern "C" void kernel_launch(void* const* d_in, const int* in_sizes, int n_in, void* d_out, int out_size, void* d_ws, size_t ws_size, hipStream_t stream) {
    static int grid = 0;
    if (grid == 0) {
        if (n_in != 25 || in_sizes[0] != MTOK * DM || out_size != MTOK * DM || ws_size < WS_END) {
            fprintf(stderr, "kernel_launch: unexpected shapes (n_in %d, in0 %d, out %d, ws %zu < %zu); nothing launched\n", n_in, n_in > 0 ? in_sizes[0] : -1, out_size, ws_size, (size_t)WS_END); grid = -1; return; }
        int dev = 0, cus = 0, per_cu = 0;
        if (hipGetDevice(&dev) != hipSuccess || hipDeviceGetAttribute(&cus, hipDeviceAttributeMultiprocessorCount, dev) != hipSuccess) { grid = -1; return; }
        if (hipFuncSetAttribute((const void*)hymba_fwd, hipFuncAttributeMaxDynamicSharedMemorySize, LDS_BYTES) != hipSuccess) { fprintf(stderr, "kernel_launch: hipFuncSetAttribute failed\n"); grid = -1; return; }
        if (hipOccupancyMaxActiveBlocksPerMultiprocessor(&per_cu, (const void*)hymba_fwd, NWAVES * 64, LDS_BYTES) != hipSuccess || per_cu < 1) { fprintf(stderr, "kernel_launch: occupancy query says %d blocks per CU\n", per_cu); per_cu = 1; }
        (void)hipGetLastError();
        grid = cus;
    }
    if (grid < 0) return;
    if (MK_N_LAUNCHES == 1) { if (hipMemsetAsync((char*)d_ws + WS_CTL, 0, CTL_ZERO_BYTES, stream) != hipSuccess) return; }
    Args a{};
    for (int i = 0; i < 25; ++i) a.in[i] = (const float*)d_in[i];
    a.out = (float*)d_out; a.ws = (unsigned char*)d_ws;
    if (MK_N_LAUNCHES == 1) {
        a.ph_lo = 0; a.ph_hi = N_PHASES;
        void* kargs[] = {&a};
        hipError_t e = hipLaunchCooperativeKernel((const void*)hymba_fwd, dim3(grid), dim3(NWAVES * 64), kargs, LDS_BYTES, stream);
        if (e != hipSuccess) fprintf(stderr, "kernel_launch: cooperative launch failed: %s (grid %d)\n", hipGetErrorString(e), grid);
    } else {
        for (int p = 0; p < N_PHASES; ++p) { a.ph_lo = p; a.ph_hi = p + 1; hipLaunchKernelGGL(hymba_fwd, dim3(grid), dim3(NWAVES * 64), LDS_BYTES, stream, a); }
    }
}
```

```cpp
#include <hip/hip_runtime.h>
#include <cstdio>
#include <cstdint>

#ifndef MK_N_LAUNCHES
#define MK_N_LAUNCHES 1
#endif

#define LAS __attribute__((address_space(3)))
#define GAS __attribute__((address_space(1)))
typedef unsigned short bf16_t;
typedef short bf16x8 __attribute__((ext_vector_type(8)));
typedef float f32x2 __attribute__((ext_vector_type(2)));
typedef float f32x4 __attribute__((ext_vector_type(4)));
typedef float f32x16 __attribute__((ext_vector_type(16)));
typedef unsigned u32x2 __attribute__((ext_vector_type(2)));
typedef unsigned u32x4 __attribute__((ext_vector_type(4)));
typedef __bf16 bf16x2_t __attribute__((ext_vector_type(2)));

#define LDS_WAIT() asm volatile("s_waitcnt lgkmcnt(0)" ::: "memory")
#define VM_WAIT() asm volatile("s_waitcnt vmcnt(0)" ::: "memory")

constexpr int BATCH = 4, SEQ = 4096, DM = 2048, MTOK = BATCH * SEQ, DFF = 8192;
constexpr int D_IN = 3632, NPROJ = 3840;
constexpr int COL_U = 0, COL_Q = 1024, COL_KC = 2048, COL_VC = 2304, COL_KS = 2560, COL_VS = 2816, COL_KW = 3072, COL_VW = 3328, COL_GL = 3584;
constexpr float EPS = 1e-6f;
constexpr float LOG2E = 1.4426950408889634f;
constexpr float C2 = 0.125f * LOG2E;
constexpr int NWAVES = 8;

constexpr size_t MiB = 1u << 20;
constexpr size_t WS_CTL = 0, CTL_ZERO_BYTES = 1 * MiB;
constexpr int CW_BAR = 4096;
constexpr size_t CTL_KMAX = 96 * 1024;
constexpr size_t CTL_SS1 = 256 * 1024, CTL_SS2 = 512 * 1024, CTL_CB = 768 * 1024;
constexpr size_t WS_R1 = 1 * MiB, WS_BTAB = 1 * MiB + 64 * 1024, WS_S5AB = 1 * MiB + 128 * 1024, WS_CBP = 1 * MiB + 256 * 1024  , WS_CBF = 1 * MiB + 384 * 1024  ;
constexpr size_t WS_BRE = 2 * MiB, WS_BIM = 2 * MiB + 128 * 1024, WS_CM = 2 * MiB + 256 * 1024;
constexpr size_t WS_SEG = 3 * MiB;
constexpr size_t WS_WIN = 4 * MiB, WS_WGLU = 19 * MiB, WS_WOUT = 21 * MiB, WS_WUP = 29 * MiB, WS_WDOWN = 61 * MiB, WS_WC1K = 93 * MiB, WS_WC1V = 94 * MiB,
                 WS_WC2K = 95 * MiB, WS_WC2V = 95 * MiB + 64 * 1024;
constexpr size_t WS_X1B = 100 * MiB, WS_MIX = 164 * MiB, WS_HID = 228 * MiB;
constexpr size_t WS_XB = 228 * MiB, WS_PROJ = 292 * MiB, WS_Z = 412 * MiB, WS_HC = 444 * MiB, WS_KCMP = 448 * MiB, WS_VCMP = 448 * MiB + 512 * 1024;
constexpr size_t WS_VST = 450 * MiB, WS_VWT = 458 * MiB, WS_VCT = 466 * MiB;
constexpr size_t WS_END = 484 * MiB;

constexpr int LDS_BYTES = 147456;
constexpr int MISC_OFF = 135168 + 4096;

__device__ __forceinline__ unsigned f2bf(float f) { unsigned u = __builtin_bit_cast(unsigned, f); return (u + 0x7fffu + ((u >> 16) & 1u)) >> 16; }
__device__ __forceinline__ unsigned pk2(float lo, float hi) { f32x2 v = {lo, hi}; bf16x2_t b = __builtin_convertvector(v, bf16x2_t); return __builtin_bit_cast(unsigned, b); }
__device__ __forceinline__ float bf2f(unsigned b) { return __builtin_bit_cast(float, b << 16); }
__device__ __forceinline__ float bflo(unsigned w) { return __builtin_bit_cast(float, w << 16); }
__device__ __forceinline__ float bfhi(unsigned w) { return __builtin_bit_cast(float, w & 0xffff0000u); }
__device__ __forceinline__ float fexp2(float x) { return __builtin_amdgcn_exp2f(x); }
__device__ __forceinline__ float frcp(float x) { return __builtin_amdgcn_rcpf(x); }
__device__ __forceinline__ float sigmoidf_(float x) { return frcp(1.f + fexp2(-x * LOG2E)); }
__device__ __forceinline__ float gelu_tanh(float x) {
    const float u = 0.7978845608028654f * (x + 0.044715f * x * x * x);
    return x * frcp(1.f + fexp2(-2.f * LOG2E * u));
}
__device__ __forceinline__ int crow(int r, int hi) { return (r & 3) + 8 * (r >> 2) + 4 * hi; }
__device__ __forceinline__ float wave_sum(float v) {
#pragma unroll
    for (int o = 1; o < 64; o <<= 1) v += __shfl_xor(v, o);
    return v;
}
__device__ __forceinline__ float pair_max(float v) {
    unsigned a = __builtin_bit_cast(unsigned, v), b = a; asm volatile("" : "+v"(b));
    auto rr = __builtin_amdgcn_permlane32_swap(a, b, false, false);
    unsigned r0 = rr[0], r1 = rr[1]; asm volatile("" : "+v"(r0), "+v"(r1));
    return fmaxf(__builtin_bit_cast(float, r0), __builtin_bit_cast(float, r1));
}
__device__ __forceinline__ float pair_sum(float v) {
    unsigned a = __builtin_bit_cast(unsigned, v), b = a; asm volatile("" : "+v"(b));
    auto rr = __builtin_amdgcn_permlane32_swap(a, b, false, false);
    unsigned r0 = rr[0], r1 = rr[1]; asm volatile("" : "+v"(r0), "+v"(r1));
    return __builtin_bit_cast(float, r0) + __builtin_bit_cast(float, r1);
}

__device__ const unsigned char T5B[128] = {0, 1, 2, 3, 4, 5, 6, 7, 8, 9, 10, 11, 12, 13, 14, 15, 16, 16, 16, 17, 17, 18, 18, 18, 19, 19, 19, 20, 20, 20, 20, 21, 21, 21, 21, 22, 22, 22, 22, 22, 23, 23, 23, 23, 23, 23,
    24, 24, 24, 24, 24, 24, 25, 25, 25, 25, 25, 25, 25, 26, 26, 26, 26, 26, 26, 26, 26, 27, 27, 27, 27, 27, 27, 27, 27, 27, 27, 28, 28, 28, 28, 28, 28, 28, 28, 28, 28, 29, 29, 29, 29, 29, 29, 29, 29, 29, 29, 29, 29,
    30, 30, 30, 30, 30, 30, 30, 30, 30, 30, 30, 30, 30, 30, 31, 31, 31, 31, 31, 31, 31, 31, 31, 31, 31, 31, 31, 31, 31};

namespace pg8 {
constexpr int BM = 256, BK = 64, HALF = 128, HTB = HALF * BK * 2, STAGE_BYTES = 8 * HTB, NXCD = 8, WGM = 8;
__host__ __device__ __forceinline__ int lds_byte(int r, int c) { const int st = (r >> 4) * 2 + (c >> 5), rr = r & 15, cc = c & 31, ob = rr * 64 + cc * 2; return st * 1024 + (ob ^ (((ob >> 9) & 1) << 5)); }
__host__ __device__ __forceinline__ void stage_rc(int b, int& R, int& C) { const int st = b / 1024, sb = b % 1024, swz = sb ^ (((sb >> 9) & 1) << 5); R = (st >> 1) * 16 + swz / 64; C = (st & 1) * 32 + (swz % 64) / 2; }
__host__ __device__ __forceinline__ int perm32(int rho) { const int n = rho >> 4, i = rho & 15; return 8 * (i >> 2) + 4 * n + (i & 3); }

struct Unit { int pm, pn; };
struct Gemm { const bf16_t* A; const bf16_t* Bt; int M, N, K; int lda; int a_kstep; int amode; };
__device__ __forceinline__ const char* a_base(const Gemm& g, int pm) {
    if (g.amode == 0) return (const char*)g.A + (size_t)pm * (size_t)BM * (size_t)g.lda * 2;
    return (const char*)g.A + ((size_t)(pm >> 2) * SEQ * NPROJ + (size_t)(pm & 3) * 64) * 2;
}

struct StaticOrder {
    int nM, nN, nwg, G, c;
    __host__ __device__ void init(int M, int N, int G_, int c_) { nM = M / BM; nN = N / BM; nwg = nM * nN; G = G_; c = c_; }
    __host__ __device__ bool next(int i, Unit& u) const {
        const long L = (long)i * G + c; if (L >= nwg) return false;
        int wgid = (int)L; { const int q = nwg / NXCD, r = nwg % NXCD, xcd = wgid % NXCD, off = wgid / NXCD; wgid = (xcd < r ? xcd * (q + 1) : r * (q + 1) + (xcd - r) * q) + off; }
        const int nig = WGM * nN, gid = wgid / nig, fm = gid * WGM, gsz = (nM - fm) < WGM ? (nM - fm) : WGM;
        u.pm = fm + ((wgid % nig) % gsz); u.pn = (wgid % nig) / gsz; return true;
    }
};

typedef f32x4 Acc[2][2][4][2];

template <class Epi, class Sched, bool ALIGN_EPI = true>
__device__ __forceinline__ void gemm_phase(LAS unsigned char* lds, const Gemm g, const Sched& S, const Epi& E) {
    const int tid = threadIdx.x, wid = __builtin_amdgcn_readfirstlane(tid >> 6), lane = tid & 63, wr = wid >> 2, wc = wid & 3, fr = lane & 15, fq = lane >> 4;
    const int K = g.K, nt = K / BK;
    unsigned voffA[2], voffB[2];
#pragma unroll
    for (int i = 0; i < 2; ++i) { int R, C; stage_rc(tid * 16 + i * 8192, R, C); const int Rb = (R & ~31) + perm32(R & 31);
        voffA[i] = (unsigned)(R * g.lda + C) * 2u; voffB[i] = (unsigned)(Rb * K + C) * 2u; }
    const size_t kstepA = (size_t)g.a_kstep, kstepB = (size_t)(BK * 2);
    const size_t hstepA = (size_t)HALF * g.lda * 2, hstepB = (size_t)HALF * K * 2;
    const size_t tstepB = 2 * hstepB;
    const unsigned ldsw = (unsigned)wid * 1024u;
    const int aoff = lds_byte(wr * 64 + fr, fq * 8), boff = lds_byte(wc * 32 + fr, fq * 8);
#define PG8_SA(b, h) (((b) * 2 + (h)) * HTB)
#define PG8_SB(b, h) ((4 + (b) * 2 + (h)) * HTB)
#define PG8_STAGE(bufoff, gbase, voff) do { _Pragma("unroll") for (int _i = 0; _i < 2; ++_i) \
        __builtin_amdgcn_global_load_lds((const unsigned*)((const char*)(gbase) + (voff)[_i]), (LAS unsigned*)(lds + (bufoff) + ldsw + _i * 8192), 16, 0, 0); } while (0)
#define PG8_LDA(dst, b, h) do { _Pragma("unroll") for (int m = 0; m < 4; ++m) _Pragma("unroll") for (int k = 0; k < 2; ++k) dst[m][k] = *(const LAS bf16x8*)(lds + PG8_SA(b, h) + aoff + m * 2048 + k * 1024); } while (0)
#define PG8_LDB(dst, b, h) do { _Pragma("unroll") for (int n = 0; n < 2; ++n) _Pragma("unroll") for (int k = 0; k < 2; ++k) dst[n][k] = *(const LAS bf16x8*)(lds + PG8_SB(b, h) + boff + n * 2048 + k * 1024); } while (0)
#define PG8_MMA(ai, bj, At, Bt) do { __builtin_amdgcn_s_setprio(1); _Pragma("unroll") for (int m = 0; m < 4; ++m) _Pragma("unroll") for (int n = 0; n < 2; ++n) _Pragma("unroll") for (int k = 0; k < 2; ++k) \
        acc[ai][bj][m][n] = __builtin_amdgcn_mfma_f32_16x16x32_bf16(Bt[n][k], At[m][k], acc[ai][bj][m][n], 0, 0, 0); __builtin_amdgcn_s_setprio(0); } while (0)
#define PG8_WAIT_V(n) asm volatile("s_waitcnt vmcnt(" #n ")" ::: "memory")
#define PG8_WAIT_L(n) asm volatile("s_waitcnt lgkmcnt(" #n ")" ::: "memory")
#define PG8_BAR __builtin_amdgcn_s_barrier()
#define PG8_SCHED __builtin_amdgcn_sched_barrier(0)
    Unit cur, nxt; int ui = 0;
    if (!S.next(0, cur)) return;
    f32x4 acc[2][2][4][2];
#pragma unroll
    for (int a = 0; a < 2; ++a)
#pragma unroll
        for (int b = 0; b < 2; ++b)
#pragma unroll
            for (int m = 0; m < 4; ++m)
#pragma unroll
                for (int n = 0; n < 2; ++n) acc[a][b][m][n] = (f32x4){0.f, 0.f, 0.f, 0.f};
    bf16x8 At[4][2], B0[2][2], B1[2][2];
    const char* cA = a_base(g, cur.pm); const char* cB = (const char*)g.Bt + (size_t)cur.pn * tstepB;
    PG8_STAGE(PG8_SB(0, 0), cB, voffB); PG8_STAGE(PG8_SB(0, 1), cB + hstepB, voffB); PG8_STAGE(PG8_SA(0, 0), cA, voffA); PG8_STAGE(PG8_SA(0, 1), cA + hstepA, voffA);
    if (wr == 1) PG8_BAR;
    PG8_WAIT_V(2); PG8_BAR;
    PG8_STAGE(PG8_SB(1, 0), cB + kstepB, voffB); PG8_STAGE(PG8_SA(1, 0), cA + kstepA, voffA); PG8_STAGE(PG8_SB(1, 1), cB + hstepB + kstepB, voffB);
    PG8_WAIT_V(6); PG8_BAR;
    for (;;) {
        const bool has_next = S.next(ui + 1, nxt);
        const char* nA = has_next ? a_base(g, nxt.pm) : cA; const char* nB = has_next ? (const char*)g.Bt + (size_t)nxt.pn * tstepB : cB;
        for (int t = 0; t < nt; t += 2) {
            const bool last = (t == nt - 2);
            const char* a1 = cA + (size_t)(t + 1) * kstepA;
            const char* a2 = last ? nA : cA + (size_t)(t + 2) * kstepA; const char* b2 = last ? nB : cB + (size_t)(t + 2) * kstepB;
            const char* a3 = a2 + kstepA; const char* b3 = b2 + kstepB;
            PG8_LDB(B0, 0, 0); PG8_LDB(B1, 0, 1); PG8_SCHED; PG8_LDA(At, 0, 0); PG8_STAGE(PG8_SA(1, 1), a1 + hstepA, voffA);
            PG8_WAIT_V(8); PG8_WAIT_L(0); PG8_BAR; PG8_MMA(0, 0, At, B0); PG8_MMA(0, 1, At, B1); PG8_BAR; PG8_SCHED;
            PG8_LDA(At, 0, 1); PG8_STAGE(PG8_SB(0, 0), b2, voffB); PG8_STAGE(PG8_SB(0, 1), b2 + hstepB, voffB); PG8_STAGE(PG8_SA(0, 0), a2, voffA);
            PG8_WAIT_V(8); PG8_WAIT_L(0); PG8_BAR; PG8_MMA(1, 0, At, B0); PG8_MMA(1, 1, At, B1); PG8_BAR; PG8_SCHED;
            PG8_LDB(B0, 1, 0); PG8_LDB(B1, 1, 1); PG8_SCHED; PG8_LDA(At, 1, 0); PG8_STAGE(PG8_SA(0, 1), a2 + hstepA, voffA);
            PG8_WAIT_V(8); PG8_WAIT_L(0); PG8_BAR; PG8_MMA(0, 0, At, B0); PG8_MMA(0, 1, At, B1); PG8_BAR; PG8_SCHED;
            PG8_LDA(At, 1, 1); PG8_STAGE(PG8_SB(1, 0), b3, voffB); PG8_STAGE(PG8_SB(1, 1), b3 + hstepB, voffB); PG8_STAGE(PG8_SA(1, 0), a3, voffA);
            PG8_WAIT_V(8); PG8_WAIT_L(0); PG8_BAR; PG8_MMA(1, 0, At, B0); PG8_MMA(1, 1, At, B1); PG8_BAR; PG8_SCHED;
        }
        if constexpr (ALIGN_EPI) { if (wr == 0) PG8_BAR; }
        E(acc, cur, wr, wc, fr, fq);
        if (!has_next) break;
#pragma unroll
        for (int a = 0; a < 2; ++a)
#pragma unroll
            for (int b = 0; b < 2; ++b)
#pragma unroll
                for (int m = 0; m < 4; ++m)
#pragma unroll
                    for (int n = 0; n < 2; ++n) acc[a][b][m][n] = (f32x4){0.f, 0.f, 0.f, 0.f};
        cur = nxt; cA = nA; cB = nB; ++ui;
        if constexpr (ALIGN_EPI) { if (wr == 1) PG8_BAR; }
    }
    PG8_WAIT_V(0);
    if constexpr (!ALIGN_EPI) { if (wr == 0) PG8_BAR; }
    PG8_BAR;
#undef PG8_SA
#undef PG8_SB
#undef PG8_STAGE
#undef PG8_LDA
#undef PG8_LDB
#undef PG8_MMA
#undef PG8_WAIT_V
#undef PG8_WAIT_L
#undef PG8_BAR
#undef PG8_SCHED
}

#define EPI_ROWS_BEGIN const int row0 = u.pm * BM + wr * 64 + fr; const int col0 = u.pn * BM + wc * 32 + 8 * fq; \
    _Pragma("unroll") for (int ai = 0; ai < 2; ++ai) _Pragma("unroll") for (int m = 0; m < 4; ++m) { const int row = row0 + ai * HALF + m * 16;
#define EPI_ROWS_END }

struct EpiProj {
    bf16_t* O; const float* r1; bf16_t* vst; bf16_t* vwt;
    __device__ __forceinline__ void operator()(const Acc& acc, const Unit& u, int wr, int wc, int fr, int fq) const {
        const float sc = (u.pn >= 4 && u.pn < 8) ? C2 : 1.f;
        if (u.pn == 11 || u.pn == 13) {
            bf16_t* vt = (u.pn == 11) ? vst : vwt;
            const int cl = wc * 32 + 8 * fq;
            EPI_ROWS_BEGIN
                const float rs = r1[row]; const int bb = row >> 12, tok = row & (SEQ - 1);
#pragma unroll
                for (int bj = 0; bj < 2; ++bj) { const int c0 = cl + bj * HALF; bf16_t* bp = vt + ((size_t)(bb * 4 + (c0 >> 6)) * 64 + (c0 & 63)) * SEQ + tok;
#pragma unroll
                    for (int e = 0; e < 4; ++e) { bp[(size_t)e * SEQ] = (bf16_t)f2bf(acc[ai][bj][m][0][e] * rs); bp[(size_t)(4 + e) * SEQ] = (bf16_t)f2bf(acc[ai][bj][m][1][e] * rs); } }
            EPI_ROWS_END
            (void)col0;
            return;
        }
        EPI_ROWS_BEGIN
            const float rs = r1[row] * sc; bf16_t* rowp = O + (size_t)row * NPROJ + col0;
#pragma unroll
            for (int bj = 0; bj < 2; ++bj) { const f32x4 v0 = acc[ai][bj][m][0] * rs, v1 = acc[ai][bj][m][1] * rs;
                u32x4 w; w.x = pk2(v0[0], v0[1]); w.y = pk2(v0[2], v0[3]); w.z = pk2(v1[0], v1[1]); w.w = pk2(v1[2], v1[3]);
                *(u32x4*)(rowp + bj * HALF) = w; }
        EPI_ROWS_END
    }
};
struct EpiCmp {
    bf16_t* O; const float* bias;
    __device__ __forceinline__ void operator()(const Acc& acc, const Unit& u, int wr, int wc, int fr, int fq) const {
        const int bc = wc * 32 + 8 * fq;
        f32x4 bv[2][2];
#pragma unroll
        for (int bj = 0; bj < 2; ++bj)
#pragma unroll
            for (int n = 0; n < 2; ++n) bv[bj][n] = *(const f32x4*)(bias + bc + bj * HALF + 4 * n);
        EPI_ROWS_BEGIN
            bf16_t* rowp = O + (size_t)row * 256 + col0;
#pragma unroll
            for (int bj = 0; bj < 2; ++bj) { const f32x4 v0 = acc[ai][bj][m][0] + bv[bj][0], v1 = acc[ai][bj][m][1] + bv[bj][1];
                u32x4 w; w.x = pk2(gelu_tanh(v0[0]), gelu_tanh(v0[1])); w.y = pk2(gelu_tanh(v0[2]), gelu_tanh(v0[3])); w.z = pk2(gelu_tanh(v1[0]), gelu_tanh(v1[1])); w.w = pk2(gelu_tanh(v1[2]), gelu_tanh(v1[3]));
                *(u32x4*)(rowp + bj * HALF) = w; }
        EPI_ROWS_END
    }
};
struct EpiGlu {
    bf16_t* O; const bf16_t* Z; const float* bias;
    __device__ __forceinline__ void operator()(const Acc& acc, const Unit& u, int wr, int wc, int fr, int fq) const {
        f32x4 bv[2][2];
#pragma unroll
        for (int bj = 0; bj < 2; ++bj)
#pragma unroll
            for (int n = 0; n < 2; ++n) bv[bj][n] = *(const f32x4*)(bias + u.pn * BM + wc * 32 + 8 * fq + bj * HALF + 4 * n);
        EPI_ROWS_BEGIN
            bf16_t* rowp = O + (size_t)row * DM + col0; const bf16_t* zp = Z + (size_t)row * 1024 + col0;
#pragma unroll
            for (int bj = 0; bj < 2; ++bj) { const f32x4 v0 = acc[ai][bj][m][0] + bv[bj][0], v1 = acc[ai][bj][m][1] + bv[bj][1];
                const u32x4 zz = *(const u32x4*)(zp + bj * HALF);
                u32x4 w; w.x = pk2(bflo(zz.x) * sigmoidf_(v0[0]), bfhi(zz.x) * sigmoidf_(v0[1])); w.y = pk2(bflo(zz.y) * sigmoidf_(v0[2]), bfhi(zz.y) * sigmoidf_(v0[3]));
                w.z = pk2(bflo(zz.z) * sigmoidf_(v1[0]), bfhi(zz.z) * sigmoidf_(v1[1])); w.w = pk2(bflo(zz.w) * sigmoidf_(v1[2]), bfhi(zz.w) * sigmoidf_(v1[3]));
                *(u32x4*)(rowp + bj * HALF) = w; }
        EPI_ROWS_END
    }
};
template <bool BF> struct EpiRes {
    const void* base; bf16_t* ob; float* ss;
    __device__ __forceinline__ void operator()(const Acc& acc, const Unit& u, int wr, int wc, int fr, int fq) const {
        EPI_ROWS_BEGIN
            const size_t off = (size_t)row * DM + col0; float q = 0.f;
#pragma unroll
            for (int bj = 0; bj < 2; ++bj) { f32x4 b0, b1;
                if (BF) { const u32x4 bb = *(const u32x4*)((const bf16_t*)base + off + bj * HALF); b0 = (f32x4){bflo(bb.x), bfhi(bb.x), bflo(bb.y), bfhi(bb.y)}; b1 = (f32x4){bflo(bb.z), bfhi(bb.z), bflo(bb.w), bfhi(bb.w)}; }
                else { b0 = *(const f32x4*)((const float*)base + off + bj * HALF); b1 = *(const f32x4*)((const float*)base + off + bj * HALF + 4); }
                const f32x4 v0 = acc[ai][bj][m][0] + b0, v1 = acc[ai][bj][m][1] + b1;
                q += (v0[0] * v0[0] + v0[1] * v0[1]) + (v0[2] * v0[2] + v0[3] * v0[3]) + (v1[0] * v1[0] + v1[1] * v1[1]) + (v1[2] * v1[2] + v1[3] * v1[3]);
                u32x4 w; w.x = pk2(v0[0], v0[1]); w.y = pk2(v0[2], v0[3]); w.z = pk2(v1[0], v1[1]); w.w = pk2(v1[2], v1[3]); *(u32x4*)(ob + off + bj * HALF) = w; }
            q += __shfl_xor(q, 16); q += __shfl_xor(q, 32);
            if (fq == 0) atomicAdd(ss + row, q);
        EPI_ROWS_END
    }
};
struct EpiUp {
    bf16_t* O; const float* ss;
    __device__ __forceinline__ void operator()(const Acc& acc, const Unit& u, int wr, int wc, int fr, int fq) const {
        EPI_ROWS_BEGIN
            const float rs = __builtin_amdgcn_rsqf(ss[row] * (1.f / DM) + EPS); bf16_t* rowp = O + (size_t)row * DFF + col0;
#pragma unroll
            for (int bj = 0; bj < 2; ++bj) { f32x4 v0 = acc[ai][bj][m][0] * rs, v1 = acc[ai][bj][m][1] * rs;
#pragma unroll
                for (int e = 0; e < 4; ++e) { const float a = fmaxf(v0[e], 0.f), b = fmaxf(v1[e], 0.f); v0[e] = a * a; v1[e] = b * b; }
                u32x4 w; w.x = pk2(v0[0], v0[1]); w.y = pk2(v0[2], v0[3]); w.z = pk2(v1[0], v1[1]); w.w = pk2(v1[2], v1[3]);
                *(u32x4*)(rowp + bj * HALF) = w; }
        EPI_ROWS_END
    }
};
}

typedef GAS unsigned gu32;
#define RLX_AGENT __ATOMIC_RELAXED, __HIP_MEMORY_SCOPE_AGENT
#define XB_TMO      128
#define XB_XCNT(j)  (256  + 64 * (j))
#define XB_XSUB(j)  (1280 + 64 * (j))
#define XB_XGEN(j)  (2304 + 64 * (j))
#define XB_TOP      3328
#define XB_TOPGEN   3392
#define XCD_BAR_WORDS 3456
#define XB_SPIN_CAP (1u << 22)
__device__ __forceinline__ unsigned xb_ld(unsigned* p)              { return __hip_atomic_load(p, __ATOMIC_RELAXED, __HIP_MEMORY_SCOPE_AGENT); }
__device__ __forceinline__ unsigned xb_add(unsigned* p, unsigned v) { return __hip_atomic_fetch_add(p, v, __ATOMIC_RELAXED, __HIP_MEMORY_SCOPE_AGENT); }
__device__ __forceinline__ unsigned xb_xcc_id() { return (unsigned)__builtin_amdgcn_s_getreg((3 << 11) | 20) & 0xFu; }
#define XB_SPIN(cond, bar) do { unsigned _sp = 0; while (cond) { __builtin_amdgcn_s_sleep(1); \
    if ((++_sp & 255u) == 0u) { if (xb_ld(&(bar)[XB_TMO])) break; if (_sp > XB_SPIN_CAP) { atomicAdd(&(bar)[XB_TMO], 1u); break; } } } } while (0)
struct XcdBarrier { unsigned* bar; unsigned x; volatile LAS unsigned* st; };
__device__ __forceinline__ XcdBarrier xcd_barrier_post(unsigned* bar, volatile LAS unsigned* st) {
    XcdBarrier b; b.bar = bar; b.x = xb_xcc_id(); b.st = st;
    if (threadIdx.x == 0) (void)xb_add(&bar[XB_XCNT(b.x)], 1u);
    return b;
}
__device__ __forceinline__ void xcd_barrier_complete(unsigned* bar, unsigned x, unsigned& nloc, unsigned& nx) {
    const unsigned G = gridDim.x * gridDim.y * gridDim.z;
    unsigned sum, cnt, mine, sp = 0u;
    for (;;) {
        sum = 0u; cnt = 0u; mine = 0u;
#pragma unroll
        for (unsigned j = 0; j < 16; ++j) { const unsigned c = xb_ld(&bar[XB_XCNT(j)]); sum += c; cnt += (c > 0u) ? 1u : 0u; mine = (j == x) ? c : mine; }
        if (sum == G) break;
        __builtin_amdgcn_s_sleep(1);
        if ((++sp & 255u) == 0u) { if (xb_ld(&bar[XB_TMO])) break; if (sp > XB_SPIN_CAP) { atomicAdd(&bar[XB_TMO], 1u); break; } }
    }
    nloc = mine > 0u ? mine : 1u; nx = cnt > 0u ? cnt : 1u;
}
__device__ __forceinline__ void xcd_barrier(const XcdBarrier& b) {
    asm volatile("s_waitcnt vmcnt(0)" ::: "memory");
    __syncthreads();
    if (threadIdx.x == 0) {
        unsigned* bar = b.bar;
        __builtin_amdgcn_s_waitcnt(0);
        unsigned nloc = b.st[0], nx = b.st[1];
        if (nloc == 0u) { xcd_barrier_complete(bar, b.x, nloc, nx); b.st[0] = nloc; b.st[1] = nx; }
        const unsigned old = xb_add(&bar[XB_XSUB(b.x)], 1u);
        const unsigned gen = old / nloc;
        if (old + 1u == (gen + 1u) * nloc) {
            __builtin_amdgcn_fence(__ATOMIC_RELEASE, "agent");
            asm volatile("s_waitcnt vmcnt(0)" ::: "memory");
            const unsigned og = xb_add(&bar[XB_TOP], 1u);
            const unsigned tg = og / nx;
            if (og + 1u == (tg + 1u) * nx) xb_add(&bar[XB_TOPGEN], 1u);
            else XB_SPIN(xb_ld(&bar[XB_TOPGEN]) == tg, bar);
            __builtin_amdgcn_fence(__ATOMIC_ACQUIRE, "agent");
            xb_add(&bar[XB_XGEN(b.x)], 1u);
            asm volatile("s_waitcnt vmcnt(0)" ::: "memory");
        } else {
            XB_SPIN(xb_ld(&bar[XB_XGEN(b.x)]) == gen, bar);
            __builtin_amdgcn_fence(__ATOMIC_ACQUIRE, "agent");
            asm volatile("s_waitcnt vmcnt(0)" ::: "memory");
        }
    }
    __syncthreads();
}

struct Args { const float* in[25]; float* out; unsigned char* ws; int ph_lo, ph_hi; };
struct Frame {
    LAS unsigned char* lds;
    int tid, lane, wave, vcu, G;
    const Args* a; float* out; unsigned char* ws;
};
enum { I_X = 0, I_N1W, I_WIN, I_ARE, I_AIM, I_LOGDT, I_BRE, I_BIM, I_CRE, I_CIM, I_D, I_WGLU, I_BGLU, I_PECK, I_WCK1, I_WCK2, I_PECV, I_WCV1, I_WCV2, I_WOUT, I_N2W, I_WUP, I_WDOWN, I_REL, I_NFW };

__device__ __forceinline__ void p0_transpose_item(const float* W, int K, int N, int Npad, bf16_t* WT, const float* scale, LAS float* scr, int item, int lane) {
    const int nblk = Npad / 64, kb = item / nblk, nb = item % nblk, k0 = 64 * kb, n0 = 64 * nb;
    const int rr = lane >> 4, cc = lane & 15, n = n0 + 4 * cc;
    f32x4 v[16];
#pragma unroll
    for (int i = 0; i < 16; ++i) { v[i] = (f32x4){0.f, 0.f, 0.f, 0.f}; if (n < N) v[i] = *(const f32x4*)(W + (size_t)(k0 + 4 * i + rr) * N + n); }
#pragma unroll
    for (int i = 0; i < 16; ++i) { const int kk = 4 * i + rr; f32x4 x = v[i]; if (scale) x = x * scale[k0 + kk];
        LAS float* d = scr + kk * 65 + 4 * cc; d[0] = x[0]; d[1] = x[1]; d[2] = x[2]; d[3] = x[3]; }
    LDS_WAIT();
    const int c = lane & 7;
#pragma unroll
    for (int j = 0; j < 8; ++j) { const int nn = (lane >> 3) + 8 * j; const LAS float* s = scr + (8 * c) * 65 + nn;
        u32x4 o; o.x = pk2(s[0 * 65], s[1 * 65]); o.y = pk2(s[2 * 65], s[3 * 65]); o.z = pk2(s[4 * 65], s[5 * 65]); o.w = pk2(s[6 * 65], s[7 * 65]);
        *(u32x4*)(WT + (size_t)(n0 + nn) * K + k0 + 8 * c) = o; }
    LDS_WAIT();
}
__device__ __forceinline__ void late_transposes(Frame& F, int part) {
    LAS float* scr = (LAS float*)(F.lds + F.wave * 16896);
    const int gw = F.vcu * NWAVES + F.wave, NGW = F.G * NWAVES, lane = F.lane;
    unsigned char* ws = F.ws;
    constexpr int T_GLU = (1024 / 64) * (1024 / 64), T_OUT = (DM / 64) * (DM / 64), T_UP = (DM / 64) * (DFF / 64), T_DOWN = (DFF / 64) * (DM / 64);
    if (part == 0) {
        int g2 = gw, n2 = NGW;
        if (F.G > 64) { if (blockIdx.x < 32) return; g2 = ((int)blockIdx.x - 32) * NWAVES + F.wave; n2 = (F.G - 32) * NWAVES; }
        for (int it = g2; it < T_GLU + T_OUT + T_UP; it += n2) {
            if (it < T_UP) p0_transpose_item(F.a->in[I_WUP], DM, DFF, DFF, (bf16_t*)(ws + WS_WUP), F.a->in[I_N2W], scr, it, lane);
            else if (it < T_UP + T_OUT) p0_transpose_item(F.a->in[I_WOUT], DM, DM, DM, (bf16_t*)(ws + WS_WOUT), nullptr, scr, it - T_UP, lane);
            else p0_transpose_item(F.a->in[I_WGLU], 1024, 1024, 1024, (bf16_t*)(ws + WS_WGLU), nullptr, scr, it - T_UP - T_OUT, lane);
        }
    } else {
        for (int it = gw; it < T_DOWN; it += NGW) p0_transpose_item(F.a->in[I_WDOWN], DFF, DM, DM, (bf16_t*)(ws + WS_WDOWN), nullptr, scr, it, lane);
    }
}
__device__ __forceinline__ void p0_prologue(Frame& F) {
    LAS float* scr = (LAS float*)(F.lds + F.wave * 16896);
    const int gw = F.vcu * NWAVES + F.wave, NGW = F.G * NWAVES, lane = F.lane;
    unsigned char* ws = F.ws;
    constexpr int T_IN = (DM / 64) * (NPROJ / 64), T_C1 = (2048 / 64) * (256 / 64), T_C2 = (256 / 64) * (64 / 64);
    constexpr int NITEMS = T_IN + 2 * T_C1 + 2 * T_C2;
    for (int it = gw; it < NITEMS; it += NGW) {
        int r = it;
        if (r < T_IN) { p0_transpose_item(F.a->in[I_WIN], DM, D_IN, NPROJ, (bf16_t*)(ws + WS_WIN), F.a->in[I_N1W], scr, r, lane); continue; } r -= T_IN;
        if (r < T_C1) { p0_transpose_item(F.a->in[I_WCK1], 2048, 256, 256, (bf16_t*)(ws + WS_WC1K), nullptr, scr, r, lane); continue; } r -= T_C1;
        if (r < T_C1) { p0_transpose_item(F.a->in[I_WCV1], 2048, 256, 256, (bf16_t*)(ws + WS_WC1V), nullptr, scr, r, lane); continue; } r -= T_C1;
        if (r < T_C2) { p0_transpose_item(F.a->in[I_WCK2], 256, 64, 64, (bf16_t*)(ws + WS_WC2K), nullptr, scr, r, lane); continue; } r -= T_C2;
        p0_transpose_item(F.a->in[I_WCV2], 256, 64, 64, (bf16_t*)(ws + WS_WC2V), nullptr, scr, r, lane);
    }
    {
        const float* x = F.a->in[I_X]; bf16_t* xb = (bf16_t*)(ws + WS_XB); float* r1 = (float*)(ws + WS_R1);
        for (int mrow = gw; mrow < MTOK; mrow += NGW) {
            const f32x4* xr = (const f32x4*)(x + (size_t)mrow * DM) + lane; u32x2* o8 = (u32x2*)(xb + (size_t)mrow * DM) + lane;
            f32x4 v[8]; float s = 0.f;
#pragma unroll
            for (int j = 0; j < 8; ++j) { v[j] = xr[64 * j]; s += (v[j].x * v[j].x + v[j].y * v[j].y) + (v[j].z * v[j].z + v[j].w * v[j].w); }
            s = wave_sum(s);
#pragma unroll
            for (int j = 0; j < 8; ++j) { u32x2 w; w.x = pk2(v[j].x, v[j].y); w.y = pk2(v[j].z, v[j].w); o8[64 * j] = w; }
            if (lane == 0) r1[mrow] = __builtin_amdgcn_rsqf(s * (1.f / DM) + EPS);
        }
    }
    {
        const int idx = gw * 64 + lane;
        if (idx < 4096) {
            const int g = idx >> 6;
            const float dt = expf(F.a->in[I_LOGDT][g]); const float ar = F.a->in[I_ARE][idx], ai = F.a->in[I_AIM][idx];
            const float em1 = expm1f(dt * ar), th = dt * ai, c = cosf(th), s = sinf(th), sh = sinf(0.5f * th);
            const float mag = em1 + 1.f, abr = mag * c, abi = mag * s;
            const float zr = em1 * c - 2.f * sh * sh, zi = abi;
            const float den = ar * ar + ai * ai;
            const float cr = (zr * ar + zi * ai) / den, ci = (zi * ar - zr * ai) / den;
            const float magS = expf(512.f * dt * ar), thS = 512.f * th;
            f32x4 ab; ab.x = abr; ab.y = abi; ab.z = magS * cosf(thS); ab.w = magS * sinf(thS);
            ((f32x4*)(ws + WS_S5AB))[idx] = ab;
            bf16_t* bre = (bf16_t*)(ws + WS_BRE) + (size_t)idx * 16; bf16_t* bim = (bf16_t*)(ws + WS_BIM) + (size_t)idx * 16;
            const float* sbr = F.a->in[I_BRE] + (size_t)idx * 16; const float* sbi = F.a->in[I_BIM] + (size_t)idx * 16;
#pragma unroll
            for (int h = 0; h < 16; ++h) { const float br = sbr[h], bi = sbi[h]; bre[h] = (bf16_t)f2bf(cr * br - ci * bi); bim[h] = (bf16_t)f2bf(cr * bi + ci * br); }
        }
        const int i2 = gw * 64 + lane;
        if (i2 < 64 * 16 * 64) { bf16_t* cm = (bf16_t*)(ws + WS_CM); ((unsigned*)cm)[i2] = pk2(F.a->in[I_CRE][i2], -F.a->in[I_CIM][i2]); }
        if (i2 < 2048) { const int h = i2 >> 7, d = i2 & 127; ((float*)(ws + WS_BTAB))[i2] = F.a->in[I_REL][(int)T5B[d] * 16 + h] * LOG2E; }
    }
    for (int it = gw; it < 2 * 32 * 4; it += NGW) {
        const int which = it >> 7, ks = (it >> 2) & 31, jg = it & 3;
        const float* pe = F.a->in[which ? I_PECV : I_PECK] + ks * 64; const float* w1 = F.a->in[which ? I_WCV1 : I_WCK1] + (size_t)(ks * 64) * 256 + jg * 64 + lane;
        float a = 0.f;
#pragma unroll 16
        for (int k = 0; k < 64; ++k) a += pe[k] * w1[(size_t)k * 256];
        ((float*)(ws + WS_CBP))[(which * 32 + ks) * 256 + jg * 64 + lane] = a;
    }
    for (int idx = gw * 64 + lane; idx < MTOK; idx += NGW * 64) { ((float*)(ws + CTL_SS1))[idx] = 0.f; ((float*)(ws + CTL_SS2))[idx] = 0.f; }
    if (gw == 0 && lane < 32) ((unsigned*)(ws + CTL_KMAX))[lane] = 0u;
}
__device__ __forceinline__ void cmp_bias_reduce(Frame& F) {
    if (blockIdx.x != 0) return;
    const float* p = (const float*)(F.ws + WS_CBP); float* o = (float*)(F.ws + WS_CBF);
    const int which = F.tid >> 8, col = F.tid & 255; float a = 0.f;
    for (int ks = 0; ks < 32; ++ks) a += p[(which * 32 + ks) * 256 + col];
    o[which * 256 + col] = a;
}

template <bool FINAL>
__device__ __forceinline__ void s5_item(Frame& F, int b, int g, int seg) {
    const int lane = F.lane, pp = lane & 31, hi = lane >> 5;
    unsigned char* ws = F.ws;
    LAS unsigned char* L = F.lds + F.wave * 16896;
    const bf16_t* proj = (const bf16_t*)(ws + WS_PROJ);
    const f32x4 ab = ((const f32x4*)(ws + WS_S5AB))[g * 64 + lane];
    const float ar = ab.x, ai = ab.y;
    const bf16_t* bre = (const bf16_t*)(ws + WS_BRE) + (size_t)g * 64 * 16; const bf16_t* bim = (const bf16_t*)(ws + WS_BIM) + (size_t)g * 64 * 16;
    const bf16x8 bre0 = *(const bf16x8*)(bre + pp * 16 + 8 * hi), bre1 = *(const bf16x8*)(bre + (32 + pp) * 16 + 8 * hi);
    const bf16x8 bim0 = *(const bf16x8*)(bim + pp * 16 + 8 * hi), bim1 = *(const bf16x8*)(bim + (32 + pp) * 16 + 8 * hi);
    f32x2* segend = (f32x2*)(ws + WS_SEG) + (size_t)((b * 64 + g) * 8) * 64;
    float sr = 0.f, si = 0.f;
    bf16x8 cf[4]; f32x4 dv = {0.f, 0.f, 0.f, 0.f};
    if (FINAL) {
        for (int s2 = 0; s2 < seg; ++s2) { const f32x2 e = segend[s2 * 64 + lane]; const float nr = ab.z * sr - ab.w * si + e.x, ni = ab.z * si + ab.w * sr + e.y; sr = nr; si = ni; }
        const bf16_t* cm = (const bf16_t*)(ws + WS_CM) + (size_t)(g * 16 + (lane & 15)) * 128 + 8 * (lane >> 4);
#pragma unroll
        for (int ks = 0; ks < 4; ++ks) cf[ks] = *(const bf16x8*)(cm + 32 * ks);
        dv = *(const f32x4*)(F.a->in[I_D] + g * 16 + 4 * (lane >> 4));
    }
    bf16_t* zb = (bf16_t*)(ws + WS_Z);
    const bf16_t* up = proj + ((size_t)b * SEQ + seg * 512 + pp) * NPROJ + COL_U + g * 16 + 8 * hi;
    asm volatile("" :: "v"(bre0), "v"(bre1), "v"(bim0), "v"(bim1), "v"(ab));
    if (FINAL) asm volatile("" :: "v"(cf[0]), "v"(cf[1]), "v"(cf[2]), "v"(cf[3]), "v"(dv));
    const bf16_t* up2 = proj + ((size_t)b * SEQ + seg * 512 + (lane & 15)) * NPROJ + COL_U + g * 16 + 4 * (lane >> 4);
    u32x2 uu_next0 = {0u, 0u}, uu_next1 = {0u, 0u};
    if (FINAL) { uu_next0 = *(const u32x2*)up2; uu_next1 = *(const u32x2*)(up2 + (size_t)16 * NPROJ); }
    bf16x8 ua_next = *(const bf16x8*)up;
    for (int ch = 0; ch < 16; ++ch) {
        const size_t row0 = (size_t)b * SEQ + seg * 512 + ch * 32;
        const bf16x8 ua = ua_next;
        ua_next = *(const bf16x8*)(up + (size_t)(ch < 15 ? ch + 1 : 15) * 32 * NPROJ);
        const u32x2 uu_cur[2] = {uu_next0, uu_next1};
        if (FINAL) { const bf16_t* q2 = up2 + (size_t)(ch < 15 ? ch + 1 : 15) * 32 * NPROJ; uu_next0 = *(const u32x2*)q2; uu_next1 = *(const u32x2*)(q2 + (size_t)16 * NPROJ); }
        const f32x16 z16 = {};
        const f32x16 re0 = __builtin_amdgcn_mfma_f32_32x32x16_bf16(ua, bre0, z16, 0, 0, 0), im0 = __builtin_amdgcn_mfma_f32_32x32x16_bf16(ua, bim0, z16, 0, 0, 0);
        const f32x16 re1 = __builtin_amdgcn_mfma_f32_32x32x16_bf16(ua, bre1, z16, 0, 0, 0), im1 = __builtin_amdgcn_mfma_f32_32x32x16_bf16(ua, bim1, z16, 0, 0, 0);
#pragma unroll
        for (int r = 0; r < 16; ++r) { const int t = crow(r, hi);
            *(LAS f32x2*)(L + t * 528 + 8 * pp) = (f32x2){re0[r], im0[r]};
            *(LAS f32x2*)(L + t * 528 + 8 * (32 + pp)) = (f32x2){re1[r], im1[r]}; }
        LDS_WAIT();
#pragma unroll 8
        for (int t = 0; t < 32; ++t) {
            const f32x2 xv = *(const LAS f32x2*)(L + t * 528 + 8 * lane);
            const float nr = ar * sr - ai * si + xv.x, ni = ar * si + ai * sr + xv.y; sr = nr; si = ni;
            if (FINAL) *(LAS unsigned*)(L + t * 528 + 4 * lane) = pk2(sr, si);
        }
        if (FINAL) {
            LDS_WAIT();
#pragma unroll
            for (int tt = 0; tt < 2; ++tt) {
                f32x4 acc = {0.f, 0.f, 0.f, 0.f};
#pragma unroll
                for (int ks = 0; ks < 4; ++ks) { const bf16x8 sb = *(const LAS bf16x8*)(L + (16 * tt + (lane & 15)) * 528 + (32 * ks + 8 * (lane >> 4)) * 2);
                    acc = __builtin_amdgcn_mfma_f32_16x16x32_bf16(cf[ks], sb, acc, 0, 0, 0); }
                const size_t row = row0 + 16 * tt + (lane & 15);
                const u32x2 uu = uu_cur[tt];
                const float y0 = acc[0] + dv[0] * bflo(uu.x), y1 = acc[1] + dv[1] * bfhi(uu.x), y2 = acc[2] + dv[2] * bflo(uu.y), y3 = acc[3] + dv[3] * bfhi(uu.y);
                u32x2 w; w.x = pk2(gelu_tanh(y0), gelu_tanh(y1)); w.y = pk2(gelu_tanh(y2), gelu_tanh(y3));
                *(u32x2*)(zb + row * 1024 + g * 16 + 4 * (lane >> 4)) = w;
            }
        }
        LDS_WAIT();
    }
    if (!FINAL) segend[seg * 64 + lane] = (f32x2){sr, si};
}
__device__ __forceinline__ void cmul(float& cr, float& ci, float ar, float ai, float br, float bi) { cr = ar * br - ai * bi; ci = ar * bi + ai * br; }
__device__ __forceinline__ void s5_pass1_item(Frame& F, int b, int g, int seg) {
    const int lane = F.lane, pp = lane & 31, hi = lane >> 5;
    unsigned char* ws = F.ws;
    const bf16_t* proj = (const bf16_t*)(ws + WS_PROJ);
    const bf16_t* bre = (const bf16_t*)(ws + WS_BRE) + (size_t)g * 64 * 16; const bf16_t* bim = (const bf16_t*)(ws + WS_BIM) + (size_t)g * 64 * 16;
    const bf16x8 bre0 = *(const bf16x8*)(bre + pp * 16 + 8 * hi), bre1 = *(const bf16x8*)(bre + (32 + pp) * 16 + 8 * hi);
    const bf16x8 bim0 = *(const bf16x8*)(bim + pp * 16 + 8 * hi), bim1 = *(const bf16x8*)(bim + (32 + pp) * 16 + 8 * hi);
    float wr[2][16], wi[2][16], a32r[2], a32i[2];
#pragma unroll
    for (int T = 0; T < 2; ++T) {
        const f32x4 ab = ((const f32x4*)(ws + WS_S5AB))[g * 64 + 32 * T + pp];
        float pr[4], pi[4];
        pr[0] = 1.f; pi[0] = 0.f; pr[1] = ab.x; pi[1] = ab.y; cmul(pr[2], pi[2], ab.x, ab.y, ab.x, ab.y); cmul(pr[3], pi[3], pr[2], pi[2], ab.x, ab.y);
        float q4r, q4i, q8r, q8i, q16r, q16i, q24r, q24i;
        cmul(q4r, q4i, pr[2], pi[2], pr[2], pi[2]); cmul(q8r, q8i, q4r, q4i, q4r, q4i); cmul(q16r, q16i, q8r, q8i, q8r, q8i); cmul(q24r, q24i, q16r, q16i, q8r, q8i);
        const float fr = hi ? 1.f : q4r, fi = hi ? 0.f : q4i;
        const float br_[4] = {1.f, q8r, q16r, q24r}, bi_[4] = {0.f, q8i, q16i, q24i};
#pragma unroll
        for (int r = 0; r < 16; ++r) {
            float tr, ti; cmul(tr, ti, br_[3 - (r >> 2)], bi_[3 - (r >> 2)], pr[3 - (r & 3)], pi[3 - (r & 3)]);
            cmul(wr[T][r], wi[T][r], tr, ti, fr, fi);
        }
        float t28r, t28i; cmul(t28r, t28i, q24r, q24i, q4r, q4i); cmul(a32r[T], a32i[T], t28r, t28i, q4r, q4i);
    }
    float sr[2] = {0.f, 0.f}, si[2] = {0.f, 0.f};
    const bf16_t* up = proj + ((size_t)b * SEQ + seg * 512 + pp) * NPROJ + COL_U + g * 16 + 8 * hi;
    asm volatile("" :: "v"(bre0), "v"(bre1), "v"(bim0), "v"(bim1));
    bf16x8 ua_next = *(const bf16x8*)up;
    for (int ch = 0; ch < 16; ++ch) {
        const bf16x8 ua = ua_next;
        ua_next = *(const bf16x8*)(up + (size_t)(ch < 15 ? ch + 1 : 15) * 32 * NPROJ);
        const f32x16 z16 = {};
        const f32x16 re0 = __builtin_amdgcn_mfma_f32_32x32x16_bf16(ua, bre0, z16, 0, 0, 0), im0 = __builtin_amdgcn_mfma_f32_32x32x16_bf16(ua, bim0, z16, 0, 0, 0);
        const f32x16 re1 = __builtin_amdgcn_mfma_f32_32x32x16_bf16(ua, bre1, z16, 0, 0, 0), im1 = __builtin_amdgcn_mfma_f32_32x32x16_bf16(ua, bim1, z16, 0, 0, 0);
        float e0r = 0.f, e0i = 0.f, e1r = 0.f, e1i = 0.f;
#pragma unroll
        for (int r = 0; r < 16; ++r) {
            e0r += wr[0][r] * re0[r] - wi[0][r] * im0[r]; e0i += wr[0][r] * im0[r] + wi[0][r] * re0[r];
            e1r += wr[1][r] * re1[r] - wi[1][r] * im1[r]; e1i += wr[1][r] * im1[r] + wi[1][r] * re1[r];
        }
        e0r = pair_sum(e0r); e0i = pair_sum(e0i); e1r = pair_sum(e1r); e1i = pair_sum(e1i);
        float nr, ni;
        cmul(nr, ni, a32r[0], a32i[0], sr[0], si[0]); sr[0] = nr + e0r; si[0] = ni + e0i;
        cmul(nr, ni, a32r[1], a32i[1], sr[1], si[1]); sr[1] = nr + e1r; si[1] = ni + e1i;
    }
    f32x2* segend = (f32x2*)(ws + WS_SEG) + (size_t)((b * 64 + g) * 8) * 64;
    segend[seg * 64 + 32 * hi + pp] = hi ? (f32x2){sr[1], si[1]} : (f32x2){sr[0], si[0]};
}
template <bool FINAL> __device__ __forceinline__ void s5_phase(Frame& F) {
    int gw = F.vcu * NWAVES + F.wave, NGW = F.G * NWAVES;
    if (!FINAL && F.G > 64) { if (blockIdx.x < 32) return; gw = ((int)blockIdx.x - 32) * NWAVES + F.wave; NGW = (F.G - 32) * NWAVES; }
    for (int it = gw; it < BATCH * 64 * 8; it += NGW) { const int g = it & 63, bs = it >> 6; if (FINAL) s5_item<true>(F, bs >> 3, g, bs & 7); else s5_pass1_item(F, bs >> 3, g, bs & 7); }
}

__device__ __forceinline__ void cmp2_phase(Frame& F) {
    const int gw = F.vcu * NWAVES + F.wave, NGW = F.G * NWAVES, lane = F.lane, pp = lane & 31, hi = lane >> 5;
    unsigned char* ws = F.ws;
    for (int it = gw; it < 256; it += NGW) {
        const int which = it >> 7, rt = it & 127;
        const bf16_t* Hc = (const bf16_t*)(ws + WS_HC) + (size_t)which * 4096 * 256 + (size_t)(32 * rt + pp) * 256 + 8 * hi;
        const bf16_t* W2 = (const bf16_t*)(ws + (which ? WS_WC2V : WS_WC2K)) + (size_t)pp * 256 + 8 * hi;
        bf16_t* O = (bf16_t*)(ws + (which ? WS_VCMP : WS_KCMP));
        f32x16 a0 = {}, a1 = {};
#pragma unroll 4
        for (int ks = 0; ks < 16; ++ks) { const bf16x8 a = *(const bf16x8*)(Hc + 16 * ks), b0 = *(const bf16x8*)(W2 + 16 * ks), b1 = *(const bf16x8*)(W2 + 32 * 256 + 16 * ks);
            a0 = __builtin_amdgcn_mfma_f32_32x32x16_bf16(a, b0, a0, 0, 0, 0); a1 = __builtin_amdgcn_mfma_f32_32x32x16_bf16(a, b1, a1, 0, 0, 0); }
        if (which == 0) {
#pragma unroll
            for (int r = 0; r < 16; ++r) { const int row = 32 * rt + crow(r, hi); const bool zero = (row & 255) == 255;
                O[(size_t)row * 64 + pp] = zero ? (bf16_t)0 : (bf16_t)f2bf(a0[r]); O[(size_t)row * 64 + 32 + pp] = zero ? (bf16_t)0 : (bf16_t)f2bf(a1[r]); }
        } else {
            bf16_t* OT = (bf16_t*)(ws + WS_VCT);
#pragma unroll
            for (int c = 0; c < 4; ++c) { const int row = 32 * rt + 8 * c + 4 * hi; const int bgx = row >> 8, n = row & 255;
                float x0[4], x1[4];
#pragma unroll
                for (int e = 0; e < 4; ++e) { const bool zero = (n + e) == 255; x0[e] = zero ? 0.f : a0[4 * c + e]; x1[e] = zero ? 0.f : a1[4 * c + e]; }
                *(u32x2*)(OT + ((size_t)bgx * 64 + pp) * 256 + n) = (u32x2){pk2(x0[0], x0[1]), pk2(x0[2], x0[3])};
                *(u32x2*)(OT + ((size_t)bgx * 64 + 32 + pp) * 256 + n) = (u32x2){pk2(x1[0], x1[1]), pk2(x1[2], x1[3])}; }
        }
    }
}

__device__ __forceinline__ void knorm_phase(Frame& F) {
    const int gw = F.vcu * NWAVES + F.wave, NGW = F.G * NWAVES, lane = F.lane;
    const bf16_t* proj = (const bf16_t*)(F.ws + WS_PROJ);
    for (int it = gw; it < 2 * 16 * 64; it += NGW) {
        const int tensor = it >> 10, bg = (it >> 6) & 15, tb = it & 63;
        const u32x4* p = (const u32x4*)(proj + ((size_t)(bg >> 2) * SEQ + tb * 64 + lane) * NPROJ + (tensor ? COL_KW : COL_KS) + (bg & 3) * 64);
        float ss = 0.f;
#pragma unroll
        for (int k = 0; k < 8; ++k) { const u32x4 w = p[k]; const unsigned ww[4] = {w.x, w.y, w.z, w.w};
#pragma unroll
            for (int e = 0; e < 4; ++e) { const float a = bflo(ww[e]), b2 = bfhi(ww[e]); ss += a * a + b2 * b2; } }
#pragma unroll
        for (int o = 1; o < 64; o <<= 1) ss = fmaxf(ss, __shfl_xor(ss, o));
        if (lane == 0) atomicMax((unsigned*)(F.ws + CTL_KMAX) + tensor * 16 + bg, __builtin_bit_cast(unsigned, ss));
    }
}

namespace att {
constexpr int KSTR = 144, VSTR = 136, KVB = 64 * KSTR + 64 * VSTR;
constexpr int BIAS_OFF = 2 * KVB, WSCR_OFF = BIAS_OFF + 2048, IMP_OFF = WSCR_OFF + 8 * 256, SEL_OFF = IMP_OFF + 64 * 65 * 4, OT_OFF = SEL_OFF + 512, OT_STR = 68, OT_WAVE = 32 * OT_STR * 4, TAB2_OFF = OT_OFF + 8 * OT_WAVE, TAB2_N = 640, BMAX_OFF = TAB2_OFF + 4 * TAB2_N * 4  , END_OFF = BMAX_OFF + 64;
static_assert(END_OFF <= MISC_OFF, "attention LDS map");
constexpr float NEG = -1e30f;
enum { CMP_A = 0, CMP_B = 1, SLC = 2, WIN = 3 };
struct TileRegs { u32x4 k, v; };
struct Src { const bf16_t* k; size_t kstride; const bf16_t* vt; size_t vstride; };
struct Ctx {
    LAS unsigned char* lds; int tid, lane, wave, q, hi, tl, head, t, i;
    bf16x8 qr[4];
};
__device__ __forceinline__ void load_tile(TileRegs& R, const Src& S, int key0, int tid) {
    const unsigned r = (unsigned)tid >> 3, c = (unsigned)tid & 7u;
    const unsigned koff = (r * (unsigned)S.kstride + c * 8u) * 2u, voff = (r * (unsigned)S.vstride + c * 8u) * 2u;
    const char* kb = (const char*)S.k + (size_t)key0 * S.kstride * 2; const char* vb = (const char*)S.vt + (size_t)key0 * 2;
    R.k = *(const u32x4*)(kb + koff);
    R.v = *(const u32x4*)(vb + voff);
}
__device__ __forceinline__ void store_tile(const TileRegs& R, LAS unsigned char* lds, int buf, int tid) {
    const int r = tid >> 3, c = tid & 7;
    LAS unsigned char* b = lds + buf * KVB;
    *(LAS u32x4*)(b + r * KSTR + c * 16) = R.k;
    *(LAS u32x2*)(b + 64 * KSTR + r * VSTR + c * 16) = (u32x2){R.v.x, R.v.y};
    *(LAS u32x2*)(b + 64 * KSTR + r * VSTR + c * 16 + 8) = (u32x2){R.v.z, R.v.w};
}
__device__ __forceinline__ void qk_tile(f32x16& p0, f32x16& p1, const f32x16& cin, const Ctx& C, int buf) {
    const LAS unsigned char* kl = C.lds + buf * KVB + C.q * KSTR + 16 * C.hi;
    bf16x8 kf[8];
#pragma unroll
    for (int d0 = 0; d0 < 4; ++d0) { kf[2 * d0] = *(const LAS bf16x8*)(kl + 32 * d0); kf[2 * d0 + 1] = *(const LAS bf16x8*)(kl + 32 * KSTR + 32 * d0); }
    __builtin_amdgcn_sched_barrier(0);
    p0 = __builtin_amdgcn_mfma_f32_32x32x16_bf16(kf[0], C.qr[0], cin, 0, 0, 0); p1 = __builtin_amdgcn_mfma_f32_32x32x16_bf16(kf[1], C.qr[0], cin, 0, 0, 0);
#pragma unroll
    for (int d0 = 1; d0 < 4; ++d0) { p0 = __builtin_amdgcn_mfma_f32_32x32x16_bf16(kf[2 * d0], C.qr[d0], p0, 0, 0, 0); p1 = __builtin_amdgcn_mfma_f32_32x32x16_bf16(kf[2 * d0 + 1], C.qr[d0], p1, 0, 0, 0); }
}
template <int MODE> __device__ __forceinline__ void mask_bias(f32x16& p0, f32x16& p1, const Ctx& C, int kbase, bool sel) {
    const LAS float* bt = (const LAS float*)(C.lds + BIAS_OFF) + C.head * 128;
    const int d00 = (MODE == CMP_A || MODE == CMP_B) ? (C.t - 31 - 16 * (kbase + 4 * C.hi)) : (C.t - kbase - 4 * C.hi);
    float bv[2][16];
#pragma unroll
    for (int T = 0; T < 2; ++T)
#pragma unroll
        for (int r = 0; r < 16; ++r) {
            const int ko = 32 * T + (r & 3) + 8 * (r >> 2);
            const int dist = (MODE == CMP_A || MODE == CMP_B) ? (d00 - 16 * ko) : (d00 - ko);
            const int di = dist < 0 ? 0 : (dist > 127 ? 127 : dist);
            bv[T][r] = bt[di];
        }
    __builtin_amdgcn_sched_barrier(0);
#pragma unroll
    for (int T = 0; T < 2; ++T)
#pragma unroll
        for (int r = 0; r < 16; ++r) {
            const int ko = 32 * T + (r & 3) + 8 * (r >> 2);
            const int dist = (MODE == CMP_A || MODE == CMP_B) ? (d00 - 16 * ko) : (d00 - ko);
            bool valid = dist >= 0; if (MODE == WIN) valid = valid && dist < 512; if (MODE == SLC) valid = valid && sel;
            if (T == 0) p0[r] = valid ? p0[r] + bv[T][r] : NEG; else p1[r] = valid ? p1[r] + bv[T][r] : NEG;
        }
}
__device__ __forceinline__ void mask_bias2(f32x16& p0, f32x16& p1, const Ctx& C, int kbase) {
    const int d00 = C.t - kbase - 4 * C.hi;
    const LAS float* bp = (const LAS float*)(C.lds + TAB2_OFF) + C.head * TAB2_N + (d00 + 4);
#pragma unroll
    for (int T = 0; T < 2; ++T) {
        float bv[16];
#pragma unroll
        for (int r = 0; r < 16; ++r) bv[r] = bp[59 - (32 * T + (r & 3) + 8 * (r >> 2))];
        __builtin_amdgcn_sched_barrier(0);
#pragma unroll
        for (int r = 0; r < 16; ++r) { if (T == 0) p0[r] += bv[r]; else p1[r] += bv[r]; }
        __builtin_amdgcn_sched_barrier(0);
    }
}
__device__ __forceinline__ float quad_sum(float v) {
    v += __builtin_bit_cast(float, __builtin_amdgcn_mov_dpp(__builtin_bit_cast(int, v), 0xB1, 0xF, 0xF, true));
    v += __builtin_bit_cast(float, __builtin_amdgcn_mov_dpp(__builtin_bit_cast(int, v), 0x4E, 0xF, 0xF, true));
    return v;
}
__device__ __forceinline__ float tile_max(const f32x16& p0, const f32x16& p1) {
    float a = fmaxf(fmaxf(p0[0], p1[0]), p0[1]), b = fmaxf(fmaxf(p1[1], p0[2]), p1[2]);
#pragma unroll
    for (int r = 3; r < 15; r += 2) { a = fmaxf(fmaxf(a, p0[r]), p1[r]); b = fmaxf(fmaxf(b, p0[r + 1]), p1[r + 1]); }
    a = fmaxf(fmaxf(a, p0[15]), p1[15]);
    return pair_max(fmaxf(a, b));
}
__device__ __forceinline__ void v_load(bf16x8 (&vf)[8], const Ctx& C, int buf) {
    const LAS unsigned char* vl = C.lds + buf * KVB + 64 * KSTR + C.q * VSTR + 8 * C.hi;
#pragma unroll
    for (int db = 0; db < 2; ++db)
#pragma unroll
        for (int T = 0; T < 2; ++T)
#pragma unroll
            for (int s = 0; s < 2; ++s) {
                const LAS unsigned char* a = vl + db * 32 * VSTR + (32 * T + 16 * s) * 2;
                const u32x2 lo = *(const LAS u32x2*)a, hi2 = *(const LAS u32x2*)(a + 16);
                const u32x4 vv = {lo.x, lo.y, hi2.x, hi2.y};
                vf[db * 4 + T * 2 + s] = __builtin_bit_cast(bf16x8, vv);
            }
}
__device__ __forceinline__ void pv_mma(f32x16 (&o)[2], const f32x16& p0, const f32x16& p1, const bf16x8 (&vf)[8]) {
    bf16x8 pa[2][2];
#pragma unroll
    for (int s = 0; s < 2; ++s) {
        u32x4 w0, w1;
        w0.x = pk2(p0[8 * s + 0], p0[8 * s + 1]); w0.y = pk2(p0[8 * s + 2], p0[8 * s + 3]); w0.z = pk2(p0[8 * s + 4], p0[8 * s + 5]); w0.w = pk2(p0[8 * s + 6], p0[8 * s + 7]);
        w1.x = pk2(p1[8 * s + 0], p1[8 * s + 1]); w1.y = pk2(p1[8 * s + 2], p1[8 * s + 3]); w1.z = pk2(p1[8 * s + 4], p1[8 * s + 5]); w1.w = pk2(p1[8 * s + 6], p1[8 * s + 7]);
        pa[0][s] = __builtin_bit_cast(bf16x8, w0); pa[1][s] = __builtin_bit_cast(bf16x8, w1);
    }
#pragma unroll
    for (int T = 0; T < 2; ++T)
#pragma unroll
        for (int s = 0; s < 2; ++s)
#pragma unroll
            for (int db = 0; db < 2; ++db) o[db] = __builtin_amdgcn_mfma_f32_32x32x16_bf16(pa[T][s], vf[db * 4 + T * 2 + s], o[db], 0, 0, 0);
}
__device__ __forceinline__ void row_scale(f32x16 (&o)[2], float fq_, const Ctx& C) {
    LAS float* wsc = (LAS float*)(C.lds + WSCR_OFF + C.wave * 256);
    wsc[C.q] = fq_; LDS_WAIT();
#pragma unroll
    for (int r = 0; r < 16; ++r) { const float f = wsc[crow(r, C.hi)]; o[0][r] *= f; o[1][r] *= f; }
    LDS_WAIT();
}
template <bool FIRST> __device__ __forceinline__ void row_fma(const f32x16 (&o)[2], float fq_, const Ctx& C) {
    LAS float* wsc = (LAS float*)(C.lds + WSCR_OFF + C.wave * 256);
    LAS float* otl = (LAS float*)(C.lds + OT_OFF + C.wave * OT_WAVE) + C.q;
    wsc[C.q] = fq_; LDS_WAIT();
#pragma unroll
    for (int r = 0; r < 16; ++r) { const int row = crow(r, C.hi); const float f = wsc[row];
        if (FIRST) { otl[row * OT_STR] = o[0][r] * f; otl[row * OT_STR + 32] = o[1][r] * f; }
        else { otl[row * OT_STR] += o[0][r] * f; otl[row * OT_STR + 32] += o[1][r] * f; } }
    LDS_WAIT();
}

template <int MODE>
__device__ __forceinline__ void branch(const Ctx& C, const Src& S, int jlo, int jhi, const f32x16& negm, const float m, float& l, f32x16 (&o)[2], float inv_l, unsigned sel_lo, unsigned sel_hi) {
    TileRegs R; load_tile(R, S, 64 * jlo, C.tid);
    const float far_bias = ((const LAS float*)(C.lds + BIAS_OFF))[C.head * 128 + 127];
    store_tile(R, C.lds, 0, C.tid);
    __syncthreads();
    if (jlo + 1 <= jhi) load_tile(R, S, 64 * (jlo + 1), C.tid);
#pragma unroll 1
    for (int j = jlo; j <= jhi; ++j) {
        const int buf = (j - jlo) & 1;
        f32x16 p0, p1;
        const bool cfar = (MODE == CMP_A || MODE == CMP_B) && (1024 * j + 1167 <= 64 * C.i);
        if (MODE == CMP_A) {
            f32x16 cin;
#pragma unroll
            for (int r = 0; r < 16; ++r) cin[r] = cfar ? far_bias - m : -m;
            qk_tile(p0, p1, cin, C, buf);
            if (!cfar) mask_bias<MODE>(p0, p1, C, 64 * j, true);
            float s = 0.f;
#pragma unroll
            for (int r = 0; r < 16; ++r) s += fexp2(p0[r]) + fexp2(p1[r]);
            l += s;
        } else if (MODE == CMP_B) {
            f32x16 cin;
#pragma unroll
            for (int r = 0; r < 16; ++r) cin[r] = cfar ? far_bias - m : -m;
            qk_tile(p0, p1, cin, C, buf);
            bf16x8 vf[8]; v_load(vf, C, buf);
            if (!cfar) mask_bias<MODE>(p0, p1, C, 64 * j, true);
#pragma unroll
            for (int r = 0; r < 16; ++r) { p0[r] = fexp2(p0[r]) * inv_l; p1[r] = fexp2(p1[r]) * inv_l; }
            LAS float* imp = (LAS float*)(C.lds + IMP_OFF) + C.tl * 65;
#pragma unroll
            for (int T = 0; T < 2; ++T)
#pragma unroll
                for (int c = 0; c < 4; ++c) {
                    const float e0 = T ? p1[4 * c] : p0[4 * c], e1 = T ? p1[4 * c + 1] : p0[4 * c + 1], e2 = T ? p1[4 * c + 2] : p0[4 * c + 2], e3 = T ? p1[4 * c + 3] : p0[4 * c + 3];
                    float mainv = (e0 + e1) + (e2 + 0.5f * e3), carry = 0.5f * e3;
                    mainv = quad_sum(mainv); carry = quad_sum(carry);
                    const int sb = 16 * j + 8 * T + 2 * c + C.hi;
                    if (C.head == 0) { (void)__hip_atomic_fetch_add(imp + sb, mainv, __ATOMIC_RELAXED, __HIP_MEMORY_SCOPE_WORKGROUP); if (sb + 1 < 64) (void)__hip_atomic_fetch_add(imp + sb + 1, carry, __ATOMIC_RELAXED, __HIP_MEMORY_SCOPE_WORKGROUP); }
                }
            pv_mma(o, p0, p1, vf);
        } else {
            const int delta = C.i - j;
            const bool sel = (MODE == SLC) ? (((j < 32 ? (sel_lo >> j) : (sel_hi >> (j - 32))) & 1u) != 0u) : true;
            if (MODE != SLC || __any(sel)) {
                const bool near = delta <= 2 || (MODE == WIN && delta >= 8);
                if (near) {
                    const float c = sel ? -m : NEG;
                    f32x16 cin;
#pragma unroll
                    for (int r = 0; r < 16; ++r) cin[r] = c;
                    qk_tile(p0, p1, cin, C, buf);
                    mask_bias2(p0, p1, C, 64 * j);
                } else if (MODE == SLC && !__all(sel)) {
                    f32x16 cin;
#pragma unroll
                    for (int r = 0; r < 16; ++r) cin[r] = sel ? negm[r] : NEG;
                    qk_tile(p0, p1, cin, C, buf);
                } else qk_tile(p0, p1, negm, C, buf);
                bf16x8 vf[8]; v_load(vf, C, buf);
                __builtin_amdgcn_sched_barrier(0);
                float s = 0.f;
#pragma unroll
                for (int r = 0; r < 16; ++r) { p0[r] = fexp2(p0[r]); p1[r] = fexp2(p1[r]); s += p0[r] + p1[r]; }
                l += s;
                pv_mma(o, p0, p1, vf);
            }
        }
        if (j < jhi) store_tile(R, C.lds, buf ^ 1, C.tid);
        __syncthreads();
        if (j + 2 <= jhi) load_tile(R, S, 64 * (j + 2), C.tid);
    }
}

__device__ __forceinline__ void attn_unit(Frame& F, int b, int g, int i, bool tables) {
    unsigned char* ws = F.ws;
    const bf16_t* proj = (const bf16_t*)(ws + WS_PROJ);
    int tid_ = threadIdx.x; asm volatile("" : "+v"(tid_));
    Ctx C; C.lds = F.lds; C.tid = tid_; C.lane = tid_ & 63; C.wave = F.wave; C.q = C.lane & 31; C.hi = C.lane >> 5; C.tl = 8 * F.wave + (C.q >> 2); C.head = C.q & 3; C.i = i; C.t = 64 * i + C.tl;
    const size_t row = (size_t)b * SEQ + C.t;
    const int hq = g * 4 + C.head;
#pragma unroll
    for (int d0 = 0; d0 < 4; ++d0) C.qr[d0] = *(const bf16x8*)(proj + row * NPROJ + COL_Q + hq * 64 + 16 * d0 + 8 * C.hi);
    float gate[3];
#pragma unroll
    for (int j = 0; j < 3; ++j) gate[j] = sigmoidf_(bf2f(proj[row * NPROJ + COL_GL + hq * 3 + j]));
    for (int idx = C.tid; idx < 64 * 65; idx += 512) ((LAS float*)(C.lds + IMP_OFF))[idx] = 0.f;
    if (tables) {
        ((LAS float*)(C.lds + BIAS_OFF))[C.tid] = ((const float*)(ws + WS_BTAB))[(g * 4 + (C.tid >> 7)) * 128 + (C.tid & 127)];
        for (int idx = C.tid; idx < 4 * TAB2_N; idx += 512) { const int h = idx / TAB2_N, d = idx % TAB2_N - 63;
            ((LAS float*)(C.lds + TAB2_OFF))[idx] = (d < 0 || d >= 512) ? NEG : ((const float*)(ws + WS_BTAB))[(g * 4 + h) * 128 + (d > 127 ? 127 : d)]; }
        {
            LAS float* bm = (LAS float*)(C.lds + BMAX_OFF);
            if (C.wave < 4) { const float* bt = (const float*)(ws + WS_BTAB) + (g * 4 + C.wave) * 128; float x = fmaxf(bt[C.lane], bt[64 + C.lane]);
#pragma unroll
                for (int o_ = 1; o_ < 64; o_ <<= 1) x = fmaxf(x, __shfl_xor(x, o_));
                if (C.lane == 0) bm[C.wave] = x; }
            const u32x4* kp = (const u32x4*)((const bf16_t*)(ws + WS_KCMP) + (size_t)((b * 4 + g) * 256 + (C.tid >> 1)) * 64 + (C.tid & 1) * 32);
            float ss = 0.f;
#pragma unroll
            for (int k = 0; k < 4; ++k) { const u32x4 w = kp[k]; const unsigned ww[4] = {w.x, w.y, w.z, w.w};
#pragma unroll
                for (int e = 0; e < 4; ++e) { const float a = bflo(ww[e]), b2 = bfhi(ww[e]); ss += a * a + b2 * b2; } }
            ss += __shfl_xor(ss, 1);
#pragma unroll
            for (int o_ = 2; o_ < 64; o_ <<= 1) ss = fmaxf(ss, __shfl_xor(ss, o_));
            if (C.lane == 0) bm[4 + C.wave] = ss;
        }
    }
    __syncthreads();
    const float far_bias = ((const LAS float*)(C.lds + BIAS_OFF))[C.head * 128 + 127];
    const int bg = b * 4 + g;
    float qn, bmax, kc2;
    {
        float ss = 0.f;
#pragma unroll
        for (int d0 = 0; d0 < 4; ++d0) { const u32x4 w = __builtin_bit_cast(u32x4, C.qr[d0]); const unsigned ww[4] = {w.x, w.y, w.z, w.w};
#pragma unroll
            for (int e = 0; e < 4; ++e) { const float a = bflo(ww[e]), b2 = bfhi(ww[e]); ss += a * a + b2 * b2; } }
        qn = sqrtf(pair_sum(ss));
        const LAS float* bm = (const LAS float*)(C.lds + BMAX_OFF);
        bmax = bm[C.head];
        kc2 = fmaxf(fmaxf(fmaxf(bm[4], bm[5]), fmaxf(bm[6], bm[7])), fmaxf(fmaxf(bm[8], bm[9]), fmaxf(bm[10], bm[11])));
    }
    const unsigned* kmx = (const unsigned*)(ws + CTL_KMAX);
    const float m_c = qn * sqrtf(kc2) + bmax, m_s = qn * sqrtf(__builtin_bit_cast(float, kmx[bg])) + bmax, m_w = qn * sqrtf(__builtin_bit_cast(float, kmx[16 + bg])) + bmax;
    f32x16 o[2], negm;
    float l;
    {
        const Src S{(const bf16_t*)(ws + WS_KCMP) + (size_t)(bg * 256) * 64, 64, (const bf16_t*)(ws + WS_VCT) + (size_t)(bg * 64) * 256, 256};
        const int nkt = (4 * i + 2) / 64 + 1;
        l = 0.f; o[0] = f32x16{}; o[1] = f32x16{}; negm = f32x16{};
        branch<CMP_A>(C, S, 0, nkt - 1, negm, m_c, l, o, 0.f, 0u, 0u);
        const float lt = pair_sum(l), inv = lt > 0.f ? 1.f / lt : 0.f;
        branch<CMP_B>(C, S, 0, nkt - 1, negm, m_c, l, o, inv, 0u, 0u);
        row_fma<true>(o, gate[0], C);
    }
    {
        LDS_WAIT();
        LAS unsigned char* selb = C.lds + SEL_OFF;
        if (i >= 16) {
            const int tk = C.lane >> 3, cg = C.lane & 7;
            LAS unsigned* rowb = (LAS unsigned*)(C.lds + IMP_OFF) + (8 * C.wave + tk) * 65;
            unsigned long long kc[8]; unsigned cnt[8];
#pragma unroll
            for (int c = 0; c < 8; ++c) { const int s = cg * 8 + c; unsigned xb = rowb[s];
                xb = (s == 0 || s == i || s == i - 1) ? 0x461c4000u   : xb;
                rowb[s] = xb; kc[c] = ((unsigned long long)xb << 6) | (unsigned)(63 - s); cnt[c] = 0u; }
            LDS_WAIT();
            for (int s2 = 0; s2 <= i; ++s2) {
                const unsigned long long k2 = ((unsigned long long)rowb[s2] << 6) | (unsigned)(63 - s2);
#pragma unroll
                for (int c = 0; c < 8; ++c) cnt[c] += (k2 > kc[c]) ? 1u : 0u;
            }
            unsigned bits = 0;
#pragma unroll
            for (int c = 0; c < 8; ++c) { const int s = cg * 8 + c; if (cnt[c] < 16u && s <= i) bits |= 1u << c; }
            selb[(8 * C.wave + tk) * 8 + cg] = (unsigned char)bits;
        } else {
            if (C.lane < 8) { const unsigned long long mk = (2ull << i) - 1ull; *(LAS unsigned long long*)(selb + (8 * C.wave + C.lane) * 8) = mk; }
        }
        LDS_WAIT();
    }
    const u32x2 selw = *(const LAS u32x2*)(C.lds + SEL_OFF + C.tl * 8);
    {
        const Src S{proj + (size_t)b * SEQ * NPROJ + COL_KS + g * 64, NPROJ, (const bf16_t*)(ws + WS_VST) + (size_t)(bg * 64) * SEQ, SEQ};
        l = 0.f; o[0] = f32x16{}; o[1] = f32x16{};
#pragma unroll
        for (int r = 0; r < 16; ++r) negm[r] = far_bias - m_s;
        branch<SLC>(C, S, 0, i, negm, m_s, l, o, 0.f, selw.x, selw.y);
        const float lt = pair_sum(l);
        row_fma<false>(o, gate[1] / lt, C);
    }
    {
        const Src S{proj + (size_t)b * SEQ * NPROJ + COL_KW + g * 64, NPROJ, (const bf16_t*)(ws + WS_VWT) + (size_t)(bg * 64) * SEQ, SEQ};
        l = 0.f; o[0] = f32x16{}; o[1] = f32x16{};
#pragma unroll
        for (int r = 0; r < 16; ++r) negm[r] = far_bias - m_w;
        branch<WIN>(C, S, i >= 8 ? i - 8 : 0, i, negm, m_w, l, o, 0.f, 0u, 0u);
        const float lt = pair_sum(l);
        row_fma<false>(o, gate[2] / lt, C);
    }
    {
        bf16_t* mix = (bf16_t*)(ws + WS_MIX);
        const LAS float* otw = (const LAS float*)(C.lds + OT_OFF + C.wave * OT_WAVE);
#pragma unroll
        for (int k = 0; k < 4; ++k) { const int rowq = 8 * k + (C.lane >> 3), ch = C.lane & 7;
            const f32x4 a = *(const LAS f32x4*)(otw + rowq * OT_STR + ch * 8), c4 = *(const LAS f32x4*)(otw + rowq * OT_STR + ch * 8 + 4);
            u32x4 w; w.x = pk2(a[0], a[1]); w.y = pk2(a[2], a[3]); w.z = pk2(c4[0], c4[1]); w.w = pk2(c4[2], c4[3]);
            const size_t orow = (size_t)b * SEQ + 64 * i + 8 * C.wave + (rowq >> 2);
            *(u32x4*)(mix + orow * DM + 1024 + (g * 4 + (rowq & 3)) * 64 + ch * 8) = w; }
    }
    __syncthreads();
}
__device__ __forceinline__ void attn_phase(Frame& F) {
    for (int v = F.vcu; v < 256; v += F.G) {
        const int bg = v >> 4, s = v & 15;
#pragma unroll 1
        for (int k = 0; k < 4; ++k) { const int i = (k == 0) ? 63 - s : (k == 1) ? 32 + s : (k == 2) ? 31 - s : s; attn_unit(F, bg >> 2, bg & 3, i, k == 0); }
    }
}
}

__device__ __forceinline__ void final_norm_phase(Frame& F) {
    const int gw = F.vcu * NWAVES + F.wave, NGW = F.G * NWAVES, lane = F.lane;
    const float* ss = (const float*)(F.ws + CTL_SS2); const f32x4* nw = (const f32x4*)F.a->in[I_NFW] + 2 * lane;
    for (int mrow = gw; mrow < MTOK; mrow += NGW) {
        const float rs = __builtin_amdgcn_rsqf(ss[mrow] * (1.f / DM) + EPS);
        const u32x4* xr = (const u32x4*)((const bf16_t*)(F.ws + WS_MIX) + (size_t)mrow * DM) + lane;
        f32x4* orow = (f32x4*)(F.out + (size_t)mrow * DM) + 2 * lane;
#pragma unroll
        for (int j = 0; j < 4; ++j) { const u32x4 b = xr[64 * j]; const f32x4 w0 = nw[128 * j], w1 = nw[128 * j + 1];
            orow[128 * j] = (f32x4){bflo(b.x), bfhi(b.x), bflo(b.y), bfhi(b.y)} * rs * w0; orow[128 * j + 1] = (f32x4){bflo(b.z), bfhi(b.z), bflo(b.w), bfhi(b.w)} * rs * w1; }
    }
}

constexpr int N_PHASES = 9;
__global__ void __launch_bounds__(NWAVES * 64, 2) hymba_fwd(Args args) {
    extern __shared__ __attribute__((aligned(16))) unsigned char lds_raw[];
    Frame F;
    F.lds = (LAS unsigned char*)lds_raw;
    F.tid = threadIdx.x; F.lane = F.tid & 63; F.wave = __builtin_amdgcn_readfirstlane(F.tid >> 6);
    F.G = gridDim.x; { const int bx = blockIdx.x; F.vcu = (F.G % 8 == 0) ? (bx % 8) * (F.G / 8) + bx / 8 : bx; }
    F.a = &args; F.out = args.out; F.ws = args.ws;
    unsigned char* ws = args.ws;
    volatile LAS unsigned* MISC = (volatile LAS unsigned*)(F.lds + MISC_OFF);
    if (F.tid < 32) MISC[F.tid] = 0u;
    __syncthreads();
    XcdBarrier bar; bar.bar = (unsigned*)(ws + WS_CTL) + CW_BAR; bar.x = 0; bar.st = nullptr;
    const int lo = args.ph_lo, hi = args.ph_hi;
    const bool multi = (hi - lo) > 1;
    if (multi) bar = xcd_barrier_post((unsigned*)(ws + WS_CTL) + CW_BAR, MISC + 8);
#ifndef REPEAT_PHASE
#define REPEAT_PHASE -1
#endif
#define REP(k) for (int rep_ = 0; rep_ < ((REPEAT_PHASE == (k)) ? 2 : 1); ++rep_)
#ifndef ONLY_PHASE
#define ONLY_PHASE -1
#endif
#define IN(k) ((ONLY_PHASE < 0 || ONLY_PHASE == (k)) && lo <= (k) && (k) < hi)
#define SEAM(k) do { if (IN(k) && IN((k) + 1)) xcd_barrier(bar); } while (0)
    const int cblk = (int)blockIdx.x;

    if (IN(0)) { REP(0) { p0_prologue(F); } SEAM(0); }
    if (IN(1)) {
        pg8::Gemm g{(const bf16_t*)(ws + WS_XB), (const bf16_t*)(ws + WS_WIN), MTOK, NPROJ, DM, DM, 128, 0};
        pg8::StaticOrder S; S.init(MTOK, NPROJ, F.G, cblk);
        pg8::EpiProj E{(bf16_t*)(ws + WS_PROJ), (const float*)(ws + WS_R1), (bf16_t*)(ws + WS_VST), (bf16_t*)(ws + WS_VWT)};
        REP(1) { pg8::gemm_phase<pg8::EpiProj, pg8::StaticOrder, true>(F.lds, g, S, E); }
        cmp_bias_reduce(F);
        SEAM(1);
    }
    if (IN(2)) { REP(2) {
        {
            pg8::Gemm g{(const bf16_t*)(ws + WS_PROJ) + COL_KC, (const bf16_t*)(ws + WS_WC1K), 4096, 256, 2048, 16 * NPROJ, NPROJ * 2, 1};
            pg8::StaticOrder S; S.init(4096, 256, F.G, cblk);
            pg8::EpiCmp E{(bf16_t*)(ws + WS_HC), (const float*)(ws + WS_CBF)};
            pg8::gemm_phase<pg8::EpiCmp, pg8::StaticOrder, true>(F.lds, g, S, E);
        }
        {
            pg8::Gemm g{(const bf16_t*)(ws + WS_PROJ) + COL_VC, (const bf16_t*)(ws + WS_WC1V), 4096, 256, 2048, 16 * NPROJ, NPROJ * 2, 1};
            pg8::StaticOrder S; S.init(4096, 256, F.G, (cblk + F.G - 16) % F.G);
            pg8::EpiCmp E{(bf16_t*)(ws + WS_HC) + (size_t)4096 * 256, (const float*)(ws + WS_CBF) + 256};
            pg8::gemm_phase<pg8::EpiCmp, pg8::StaticOrder, true>(F.lds, g, S, E);
        }
        __syncthreads();
        s5_phase<false>(F);
        late_transposes(F, 0);
        __syncthreads(); }
        SEAM(2);
    }
    if (IN(3)) { REP(3) { if (REPEAT_PHASE != 31) s5_phase<true>(F); if (REPEAT_PHASE != 32) cmp2_phase(F); knorm_phase(F); late_transposes(F, 1); __syncthreads(); } SEAM(3); }
    if (IN(4)) {
        __syncthreads();
        pg8::Gemm g{(const bf16_t*)(ws + WS_Z), (const bf16_t*)(ws + WS_WGLU), MTOK, 1024, 1024, 1024, 128, 0};
        pg8::StaticOrder S; S.init(MTOK, 1024, F.G, cblk);
        pg8::EpiGlu E{(bf16_t*)(ws + WS_MIX), (const bf16_t*)(ws + WS_Z), F.a->in[I_BGLU]};
        for (int rep_ = 0; rep_ < ((REPEAT_PHASE == 40) ? 2 : 1); ++rep_) pg8::gemm_phase<pg8::EpiGlu, pg8::StaticOrder, true>(F.lds, g, S, E);
        __syncthreads();
        REP(4) { att::attn_phase(F); __syncthreads(); }
        SEAM(4);
    }
    if (IN(5)) {
        __syncthreads();
        pg8::Gemm g{(const bf16_t*)(ws + WS_MIX), (const bf16_t*)(ws + WS_WOUT), MTOK, DM, DM, DM, 128, 0};
        pg8::StaticOrder S; S.init(MTOK, DM, F.G, cblk);
        pg8::EpiRes<false> E{F.a->in[I_X], (bf16_t*)(ws + WS_X1B), (float*)(ws + CTL_SS1)};
        pg8::gemm_phase<pg8::EpiRes<false>, pg8::StaticOrder, true>(F.lds, g, S, E);
        SEAM(5);
    }
    if (IN(6)) {
        pg8::Gemm g{(const bf16_t*)(ws + WS_X1B), (const bf16_t*)(ws + WS_WUP), MTOK, DFF, DM, DM, 128, 0};
        pg8::StaticOrder S; S.init(MTOK, DFF, F.G, cblk);
        pg8::EpiUp E{(bf16_t*)(ws + WS_HID), (const float*)(ws + CTL_SS1)};
        REP(6) { pg8::gemm_phase<pg8::EpiUp, pg8::StaticOrder, true>(F.lds, g, S, E); }
        SEAM(6);
    }
    if (IN(7)) {
        pg8::Gemm g{(const bf16_t*)(ws + WS_HID), (const bf16_t*)(ws + WS_WDOWN), MTOK, DM, DFF, DFF, 128, 0};
        pg8::StaticOrder S; S.init(MTOK, DM, F.G, cblk);
        pg8::EpiRes<true> E{(const bf16_t*)(ws + WS_X1B), (bf16_t*)(ws + WS_MIX), (float*)(ws + CTL_SS2)};
        pg8::gemm_phase<pg8::EpiRes<true>, pg8::StaticOrder, true>(F.lds, g, S, E);
        SEAM(7);
    }
    if (IN(8)) final_norm_phase(F);
#undef IN
#undef SEAM
}

extern "C" void kernel_launch(void* const* d_in, const int* in_sizes, int n_in, void* d_out, int out_size, void* d_ws, size_t ws_size, hipStream_t stream) {
    static int grid = 0;
    if (grid == 0) {
        if (n_in != 25 || in_sizes[0] != MTOK * DM || out_size != MTOK * DM || ws_size < WS_END) {
            fprintf(stderr, "kernel_launch: unexpected shapes (n_in %d, in0 %d, out %d, ws %zu < %zu); nothing launched\n", n_in, n_in > 0 ? in_sizes[0] : -1, out_size, ws_size, (size_t)WS_END); grid = -1; return; }
        int dev = 0, cus = 0, per_cu = 0;
        if (hipGetDevice(&dev) != hipSuccess || hipDeviceGetAttribute(&cus, hipDeviceAttributeMultiprocessorCount, dev) != hipSuccess) { grid = -1; return; }
        if (hipFuncSetAttribute((const void*)hymba_fwd, hipFuncAttributeMaxDynamicSharedMemorySize, LDS_BYTES) != hipSuccess) { fprintf(stderr, "kernel_launch: hipFuncSetAttribute failed\n"); grid = -1; return; }
        if (hipOccupancyMaxActiveBlocksPerMultiprocessor(&per_cu, (const void*)hymba_fwd, NWAVES * 64, LDS_BYTES) != hipSuccess || per_cu < 1) { fprintf(stderr, "kernel_launch: occupancy query says %d blocks per CU\n", per_cu); per_cu = 1; }
        (void)hipGetLastError();
        grid = cus;
    }
    if (grid < 0) return;
    if (MK_N_LAUNCHES == 1) { if (hipMemsetAsync((char*)d_ws + WS_CTL, 0, CTL_ZERO_BYTES, stream) != hipSuccess) return; }
    Args a{};
    for (int i = 0; i < 25; ++i) a.in[i] = (const float*)d_in[i];
    a.out = (float*)d_out; a.ws = (unsigned char*)d_ws;
    if (MK_N_LAUNCHES == 1) {
        a.ph_lo = 0; a.ph_hi = N_PHASES;
        void* kargs[] = {&a};
        hipError_t e = hipLaunchCooperativeKernel((const void*)hymba_fwd, dim3(grid), dim3(NWAVES * 64), kargs, LDS_BYTES, stream);
        if (e != hipSuccess) fprintf(stderr, "kernel_launch: cooperative launch failed: %s (grid %d)\n", hipGetErrorString(e), grid);
    } else {
        for (int p = 0; p < N_PHASES; ++p) { a.ph_lo = p; a.ph_hi = p + 1; hipLaunchKernelGGL(hymba_fwd, dim3(grid), dim3(NWAVES * 64), LDS_BYTES, stream, a); }
    }
}
```

```cpp
#include <hip/hip_runtime.h>
#include <cstdio>
#include <cstdint>

#ifndef MK_N_LAUNCHES
#define MK_N_LAUNCHES 1
#endif

#define LAS __attribute__((address_space(3)))
#define GAS __attribute__((address_space(1)))
typedef unsigned short bf16_t;
typedef short bf16x8 __attribute__((ext_vector_type(8)));
typedef float f32x2 __attribute__((ext_vector_type(2)));
typedef float f32x4 __attribute__((ext_vector_type(4)));
typedef float f32x16 __attribute__((ext_vector_type(16)));
typedef unsigned u32x2 __attribute__((ext_vector_type(2)));
typedef unsigned u32x4 __attribute__((ext_vector_type(4)));
typedef __bf16 bf16x2_t __attribute__((ext_vector_type(2)));

#define LDS_WAIT() asm volatile("s_waitcnt lgkmcnt(0)" ::: "memory")
#define VM_WAIT() asm volatile("s_waitcnt vmcnt(0)" ::: "memory")

constexpr int BATCH = 4, SEQ = 4096, DM = 2048, MTOK = BATCH * SEQ, DFF = 8192;
constexpr int D_IN = 3632, NPROJ = 3840;
constexpr int COL_U = 0, COL_Q = 1024, COL_KC = 2048, COL_VC = 2304, COL_KS = 2560, COL_VS = 2816, COL_KW = 3072, COL_VW = 3328, COL_GL = 3584;
constexpr float EPS = 1e-6f;
constexpr float LOG2E = 1.4426950408889634f;
constexpr float C2 = 0.125f * LOG2E;
constexpr int NWAVES = 8;

constexpr size_t MiB = 1u << 20;
constexpr size_t WS_CTL = 0, CTL_ZERO_BYTES = 1 * MiB;
constexpr int CW_BAR = 4096;
constexpr size_t CTL_KMAX = 96 * 1024;
constexpr size_t CTL_SS1 = 256 * 1024, CTL_SS2 = 512 * 1024, CTL_CB = 768 * 1024;
constexpr size_t WS_R1 = 1 * MiB, WS_BTAB = 1 * MiB + 64 * 1024, WS_S5AB = 1 * MiB + 128 * 1024, WS_CBP = 1 * MiB + 256 * 1024  , WS_CBF = 1 * MiB + 384 * 1024  ;
constexpr size_t WS_BRE = 2 * MiB, WS_BIM = 2 * MiB + 128 * 1024, WS_CM = 2 * MiB + 256 * 1024;
constexpr size_t WS_SEG = 3 * MiB;
constexpr size_t WS_WIN = 4 * MiB, WS_WGLU = 19 * MiB, WS_WOUT = 21 * MiB, WS_WUP = 29 * MiB, WS_WDOWN = 61 * MiB, WS_WC1K = 93 * MiB, WS_WC1V = 94 * MiB,
                 WS_WC2K = 95 * MiB, WS_WC2V = 95 * MiB + 64 * 1024;
constexpr size_t WS_X1B = 100 * MiB, WS_MIX = 164 * MiB, WS_HID = 228 * MiB;
constexpr size_t WS_XB = 228 * MiB, WS_PROJ = 292 * MiB, WS_Z = 412 * MiB, WS_HC = 444 * MiB, WS_KCMP = 448 * MiB, WS_VCMP = 448 * MiB + 512 * 1024;
constexpr size_t WS_VST = 450 * MiB, WS_VWT = 458 * MiB, WS_VCT = 466 * MiB;
constexpr size_t WS_END = 484 * MiB;

constexpr int LDS_BYTES = 147456;
constexpr int MISC_OFF = 135168 + 4096;

__device__ __forceinline__ unsigned f2bf(float f) { unsigned u = __builtin_bit_cast(unsigned, f); return (u + 0x7fffu + ((u >> 16) & 1u)) >> 16; }
__device__ __forceinline__ unsigned pk2(float lo, float hi) { f32x2 v = {lo, hi}; bf16x2_t b = __builtin_convertvector(v, bf16x2_t); return __builtin_bit_cast(unsigned, b); }
__device__ __forceinline__ float bf2f(unsigned b) { return __builtin_bit_cast(float, b << 16); }
__device__ __forceinline__ float bflo(unsigned w) { return __builtin_bit_cast(float, w << 16); }
__device__ __forceinline__ float bfhi(unsigned w) { return __builtin_bit_cast(float, w & 0xffff0000u); }
__device__ __forceinline__ float fexp2(float x) { return __builtin_amdgcn_exp2f(x); }
__device__ __forceinline__ float frcp(float x) { return __builtin_amdgcn_rcpf(x); }
__device__ __forceinline__ float sigmoidf_(float x) { return frcp(1.f + fexp2(-x * LOG2E)); }
__device__ __forceinline__ float gelu_tanh(float x) {
    const float u = 0.7978845608028654f * (x + 0.044715f * x * x * x);
    return x * frcp(1.f + fexp2(-2.f * LOG2E * u));
}
__device__ __forceinline__ int crow(int r, int hi) { return (r & 3) + 8 * (r >> 2) + 4 * hi; }
__device__ __forceinline__ float wave_sum(float v) {
#pragma unroll
    for (int o = 1; o < 64; o <<= 1) v += __shfl_xor(v, o);
    return v;
}
__device__ __forceinline__ float pair_max(float v) {
    unsigned a = __builtin_bit_cast(unsigned, v), b = a; asm volatile("" : "+v"(b));
    auto rr = __builtin_amdgcn_permlane32_swap(a, b, false, false);
    unsigned r0 = rr[0], r1 = rr[1]; asm volatile("" : "+v"(r0), "+v"(r1));
    return fmaxf(__builtin_bit_cast(float, r0), __builtin_bit_cast(float, r1));
}
__device__ __forceinline__ float pair_sum(float v) {
    unsigned a = __builtin_bit_cast(unsigned, v), b = a; asm volatile("" : "+v"(b));
    auto rr = __builtin_amdgcn_permlane32_swap(a, b, false, false);
    unsigned r0 = rr[0], r1 = rr[1]; asm volatile("" : "+v"(r0), "+v"(r1));
    return __builtin_bit_cast(float, r0) + __builtin_bit_cast(float, r1);
}

__device__ const unsigned char T5B[128] = {0, 1, 2, 3, 4, 5, 6, 7, 8, 9, 10, 11, 12, 13, 14, 15, 16, 16, 16, 17, 17, 18, 18, 18, 19, 19, 19, 20, 20, 20, 20, 21, 21, 21, 21, 22, 22, 22, 22, 22, 23, 23, 23, 23, 23, 23,
    24, 24, 24, 24, 24, 24, 25, 25, 25, 25, 25, 25, 25, 26, 26, 26, 26, 26, 26, 26, 26, 27, 27, 27, 27, 27, 27, 27, 27, 27, 27, 28, 28, 28, 28, 28, 28, 28, 28, 28, 28, 29, 29, 29, 29, 29, 29, 29, 29, 29, 29, 29, 29,
    30, 30, 30, 30, 30, 30, 30, 30, 30, 30, 30, 30, 30, 30, 31, 31, 31, 31, 31, 31, 31, 31, 31, 31, 31, 31, 31, 31, 31};

namespace pg8 {
constexpr int BM = 256, BK = 64, HALF = 128, HTB = HALF * BK * 2, STAGE_BYTES = 8 * HTB, NXCD = 8, WGM = 8;
__host__ __device__ __forceinline__ int lds_byte(int r, int c) { const int st = (r >> 4) * 2 + (c >> 5), rr = r & 15, cc = c & 31, ob = rr * 64 + cc * 2; return st * 1024 + (ob ^ (((ob >> 9) & 1) << 5)); }
__host__ __device__ __forceinline__ void stage_rc(int b, int& R, int& C) { const int st = b / 1024, sb = b % 1024, swz = sb ^ (((sb >> 9) & 1) << 5); R = (st >> 1) * 16 + swz / 64; C = (st & 1) * 32 + (swz % 64) / 2; }
__host__ __device__ __forceinline__ int perm32(int rho) { const int n = rho >> 4, i = rho & 15; return 8 * (i >> 2) + 4 * n + (i & 3); }

struct Unit { int pm, pn; };
struct Gemm { const bf16_t* A; const bf16_t* Bt; int M, N, K; int lda; int a_kstep; int amode; };
__device__ __forceinline__ const char* a_base(const Gemm& g, int pm) {
    if (g.amode == 0) return (const char*)g.A + (size_t)pm * (size_t)BM * (size_t)g.lda * 2;
    return (const char*)g.A + ((size_t)(pm >> 2) * SEQ * NPROJ + (size_t)(pm & 3) * 64) * 2;
}

struct StaticOrder {
    int nM, nN, nwg, G, c;
    __host__ __device__ void init(int M, int N, int G_, int c_) { nM = M / BM; nN = N / BM; nwg = nM * nN; G = G_; c = c_; }
    __host__ __device__ bool next(int i, Unit& u) const {
        const long L = (long)i * G + c; if (L >= nwg) return false;
        int wgid = (int)L; { const int q = nwg / NXCD, r = nwg % NXCD, xcd = wgid % NXCD, off = wgid / NXCD; wgid = (xcd < r ? xcd * (q + 1) : r * (q + 1) + (xcd - r) * q) + off; }
        const int nig = WGM * nN, gid = wgid / nig, fm = gid * WGM, gsz = (nM - fm) < WGM ? (nM - fm) : WGM;
        u.pm = fm + ((wgid % nig) % gsz); u.pn = (wgid % nig) / gsz; return true;
    }
};

typedef f32x4 Acc[2][2][4][2];

template <class Epi, class Sched, bool ALIGN_EPI = true>
__device__ __forceinline__ void gemm_phase(LAS unsigned char* lds, const Gemm g, const Sched& S, const Epi& E) {
    const int tid = threadIdx.x, wid = __builtin_amdgcn_readfirstlane(tid >> 6), lane = tid & 63, wr = wid >> 2, wc = wid & 3, fr = lane & 15, fq = lane >> 4;
    const int K = g.K, nt = K / BK;
    unsigned voffA[2], voffB[2];
#pragma unroll
    for (int i = 0; i < 2; ++i) { int R, C; stage_rc(tid * 16 + i * 8192, R, C); const int Rb = (R & ~31) + perm32(R & 31);
        voffA[i] = (unsigned)(R * g.lda + C) * 2u; voffB[i] = (unsigned)(Rb * K + C) * 2u; }
    const size_t kstepA = (size_t)g.a_kstep, kstepB = (size_t)(BK * 2);
    const size_t hstepA = (size_t)HALF * g.lda * 2, hstepB = (size_t)HALF * K * 2;
    const size_t tstepB = 2 * hstepB;
    const unsigned ldsw = (unsigned)wid * 1024u;
    const int aoff = lds_byte(wr * 64 + fr, fq * 8), boff = lds_byte(wc * 32 + fr, fq * 8);
#define PG8_SA(b, h) (((b) * 2 + (h)) * HTB)
#define PG8_SB(b, h) ((4 + (b) * 2 + (h)) * HTB)
#define PG8_STAGE(bufoff, gbase, voff) do { _Pragma("unroll") for (int _i = 0; _i < 2; ++_i) \
        __builtin_amdgcn_global_load_lds((const unsigned*)((const char*)(gbase) + (voff)[_i]), (LAS unsigned*)(lds + (bufoff) + ldsw + _i * 8192), 16, 0, 0); } while (0)
#define PG8_LDA(dst, b, h) do { _Pragma("unroll") for (int m = 0; m < 4; ++m) _Pragma("unroll") for (int k = 0; k < 2; ++k) dst[m][k] = *(const LAS bf16x8*)(lds + PG8_SA(b, h) + aoff + m * 2048 + k * 1024); } while (0)
#define PG8_LDB(dst, b, h) do { _Pragma("unroll") for (int n = 0; n < 2; ++n) _Pragma("unroll") for (int k = 0; k < 2; ++k) dst[n][k] = *(const LAS bf16x8*)(lds + PG8_SB(b, h) + boff + n * 2048 + k * 1024); } while (0)
#define PG8_MMA(ai, bj, At, Bt) do { __builtin_amdgcn_s_setprio(1); _Pragma("unroll") for (int m = 0; m < 4; ++m) _Pragma("unroll") for (int n = 0; n < 2; ++n) _Pragma("unroll") for (int k = 0; k < 2; ++k) \
        acc[ai][bj][m][n] = __builtin_amdgcn_mfma_f32_16x16x32_bf16(Bt[n][k], At[m][k], acc[ai][bj][m][n], 0, 0, 0); __builtin_amdgcn_s_setprio(0); } while (0)
#define PG8_WAIT_V(n) asm volatile("s_waitcnt vmcnt(" #n ")" ::: "memory")
#define PG8_WAIT_L(n) asm volatile("s_waitcnt lgkmcnt(" #n ")" ::: "memory")
#define PG8_BAR __builtin_amdgcn_s_barrier()
#define PG8_SCHED __builtin_amdgcn_sched_barrier(0)
    Unit cur, nxt; int ui = 0;
    if (!S.next(0, cur)) return;
    f32x4 acc[2][2][4][2];
#pragma unroll
    for (int a = 0; a < 2; ++a)
#pragma unroll
        for (int b = 0; b < 2; ++b)
#pragma unroll
            for (int m = 0; m < 4; ++m)
#pragma unroll
                for (int n = 0; n < 2; ++n) acc[a][b][m][n] = (f32x4){0.f, 0.f, 0.f, 0.f};
    bf16x8 At[4][2], B0[2][2], B1[2][2];
    const char* cA = a_base(g, cur.pm); const char* cB = (const char*)g.Bt + (size_t)cur.pn * tstepB;
    PG8_STAGE(PG8_SB(0, 0), cB, voffB); PG8_STAGE(PG8_SB(0, 1), cB + hstepB, voffB); PG8_STAGE(PG8_SA(0, 0), cA, voffA); PG8_STAGE(PG8_SA(0, 1), cA + hstepA, voffA);
    if (wr == 1) PG8_BAR;
    PG8_WAIT_V(2); PG8_BAR;
    PG8_STAGE(PG8_SB(1, 0), cB + kstepB, voffB); PG8_STAGE(PG8_SA(1, 0), cA + kstepA, voffA); PG8_STAGE(PG8_SB(1, 1), cB + hstepB + kstepB, voffB);
    PG8_WAIT_V(6); PG8_BAR;
    for (;;) {
        const bool has_next = S.next(ui + 1, nxt);
        const char* nA = has_next ? a_base(g, nxt.pm) : cA; const char* nB = has_next ? (const char*)g.Bt + (size_t)nxt.pn * tstepB : cB;
        for (int t = 0; t < nt; t += 2) {
            const bool last = (t == nt - 2);
            const char* a1 = cA + (size_t)(t + 1) * kstepA;
            const char* a2 = last ? nA : cA + (size_t)(t + 2) * kstepA; const char* b2 = last ? nB : cB + (size_t)(t + 2) * kstepB;
            const char* a3 = a2 + kstepA; const char* b3 = b2 + kstepB;
            PG8_LDB(B0, 0, 0); PG8_LDB(B1, 0, 1); PG8_SCHED; PG8_LDA(At, 0, 0); PG8_STAGE(PG8_SA(1, 1), a1 + hstepA, voffA);
            PG8_WAIT_V(8); PG8_WAIT_L(0); PG8_BAR; PG8_MMA(0, 0, At, B0); PG8_MMA(0, 1, At, B1); PG8_BAR; PG8_SCHED;
            PG8_LDA(At, 0, 1); PG8_STAGE(PG8_SB(0, 0), b2, voffB); PG8_STAGE(PG8_SB(0, 1), b2 + hstepB, voffB); PG8_STAGE(PG8_SA(0, 0), a2, voffA);
            PG8_WAIT_V(8); PG8_WAIT_L(0); PG8_BAR; PG8_MMA(1, 0, At, B0); PG8_MMA(1, 1, At, B1); PG8_BAR; PG8_SCHED;
            PG8_LDB(B0, 1, 0); PG8_LDB(B1, 1, 1); PG8_SCHED; PG8_LDA(At, 1, 0); PG8_STAGE(PG8_SA(0, 1), a2 + hstepA, voffA);
            PG8_WAIT_V(8); PG8_WAIT_L(0); PG8_BAR; PG8_MMA(0, 0, At, B0); PG8_MMA(0, 1, At, B1); PG8_BAR; PG8_SCHED;
            PG8_LDA(At, 1, 1); PG8_STAGE(PG8_SB(1, 0), b3, voffB); PG8_STAGE(PG8_SB(1, 1), b3 + hstepB, voffB); PG8_STAGE(PG8_SA(1, 0), a3, voffA);
            PG8_WAIT_V(8); PG8_WAIT_L(0); PG8_BAR; PG8_MMA(1, 0, At, B0); PG8_MMA(1, 1, At, B1); PG8_BAR; PG8_SCHED;
        }
        if constexpr (ALIGN_EPI) { if (wr == 0) PG8_BAR; }
        E(acc, cur, wr, wc, fr, fq);
        if (!has_next) break;
#pragma unroll
        for (int a = 0; a < 2; ++a)
#pragma unroll
            for (int b = 0; b < 2; ++b)
#pragma unroll
                for (int m = 0; m < 4; ++m)
#pragma unroll
                    for (int n = 0; n < 2; ++n) acc[a][b][m][n] = (f32x4){0.f, 0.f, 0.f, 0.f};
        cur = nxt; cA = nA; cB = nB; ++ui;
        if constexpr (ALIGN_EPI) { if (wr == 1) PG8_BAR; }
    }
    PG8_WAIT_V(0);
    if constexpr (!ALIGN_EPI) { if (wr == 0) PG8_BAR; }
    PG8_BAR;
#undef PG8_SA
#undef PG8_SB
#undef PG8_STAGE
#undef PG8_LDA
#undef PG8_LDB
#undef PG8_MMA
#undef PG8_WAIT_V
#undef PG8_WAIT_L
#undef PG8_BAR
#undef PG8_SCHED
}

#define EPI_ROWS_BEGIN const int row0 = u.pm * BM + wr * 64 + fr; const int col0 = u.pn * BM + wc * 32 + 8 * fq; \
    _Pragma("unroll") for (int ai = 0; ai < 2; ++ai) _Pragma("unroll") for (int m = 0; m < 4; ++m) { const int row = row0 + ai * HALF + m * 16;
#define EPI_ROWS_END }

struct EpiProj {
    bf16_t* O; const float* r1; bf16_t* vst; bf16_t* vwt;
    __device__ __forceinline__ void operator()(const Acc& acc, const Unit& u, int wr, int wc, int fr, int fq) const {
        const float sc = (u.pn >= 4 && u.pn < 8) ? C2 : 1.f;
        if (u.pn == 11 || u.pn == 13) {
            bf16_t* vt = (u.pn == 11) ? vst : vwt;
            const int cl = wc * 32 + 8 * fq;
            EPI_ROWS_BEGIN
                const float rs = r1[row]; const int bb = row >> 12, tok = row & (SEQ - 1);
#pragma unroll
                for (int bj = 0; bj < 2; ++bj) { const int c0 = cl + bj * HALF; bf16_t* bp = vt + ((size_t)(bb * 4 + (c0 >> 6)) * 64 + (c0 & 63)) * SEQ + tok;
#pragma unroll
                    for (int e = 0; e < 4; ++e) { bp[(size_t)e * SEQ] = (bf16_t)f2bf(acc[ai][bj][m][0][e] * rs); bp[(size_t)(4 + e) * SEQ] = (bf16_t)f2bf(acc[ai][bj][m][1][e] * rs); } }
            EPI_ROWS_END
            (void)col0;
            return;
        }
        EPI_ROWS_BEGIN
            const float rs = r1[row] * sc; bf16_t* rowp = O + (size_t)row * NPROJ + col0;
#pragma unroll
            for (int bj = 0; bj < 2; ++bj) { const f32x4 v0 = acc[ai][bj][m][0] * rs, v1 = acc[ai][bj][m][1] * rs;
                u32x4 w; w.x = pk2(v0[0], v0[1]); w.y = pk2(v0[2], v0[3]); w.z = pk2(v1[0], v1[1]); w.w = pk2(v1[2], v1[3]);
                *(u32x4*)(rowp + bj * HALF) = w; }
        EPI_ROWS_END
    }
};
struct EpiCmp {
    bf16_t* O; const float* bias;
    __device__ __forceinline__ void operator()(const Acc& acc, const Unit& u, int wr, int wc, int fr, int fq) const {
        const int bc = wc * 32 + 8 * fq;
        f32x4 bv[2][2];
#pragma unroll
        for (int bj = 0; bj < 2; ++bj)
#pragma unroll
            for (int n = 0; n < 2; ++n) bv[bj][n] = *(const f32x4*)(bias + bc + bj * HALF + 4 * n);
        EPI_ROWS_BEGIN
            bf16_t* rowp = O + (size_t)row * 256 + col0;
#pragma unroll
            for (int bj = 0; bj < 2; ++bj) { const f32x4 v0 = acc[ai][bj][m][0] + bv[bj][0], v1 = acc[ai][bj][m][1] + bv[bj][1];
                u32x4 w; w.x = pk2(gelu_tanh(v0[0]), gelu_tanh(v0[1])); w.y = pk2(gelu_tanh(v0[2]), gelu_tanh(v0[3])); w.z = pk2(gelu_tanh(v1[0]), gelu_tanh(v1[1])); w.w = pk2(gelu_tanh(v1[2]), gelu_tanh(v1[3]));
                *(u32x4*)(rowp + bj * HALF) = w; }
        EPI_ROWS_END
    }
};
struct EpiGlu {
    bf16_t* O; const bf16_t* Z; const float* bias;
    __device__ __forceinline__ void operator()(const Acc& acc, const Unit& u, int wr, int wc, int fr, int fq) const {
        f32x4 bv[2][2];
#pragma unroll
        for (int bj = 0; bj < 2; ++bj)
#pragma unroll
            for (int n = 0; n < 2; ++n) bv[bj][n] = *(const f32x4*)(bias + u.pn * BM + wc * 32 + 8 * fq + bj * HALF + 4 * n);
        EPI_ROWS_BEGIN
            bf16_t* rowp = O + (size_t)row * DM + col0; const bf16_t* zp = Z + (size_t)row * 1024 + col0;
#pragma unroll
            for (int bj = 0; bj < 2; ++bj) { const f32x4 v0 = acc[ai][bj][m][0] + bv[bj][0], v1 = acc[ai][bj][m][1] + bv[bj][1];
                const u32x4 zz = *(const u32x4*)(zp + bj * HALF);
                u32x4 w; w.x = pk2(bflo(zz.x) * sigmoidf_(v0[0]), bfhi(zz.x) * sigmoidf_(v0[1])); w.y = pk2(bflo(zz.y) * sigmoidf_(v0[2]), bfhi(zz.y) * sigmoidf_(v0[3]));
                w.z = pk2(bflo(zz.z) * sigmoidf_(v1[0]), bfhi(zz.z) * sigmoidf_(v1[1])); w.w = pk2(bflo(zz.w) * sigmoidf_(v1[2]), bfhi(zz.w) * sigmoidf_(v1[3]));
                *(u32x4*)(rowp + bj * HALF) = w; }
        EPI_ROWS_END
    }
};
template <bool BF> struct EpiRes {
    const void* base; bf16_t* ob; float* ss;
    __device__ __forceinline__ void operator()(const Acc& acc, const Unit& u, int wr, int wc, int fr, int fq) const {
        EPI_ROWS_BEGIN
            const size_t off = (size_t)row * DM + col0; float q = 0.f;
#pragma unroll
            for (int bj = 0; bj < 2; ++bj) { f32x4 b0, b1;
                if (BF) { const u32x4 bb = *(const u32x4*)((const bf16_t*)base + off + bj * HALF); b0 = (f32x4){bflo(bb.x), bfhi(bb.x), bflo(bb.y), bfhi(bb.y)}; b1 = (f32x4){bflo(bb.z), bfhi(bb.z), bflo(bb.w), bfhi(bb.w)}; }
                else { b0 = *(const f32x4*)((const float*)base + off + bj * HALF); b1 = *(const f32x4*)((const float*)base + off + bj * HALF + 4); }
                const f32x4 v0 = acc[ai][bj][m][0] + b0, v1 = acc[ai][bj][m][1] + b1;
                q += (v0[0] * v0[0] + v0[1] * v0[1]) + (v0[2] * v0[2] + v0[3] * v0[3]) + (v1[0] * v1[0] + v1[1] * v1[1]) + (v1[2] * v1[2] + v1[3] * v1[3]);
                u32x4 w; w.x = pk2(v0[0], v0[1]); w.y = pk2(v0[2], v0[3]); w.z = pk2(v1[0], v1[1]); w.w = pk2(v1[2], v1[3]); *(u32x4*)(ob + off + bj * HALF) = w; }
            q += __shfl_xor(q, 16); q += __shfl_xor(q, 32);
            if (fq == 0) atomicAdd(ss + row, q);
        EPI_ROWS_END
    }
};
struct EpiUp {
    bf16_t* O; const float* ss;
    __device__ __forceinline__ void operator()(const Acc& acc, const Unit& u, int wr, int wc, int fr, int fq) const {
        EPI_ROWS_BEGIN
            const float rs = __builtin_amdgcn_rsqf(ss[row] * (1.f / DM) + EPS); bf16_t* rowp = O + (size_t)row * DFF + col0;
#pragma unroll
            for (int bj = 0; bj < 2; ++bj) { f32x4 v0 = acc[ai][bj][m][0] * rs, v1 = acc[ai][bj][m][1] * rs;
#pragma unroll
                for (int e = 0; e < 4; ++e) { const float a = fmaxf(v0[e], 0.f), b = fmaxf(v1[e], 0.f); v0[e] = a * a; v1[e] = b * b; }
                u32x4 w; w.x = pk2(v0[0], v0[1]); w.y = pk2(v0[2], v0[3]); w.z = pk2(v1[0], v1[1]); w.w = pk2(v1[2], v1[3]);
                *(u32x4*)(rowp + bj * HALF) = w; }
        EPI_ROWS_END
    }
};
}

typedef GAS unsigned gu32;
#define RLX_AGENT __ATOMIC_RELAXED, __HIP_MEMORY_SCOPE_AGENT
#define XB_TMO      128
#define XB_XCNT(j)  (256  + 64 * (j))
#define XB_XSUB(j)  (1280 + 64 * (j))
#define XB_XGEN(j)  (2304 + 64 * (j))
#define XB_TOP      3328
#define XB_TOPGEN   3392
#define XCD_BAR_WORDS 3456
#define XB_SPIN_CAP (1u << 22)
__device__ __forceinline__ unsigned xb_ld(unsigned* p)              { return __hip_atomic_load(p, __ATOMIC_RELAXED, __HIP_MEMORY_SCOPE_AGENT); }
__device__ __forceinline__ unsigned xb_add(unsigned* p, unsigned v) { return __hip_atomic_fetch_add(p, v, __ATOMIC_RELAXED, __HIP_MEMORY_SCOPE_AGENT); }
__device__ __forceinline__ unsigned xb_xcc_id() { return (unsigned)__builtin_amdgcn_s_getreg((3 << 11) | 20) & 0xFu; }
#define XB_SPIN(cond, bar) do { unsigned _sp = 0; while (cond) { __builtin_amdgcn_s_sleep(1); \
    if ((++_sp & 255u) == 0u) { if (xb_ld(&(bar)[XB_TMO])) break; if (_sp > XB_SPIN_CAP) { atomicAdd(&(bar)[XB_TMO], 1u); break; } } } } while (0)
struct XcdBarrier { unsigned* bar; unsigned x; volatile LAS unsigned* st; };
__device__ __forceinline__ XcdBarrier xcd_barrier_post(unsigned* bar, volatile LAS unsigned* st) {
    XcdBarrier b; b.bar = bar; b.x = xb_xcc_id(); b.st = st;
    if (threadIdx.x == 0) (void)xb_add(&bar[XB_XCNT(b.x)], 1u);
    return b;
}
__device__ __forceinline__ void xcd_barrier_complete(unsigned* bar, unsigned x, unsigned& nloc, unsigned& nx) {
    const unsigned G = gridDim.x * gridDim.y * gridDim.z;
    unsigned sum, cnt, mine, sp = 0u;
    for (;;) {
        sum = 0u; cnt = 0u; mine = 0u;
#pragma unroll
        for (unsigned j = 0; j < 16; ++j) { const unsigned c = xb_ld(&bar[XB_XCNT(j)]); sum += c; cnt += (c > 0u) ? 1u : 0u; mine = (j == x) ? c : mine; }
        if (sum == G) break;
        __builtin_amdgcn_s_sleep(1);
        if ((++sp & 255u) == 0u) { if (xb_ld(&bar[XB_TMO])) break; if (sp > XB_SPIN_CAP) { atomicAdd(&bar[XB_TMO], 1u); break; } }
    }
    nloc = mine > 0u ? mine : 1u; nx = cnt > 0u ? cnt : 1u;
}
__device__ __forceinline__ void xcd_barrier(const XcdBarrier& b) {
    asm volatile("s_waitcnt vmcnt(0)" ::: "memory");
    __syncthreads();
    if (threadIdx.x == 0) {
        unsigned* bar = b.bar;
        __builtin_amdgcn_s_waitcnt(0);
        unsigned nloc = b.st[0], nx = b.st[1];
        if (nloc == 0u) { xcd_barrier_complete(bar, b.x, nloc, nx); b.st[0] = nloc; b.st[1] = nx; }
        const unsigned old = xb_add(&bar[XB_XSUB(b.x)], 1u);
        const unsigned gen = old / nloc;
        if (old + 1u == (gen + 1u) * nloc) {
            __builtin_amdgcn_fence(__ATOMIC_RELEASE, "agent");
            asm volatile("s_waitcnt vmcnt(0)" ::: "memory");
            const unsigned og = xb_add(&bar[XB_TOP], 1u);
            const unsigned tg = og / nx;
            if (og + 1u == (tg + 1u) * nx) xb_add(&bar[XB_TOPGEN], 1u);
            else XB_SPIN(xb_ld(&bar[XB_TOPGEN]) == tg, bar);
            __builtin_amdgcn_fence(__ATOMIC_ACQUIRE, "agent");
            xb_add(&bar[XB_XGEN(b.x)], 1u);
            asm volatile("s_waitcnt vmcnt(0)" ::: "memory");
        } else {
            XB_SPIN(xb_ld(&bar[XB_XGEN(b.x)]) == gen, bar);
            __builtin_amdgcn_fence(__ATOMIC_ACQUIRE, "agent");
            asm volatile("s_waitcnt vmcnt(0)" ::: "memory");
        }
    }
    __syncthreads();
}

struct Args { const float* in[25]; float* out; unsigned char* ws; int ph_lo, ph_hi; };
struct Frame {
    LAS unsigned char* lds;
    int tid, lane, wave, vcu, G;
    const Args* a; float* out; unsigned char* ws;
};
enum { I_X = 0, I_N1W, I_WIN, I_ARE, I_AIM, I_LOGDT, I_BRE, I_BIM, I_CRE, I_CIM, I_D, I_WGLU, I_BGLU, I_PECK, I_WCK1, I_WCK2, I_PECV, I_WCV1, I_WCV2, I_WOUT, I_N2W, I_WUP, I_WDOWN, I_REL, I_NFW };

__device__ __forceinline__ void p0_transpose_item(const float* W, int K, int N, int Npad, bf16_t* WT, const float* scale, LAS float* scr, int item, int lane) {
    const int nblk = Npad / 64, kb = item / nblk, nb = item % nblk, k0 = 64 * kb, n0 = 64 * nb;
    const int rr = lane >> 4, cc = lane & 15, n = n0 + 4 * cc;
    f32x4 v[16];
#pragma unroll
    for (int i = 0; i < 16; ++i) { v[i] = (f32x4){0.f, 0.f, 0.f, 0.f}; if (n < N) v[i] = *(const f32x4*)(W + (size_t)(k0 + 4 * i + rr) * N + n); }
#pragma unroll
    for (int i = 0; i < 16; ++i) { const int kk = 4 * i + rr; f32x4 x = v[i]; if (scale) x = x * scale[k0 + kk];
        LAS float* d = scr + kk * 65 + 4 * cc; d[0] = x[0]; d[1] = x[1]; d[2] = x[2]; d[3] = x[3]; }
    LDS_WAIT();
    const int c = lane & 7;
#pragma unroll
    for (int j = 0; j < 8; ++j) { const int nn = (lane >> 3) + 8 * j; const LAS float* s = scr + (8 * c) * 65 + nn;
        u32x4 o; o.x = pk2(s[0 * 65], s[1 * 65]); o.y = pk2(s[2 * 65], s[3 * 65]); o.z = pk2(s[4 * 65], s[5 * 65]); o.w = pk2(s[6 * 65], s[7 * 65]);
        *(u32x4*)(WT + (size_t)(n0 + nn) * K + k0 + 8 * c) = o; }
    LDS_WAIT();
}
__device__ __forceinline__ void late_transposes(Frame& F, int part) {
    LAS float* scr = (LAS float*)(F.lds + F.wave * 16896);
    const int gw = F.vcu * NWAVES + F.wave, NGW = F.G * NWAVES, lane = F.lane;
    unsigned char* ws = F.ws;
    constexpr int T_GLU = (1024 / 64) * (1024 / 64), T_OUT = (DM / 64) * (DM / 64), T_UP = (DM / 64) * (DFF / 64), T_DOWN = (DFF / 64) * (DM / 64);
    if (part == 0) {
        int g2 = gw, n2 = NGW;
        if (F.G > 64) { if (blockIdx.x < 32) return; g2 = ((int)blockIdx.x - 32) * NWAVES + F.wave; n2 = (F.G - 32) * NWAVES; }
        for (int it = g2; it < T_GLU + T_OUT + T_DOWN; it += n2) {
            if (it < T_DOWN) p0_transpose_item(F.a->in[I_WDOWN], DFF, DM, DM, (bf16_t*)(ws + WS_WDOWN), nullptr, scr, it, lane);
            else if (it < T_DOWN + T_OUT) p0_transpose_item(F.a->in[I_WOUT], DM, DM, DM, (bf16_t*)(ws + WS_WOUT), nullptr, scr, it - T_DOWN, lane);
            else p0_transpose_item(F.a->in[I_WGLU], 1024, 1024, 1024, (bf16_t*)(ws + WS_WGLU), nullptr, scr, it - T_DOWN - T_OUT, lane);
        }
    } else {
        int g2 = gw, n2 = NGW;
        const int nwg = (MTOK / 256) * (NPROJ / 256), r = nwg % F.G;
        if (r != 0 && F.G - r >= 8) { if ((int)blockIdx.x < r) return; g2 = ((int)blockIdx.x - r) * NWAVES + F.wave; n2 = (F.G - r) * NWAVES; }
        for (int it = g2; it < T_UP; it += n2) p0_transpose_item(F.a->in[I_WUP], DM, DFF, DFF, (bf16_t*)(ws + WS_WUP), F.a->in[I_N2W], scr, it, lane);
    }
}
__device__ __forceinline__ void p0_prologue(Frame& F) {
    LAS float* scr = (LAS float*)(F.lds + F.wave * 16896);
    const int gw = F.vcu * NWAVES + F.wave, NGW = F.G * NWAVES, lane = F.lane;
    unsigned char* ws = F.ws;
    constexpr int T_IN = (DM / 64) * (NPROJ / 64), T_C1 = (2048 / 64) * (256 / 64), T_C2 = (256 / 64) * (64 / 64);
    constexpr int NITEMS = T_IN + 2 * T_C1 + 2 * T_C2;
    for (int it = gw; it < NITEMS; it += NGW) {
        int r = it;
        if (r < T_IN) { p0_transpose_item(F.a->in[I_WIN], DM, D_IN, NPROJ, (bf16_t*)(ws + WS_WIN), F.a->in[I_N1W], scr, r, lane); continue; } r -= T_IN;
        if (r < T_C1) { p0_transpose_item(F.a->in[I_WCK1], 2048, 256, 256, (bf16_t*)(ws + WS_WC1K), nullptr, scr, r, lane); continue; } r -= T_C1;
        if (r < T_C1) { p0_transpose_item(F.a->in[I_WCV1], 2048, 256, 256, (bf16_t*)(ws + WS_WC1V), nullptr, scr, r, lane); continue; } r -= T_C1;
        if (r < T_C2) { p0_transpose_item(F.a->in[I_WCK2], 256, 64, 64, (bf16_t*)(ws + WS_WC2K), nullptr, scr, r, lane); continue; } r -= T_C2;
        p0_transpose_item(F.a->in[I_WCV2], 256, 64, 64, (bf16_t*)(ws + WS_WC2V), nullptr, scr, r, lane);
    }
    {
        const float* x = F.a->in[I_X]; bf16_t* xb = (bf16_t*)(ws + WS_XB); float* r1 = (float*)(ws + WS_R1);
        for (int mrow = gw; mrow < MTOK; mrow += NGW) {
            const f32x4* xr = (const f32x4*)(x + (size_t)mrow * DM) + lane; u32x2* o8 = (u32x2*)(xb + (size_t)mrow * DM) + lane;
            f32x4 v[8]; float s = 0.f;
#pragma unroll
            for (int j = 0; j < 8; ++j) { v[j] = xr[64 * j]; s += (v[j].x * v[j].x + v[j].y * v[j].y) + (v[j].z * v[j].z + v[j].w * v[j].w); }
            s = wave_sum(s);
#pragma unroll
            for (int j = 0; j < 8; ++j) { u32x2 w; w.x = pk2(v[j].x, v[j].y); w.y = pk2(v[j].z, v[j].w); o8[64 * j] = w; }
            if (lane == 0) r1[mrow] = __builtin_amdgcn_rsqf(s * (1.f / DM) + EPS);
        }
    }
    {
        const int idx = gw * 64 + lane;
        if (idx < 4096) {
            const int g = idx >> 6;
            const float dt = expf(F.a->in[I_LOGDT][g]); const float ar = F.a->in[I_ARE][idx], ai = F.a->in[I_AIM][idx];
            const float em1 = expm1f(dt * ar), th = dt * ai, c = cosf(th), s = sinf(th), sh = sinf(0.5f * th);
            const float mag = em1 + 1.f, abr = mag * c, abi = mag * s;
            const float zr = em1 * c - 2.f * sh * sh, zi = abi;
            const float den = ar * ar + ai * ai;
            const float cr = (zr * ar + zi * ai) / den, ci = (zi * ar - zr * ai) / den;
            const float magS = expf(512.f * dt * ar), thS = 512.f * th;
            f32x4 ab; ab.x = abr; ab.y = abi; ab.z = magS * cosf(thS); ab.w = magS * sinf(thS);
            ((f32x4*)(ws + WS_S5AB))[idx] = ab;
            bf16_t* bre = (bf16_t*)(ws + WS_BRE) + (size_t)idx * 16; bf16_t* bim = (bf16_t*)(ws + WS_BIM) + (size_t)idx * 16;
            const float* sbr = F.a->in[I_BRE] + (size_t)idx * 16; const float* sbi = F.a->in[I_BIM] + (size_t)idx * 16;
#pragma unroll
            for (int h = 0; h < 16; ++h) { const float br = sbr[h], bi = sbi[h]; bre[h] = (bf16_t)f2bf(cr * br - ci * bi); bim[h] = (bf16_t)f2bf(cr * bi + ci * br); }
        }
        const int i2 = gw * 64 + lane;
        if (i2 < 64 * 16 * 64) { bf16_t* cm = (bf16_t*)(ws + WS_CM); ((unsigned*)cm)[i2] = pk2(F.a->in[I_CRE][i2], -F.a->in[I_CIM][i2]); }
        if (i2 < 2048) { const int h = i2 >> 7, d = i2 & 127; ((float*)(ws + WS_BTAB))[i2] = F.a->in[I_REL][(int)T5B[d] * 16 + h] * LOG2E; }
    }
    for (int it = gw; it < 2 * 32 * 4; it += NGW) {
        const int which = it >> 7, ks = (it >> 2) & 31, jg = it & 3;
        const float* pe = F.a->in[which ? I_PECV : I_PECK] + ks * 64; const float* w1 = F.a->in[which ? I_WCV1 : I_WCK1] + (size_t)(ks * 64) * 256 + jg * 64 + lane;
        float a = 0.f;
#pragma unroll 16
        for (int k = 0; k < 64; ++k) a += pe[k] * w1[(size_t)k * 256];
        ((float*)(ws + WS_CBP))[(which * 32 + ks) * 256 + jg * 64 + lane] = a;
    }
    for (int idx = gw * 64 + lane; idx < MTOK; idx += NGW * 64) { ((float*)(ws + CTL_SS1))[idx] = 0.f; ((float*)(ws + CTL_SS2))[idx] = 0.f; }
    if (gw == 0 && lane < 32) ((unsigned*)(ws + CTL_KMAX))[lane] = 0u;
}
__device__ __forceinline__ void cmp_bias_reduce(Frame& F) {
    if (blockIdx.x != 0) return;
    const float* p = (const float*)(F.ws + WS_CBP); float* o = (float*)(F.ws + WS_CBF);
    const int which = F.tid >> 8, col = F.tid & 255; float a = 0.f;
    for (int ks = 0; ks < 32; ++ks) a += p[(which * 32 + ks) * 256 + col];
    o[which * 256 + col] = a;
}

template <bool FINAL>
__device__ __forceinline__ void s5_item(Frame& F, int b, int g, int seg) {
    const int lane = F.lane, pp = lane & 31, hi = lane >> 5;
    unsigned char* ws = F.ws;
    LAS unsigned char* L = F.lds + F.wave * 16896;
    const bf16_t* proj = (const bf16_t*)(ws + WS_PROJ);
    const f32x4 ab = ((const f32x4*)(ws + WS_S5AB))[g * 64 + lane];
    const float ar = ab.x, ai = ab.y;
    const bf16_t* bre = (const bf16_t*)(ws + WS_BRE) + (size_t)g * 64 * 16; const bf16_t* bim = (const bf16_t*)(ws + WS_BIM) + (size_t)g * 64 * 16;
    const bf16x8 bre0 = *(const bf16x8*)(bre + pp * 16 + 8 * hi), bre1 = *(const bf16x8*)(bre + (32 + pp) * 16 + 8 * hi);
    const bf16x8 bim0 = *(const bf16x8*)(bim + pp * 16 + 8 * hi), bim1 = *(const bf16x8*)(bim + (32 + pp) * 16 + 8 * hi);
    f32x2* segend = (f32x2*)(ws + WS_SEG) + (size_t)((b * 64 + g) * 8) * 64;
    float sr = 0.f, si = 0.f;
    bf16x8 cf[4]; f32x4 dv = {0.f, 0.f, 0.f, 0.f};
    if (FINAL) {
        for (int s2 = 0; s2 < seg; ++s2) { const f32x2 e = segend[s2 * 64 + lane]; const float nr = ab.z * sr - ab.w * si + e.x, ni = ab.z * si + ab.w * sr + e.y; sr = nr; si = ni; }
        const bf16_t* cm = (const bf16_t*)(ws + WS_CM) + (size_t)(g * 16 + (lane & 15)) * 128 + 8 * (lane >> 4);
#pragma unroll
        for (int ks = 0; ks < 4; ++ks) cf[ks] = *(const bf16x8*)(cm + 32 * ks);
        dv = *(const f32x4*)(F.a->in[I_D] + g * 16 + 4 * (lane >> 4));
    }
    bf16_t* zb = (bf16_t*)(ws + WS_Z);
    const bf16_t* up = proj + ((size_t)b * SEQ + seg * 512 + pp) * NPROJ + COL_U + g * 16 + 8 * hi;
    asm volatile("" :: "v"(bre0), "v"(bre1), "v"(bim0), "v"(bim1), "v"(ab));
    if (FINAL) asm volatile("" :: "v"(cf[0]), "v"(cf[1]), "v"(cf[2]), "v"(cf[3]), "v"(dv));
    const bf16_t* up2 = proj + ((size_t)b * SEQ + seg * 512 + (lane & 15)) * NPROJ + COL_U + g * 16 + 4 * (lane >> 4);
    u32x2 uu_next0 = {0u, 0u}, uu_next1 = {0u, 0u};
    if (FINAL) { uu_next0 = *(const u32x2*)up2; uu_next1 = *(const u32x2*)(up2 + (size_t)16 * NPROJ); }
    bf16x8 ua_next = *(const bf16x8*)up;
    for (int ch = 0; ch < 16; ++ch) {
        const size_t row0 = (size_t)b * SEQ + seg * 512 + ch * 32;
        const bf16x8 ua = ua_next;
        ua_next = *(const bf16x8*)(up + (size_t)(ch < 15 ? ch + 1 : 15) * 32 * NPROJ);
        const u32x2 uu_cur[2] = {uu_next0, uu_next1};
        if (FINAL) { const bf16_t* q2 = up2 + (size_t)(ch < 15 ? ch + 1 : 15) * 32 * NPROJ; uu_next0 = *(const u32x2*)q2; uu_next1 = *(const u32x2*)(q2 + (size_t)16 * NPROJ); }
        const f32x16 z16 = {};
        const f32x16 re0 = __builtin_amdgcn_mfma_f32_32x32x16_bf16(ua, bre0, z16, 0, 0, 0), im0 = __builtin_amdgcn_mfma_f32_32x32x16_bf16(ua, bim0, z16, 0, 0, 0);
        const f32x16 re1 = __builtin_amdgcn_mfma_f32_32x32x16_bf16(ua, bre1, z16, 0, 0, 0), im1 = __builtin_amdgcn_mfma_f32_32x32x16_bf16(ua, bim1, z16, 0, 0, 0);
#pragma unroll
        for (int r = 0; r < 16; ++r) { const int t = crow(r, hi);
            *(LAS f32x2*)(L + t * 528 + 8 * pp) = (f32x2){re0[r], im0[r]};
            *(LAS f32x2*)(L + t * 528 + 8 * (32 + pp)) = (f32x2){re1[r], im1[r]}; }
        LDS_WAIT();
#pragma unroll 8
        for (int t = 0; t < 32; ++t) {
            const f32x2 xv = *(const LAS f32x2*)(L + t * 528 + 8 * lane);
            const float nr = ar * sr - ai * si + xv.x, ni = ar * si + ai * sr + xv.y; sr = nr; si = ni;
            if (FINAL) *(LAS unsigned*)(L + t * 528 + 4 * lane) = pk2(sr, si);
        }
        if (FINAL) {
            LDS_WAIT();
#pragma unroll
            for (int tt = 0; tt < 2; ++tt) {
                f32x4 acc = {0.f, 0.f, 0.f, 0.f};
#pragma unroll
                for (int ks = 0; ks < 4; ++ks) { const bf16x8 sb = *(const LAS bf16x8*)(L + (16 * tt + (lane & 15)) * 528 + (32 * ks + 8 * (lane >> 4)) * 2);
                    acc = __builtin_amdgcn_mfma_f32_16x16x32_bf16(cf[ks], sb, acc, 0, 0, 0); }
                const size_t row = row0 + 16 * tt + (lane & 15);
                const u32x2 uu = uu_cur[tt];
                const float y0 = acc[0] + dv[0] * bflo(uu.x), y1 = acc[1] + dv[1] * bfhi(uu.x), y2 = acc[2] + dv[2] * bflo(uu.y), y3 = acc[3] + dv[3] * bfhi(uu.y);
                u32x2 w; w.x = pk2(gelu_tanh(y0), gelu_tanh(y1)); w.y = pk2(gelu_tanh(y2), gelu_tanh(y3));
                *(u32x2*)(zb + row * 1024 + g * 16 + 4 * (lane >> 4)) = w;
            }
        }
        LDS_WAIT();
    }
    if (!FINAL) segend[seg * 64 + lane] = (f32x2){sr, si};
}
__device__ __forceinline__ void cmul(float& cr, float& ci, float ar, float ai, float br, float bi) { cr = ar * br - ai * bi; ci = ar * bi + ai * br; }
__device__ __forceinline__ void s5_pass1_item(Frame& F, int b, int g, int seg) {
    const int lane = F.lane, pp = lane & 31, hi = lane >> 5;
    unsigned char* ws = F.ws;
    const bf16_t* proj = (const bf16_t*)(ws + WS_PROJ);
    const bf16_t* bre = (const bf16_t*)(ws + WS_BRE) + (size_t)g * 64 * 16; const bf16_t* bim = (const bf16_t*)(ws + WS_BIM) + (size_t)g * 64 * 16;
    const bf16x8 bre0 = *(const bf16x8*)(bre + pp * 16 + 8 * hi), bre1 = *(const bf16x8*)(bre + (32 + pp) * 16 + 8 * hi);
    const bf16x8 bim0 = *(const bf16x8*)(bim + pp * 16 + 8 * hi), bim1 = *(const bf16x8*)(bim + (32 + pp) * 16 + 8 * hi);
    float wr[2][16], wi[2][16], a32r[2], a32i[2];
#pragma unroll
    for (int T = 0; T < 2; ++T) {
        const f32x4 ab = ((const f32x4*)(ws + WS_S5AB))[g * 64 + 32 * T + pp];
        float pr[4], pi[4];
        pr[0] = 1.f; pi[0] = 0.f; pr[1] = ab.x; pi[1] = ab.y; cmul(pr[2], pi[2], ab.x, ab.y, ab.x, ab.y); cmul(pr[3], pi[3], pr[2], pi[2], ab.x, ab.y);
        float q4r, q4i, q8r, q8i, q16r, q16i, q24r, q24i;
        cmul(q4r, q4i, pr[2], pi[2], pr[2], pi[2]); cmul(q8r, q8i, q4r, q4i, q4r, q4i); cmul(q16r, q16i, q8r, q8i, q8r, q8i); cmul(q24r, q24i, q16r, q16i, q8r, q8i);
        const float fr = hi ? 1.f : q4r, fi = hi ? 0.f : q4i;
        const float br_[4] = {1.f, q8r, q16r, q24r}, bi_[4] = {0.f, q8i, q16i, q24i};
#pragma unroll
        for (int r = 0; r < 16; ++r) {
            float tr, ti; cmul(tr, ti, br_[3 - (r >> 2)], bi_[3 - (r >> 2)], pr[3 - (r & 3)], pi[3 - (r & 3)]);
            cmul(wr[T][r], wi[T][r], tr, ti, fr, fi);
        }
        float t28r, t28i; cmul(t28r, t28i, q24r, q24i, q4r, q4i); cmul(a32r[T], a32i[T], t28r, t28i, q4r, q4i);
    }
    float sr[2] = {0.f, 0.f}, si[2] = {0.f, 0.f};
    const bf16_t* up = proj + ((size_t)b * SEQ + seg * 512 + pp) * NPROJ + COL_U + g * 16 + 8 * hi;
    asm volatile("" :: "v"(bre0), "v"(bre1), "v"(bim0), "v"(bim1));
    bf16x8 ua_next = *(const bf16x8*)up;
    for (int ch = 0; ch < 16; ++ch) {
        const bf16x8 ua = ua_next;
        ua_next = *(const bf16x8*)(up + (size_t)(ch < 15 ? ch + 1 : 15) * 32 * NPROJ);
        const f32x16 z16 = {};
        const f32x16 re0 = __builtin_amdgcn_mfma_f32_32x32x16_bf16(ua, bre0, z16, 0, 0, 0), im0 = __builtin_amdgcn_mfma_f32_32x32x16_bf16(ua, bim0, z16, 0, 0, 0);
        const f32x16 re1 = __builtin_amdgcn_mfma_f32_32x32x16_bf16(ua, bre1, z16, 0, 0, 0), im1 = __builtin_amdgcn_mfma_f32_32x32x16_bf16(ua, bim1, z16, 0, 0, 0);
        float e0r = 0.f, e0i = 0.f, e1r = 0.f, e1i = 0.f;
#pragma unroll
        for (int r = 0; r < 16; ++r) {
            e0r += wr[0][r] * re0[r] - wi[0][r] * im0[r]; e0i += wr[0][r] * im0[r] + wi[0][r] * re0[r];
            e1r += wr[1][r] * re1[r] - wi[1][r] * im1[r]; e1i += wr[1][r] * im1[r] + wi[1][r] * re1[r];
        }
        e0r = pair_sum(e0r); e0i = pair_sum(e0i); e1r = pair_sum(e1r); e1i = pair_sum(e1i);
        float nr, ni;
        cmul(nr, ni, a32r[0], a32i[0], sr[0], si[0]); sr[0] = nr + e0r; si[0] = ni + e0i;
        cmul(nr, ni, a32r[1], a32i[1], sr[1], si[1]); sr[1] = nr + e1r; si[1] = ni + e1i;
    }
    f32x2* segend = (f32x2*)(ws + WS_SEG) + (size_t)((b * 64 + g) * 8) * 64;
    segend[seg * 64 + 32 * hi + pp] = hi ? (f32x2){sr[1], si[1]} : (f32x2){sr[0], si[0]};
}
template <bool FINAL> __device__ __forceinline__ void s5_phase(Frame& F) {
    int gw = F.vcu * NWAVES + F.wave, NGW = F.G * NWAVES;
    if (!FINAL && F.G > 64) { if (blockIdx.x < 32) return; gw = ((int)blockIdx.x - 32) * NWAVES + F.wave; NGW = (F.G - 32) * NWAVES; }
    for (int it = gw; it < BATCH * 64 * 8; it += NGW) { const int g = it & 63, bs = it >> 6; if (FINAL) s5_item<true>(F, bs >> 3, g, bs & 7); else s5_pass1_item(F, bs >> 3, g, bs & 7); }
}

__device__ __forceinline__ void cmp2_phase(Frame& F) {
    const int gw = F.vcu * NWAVES + F.wave, NGW = F.G * NWAVES, lane = F.lane, pp = lane & 31, hi = lane >> 5;
    unsigned char* ws = F.ws;
    for (int it = gw; it < 256; it += NGW) {
        const int which = it >> 7, rt = it & 127;
        const bf16_t* Hc = (const bf16_t*)(ws + WS_HC) + (size_t)which * 4096 * 256 + (size_t)(32 * rt + pp) * 256 + 8 * hi;
        const bf16_t* W2 = (const bf16_t*)(ws + (which ? WS_WC2V : WS_WC2K)) + (size_t)pp * 256 + 8 * hi;
        bf16_t* O = (bf16_t*)(ws + (which ? WS_VCMP : WS_KCMP));
        f32x16 a0 = {}, a1 = {};
#pragma unroll 4
        for (int ks = 0; ks < 16; ++ks) { const bf16x8 a = *(const bf16x8*)(Hc + 16 * ks), b0 = *(const bf16x8*)(W2 + 16 * ks), b1 = *(const bf16x8*)(W2 + 32 * 256 + 16 * ks);
            a0 = __builtin_amdgcn_mfma_f32_32x32x16_bf16(a, b0, a0, 0, 0, 0); a1 = __builtin_amdgcn_mfma_f32_32x32x16_bf16(a, b1, a1, 0, 0, 0); }
        if (which == 0) {
#pragma unroll
            for (int r = 0; r < 16; ++r) { const int row = 32 * rt + crow(r, hi); const bool zero = (row & 255) == 255;
                O[(size_t)row * 64 + pp] = zero ? (bf16_t)0 : (bf16_t)f2bf(a0[r]); O[(size_t)row * 64 + 32 + pp] = zero ? (bf16_t)0 : (bf16_t)f2bf(a1[r]); }
        } else {
            bf16_t* OT = (bf16_t*)(ws + WS_VCT);
#pragma unroll
            for (int c = 0; c < 4; ++c) { const int row = 32 * rt + 8 * c + 4 * hi; const int bgx = row >> 8, n = row & 255;
                float x0[4], x1[4];
#pragma unroll
                for (int e = 0; e < 4; ++e) { const bool zero = (n + e) == 255; x0[e] = zero ? 0.f : a0[4 * c + e]; x1[e] = zero ? 0.f : a1[4 * c + e]; }
                *(u32x2*)(OT + ((size_t)bgx * 64 + pp) * 256 + n) = (u32x2){pk2(x0[0], x0[1]), pk2(x0[2], x0[3])};
                *(u32x2*)(OT + ((size_t)bgx * 64 + 32 + pp) * 256 + n) = (u32x2){pk2(x1[0], x1[1]), pk2(x1[2], x1[3])}; }
        }
    }
}

__device__ __forceinline__ void knorm_phase(Frame& F) {
    const int gw = F.vcu * NWAVES + F.wave, NGW = F.G * NWAVES, lane = F.lane;
    const bf16_t* proj = (const bf16_t*)(F.ws + WS_PROJ);
    for (int it = gw; it < 2 * 16 * 64; it += NGW) {
        const int tensor = it >> 10, bg = (it >> 6) & 15, tb = it & 63;
        const u32x4* p = (const u32x4*)(proj + ((size_t)(bg >> 2) * SEQ + tb * 64 + lane) * NPROJ + (tensor ? COL_KW : COL_KS) + (bg & 3) * 64);
        float ss = 0.f;
#pragma unroll
        for (int k = 0; k < 8; ++k) { const u32x4 w = p[k]; const unsigned ww[4] = {w.x, w.y, w.z, w.w};
#pragma unroll
            for (int e = 0; e < 4; ++e) { const float a = bflo(ww[e]), b2 = bfhi(ww[e]); ss += a * a + b2 * b2; } }
#pragma unroll
        for (int o = 1; o < 64; o <<= 1) ss = fmaxf(ss, __shfl_xor(ss, o));
        if (lane == 0) atomicMax((unsigned*)(F.ws + CTL_KMAX) + tensor * 16 + bg, __builtin_bit_cast(unsigned, ss));
    }
}

namespace att {
constexpr int KSTR = 144, VSTR = 136, KVB = 64 * KSTR + 64 * VSTR;
constexpr int BIAS_OFF = 2 * KVB, WSCR_OFF = BIAS_OFF + 2048, IMP_OFF = WSCR_OFF + 8 * 256, SEL_OFF = IMP_OFF + 64 * 65 * 4, OT_OFF = SEL_OFF + 512, OT_STR = 68, OT_WAVE = 32 * OT_STR * 4, TAB2_OFF = OT_OFF + 8 * OT_WAVE, TAB2_N = 640, BMAX_OFF = TAB2_OFF + 4 * TAB2_N * 4  , END_OFF = BMAX_OFF + 64;
static_assert(END_OFF <= MISC_OFF, "attention LDS map");
constexpr float NEG = -1e30f;
enum { CMP_A = 0, CMP_B = 1, SLC = 2, WIN = 3 };
struct TileRegs { u32x4 k, v; };
struct Src { const bf16_t* k; size_t kstride; const bf16_t* vt; size_t vstride; };
struct Ctx {
    LAS unsigned char* lds; int tid, lane, wave, q, hi, tl, head, t, i;
    bf16x8 qr[4];
};
__device__ __forceinline__ void load_tile(TileRegs& R, const Src& S, int key0, int tid) {
    const unsigned r = (unsigned)tid >> 3, c = (unsigned)tid & 7u;
    const unsigned koff = (r * (unsigned)S.kstride + c * 8u) * 2u, voff = (r * (unsigned)S.vstride + c * 8u) * 2u;
    const char* kb = (const char*)S.k + (size_t)key0 * S.kstride * 2; const char* vb = (const char*)S.vt + (size_t)key0 * 2;
    R.k = *(const u32x4*)(kb + koff);
    R.v = *(const u32x4*)(vb + voff);
}
__device__ __forceinline__ void store_tile(const TileRegs& R, LAS unsigned char* lds, int buf, int tid) {
    const int r = tid >> 3, c = tid & 7;
    LAS unsigned char* b = lds + buf * KVB;
    *(LAS u32x4*)(b + r * KSTR + c * 16) = R.k;
    *(LAS u32x2*)(b + 64 * KSTR + r * VSTR + c * 16) = (u32x2){R.v.x, R.v.y};
    *(LAS u32x2*)(b + 64 * KSTR + r * VSTR + c * 16 + 8) = (u32x2){R.v.z, R.v.w};
}
__device__ __forceinline__ void qk_tile(f32x16& p0, f32x16& p1, const f32x16& cin, const Ctx& C, int buf) {
    const LAS unsigned char* kl = C.lds + buf * KVB + C.q * KSTR + 16 * C.hi;
    bf16x8 kf[8];
#pragma unroll
    for (int d0 = 0; d0 < 4; ++d0) { kf[2 * d0] = *(const LAS bf16x8*)(kl + 32 * d0); kf[2 * d0 + 1] = *(const LAS bf16x8*)(kl + 32 * KSTR + 32 * d0); }
    __builtin_amdgcn_sched_barrier(0);
    p0 = __builtin_amdgcn_mfma_f32_32x32x16_bf16(kf[0], C.qr[0], cin, 0, 0, 0); p1 = __builtin_amdgcn_mfma_f32_32x32x16_bf16(kf[1], C.qr[0], cin, 0, 0, 0);
#pragma unroll
    for (int d0 = 1; d0 < 4; ++d0) { p0 = __builtin_amdgcn_mfma_f32_32x32x16_bf16(kf[2 * d0], C.qr[d0], p0, 0, 0, 0); p1 = __builtin_amdgcn_mfma_f32_32x32x16_bf16(kf[2 * d0 + 1], C.qr[d0], p1, 0, 0, 0); }
}
template <int MODE> __device__ __forceinline__ void mask_bias(f32x16& p0, f32x16& p1, const Ctx& C, int kbase, bool sel) {
    const LAS float* bt = (const LAS float*)(C.lds + BIAS_OFF) + C.head * 128;
    const int d00 = (MODE == CMP_A || MODE == CMP_B) ? (C.t - 31 - 16 * (kbase + 4 * C.hi)) : (C.t - kbase - 4 * C.hi);
    float bv[2][16];
#pragma unroll
    for (int T = 0; T < 2; ++T)
#pragma unroll
        for (int r = 0; r < 16; ++r) {
            const int ko = 32 * T + (r & 3) + 8 * (r >> 2);
            const int dist = (MODE == CMP_A || MODE == CMP_B) ? (d00 - 16 * ko) : (d00 - ko);
            const int di = dist < 0 ? 0 : (dist > 127 ? 127 : dist);
            bv[T][r] = bt[di];
        }
    __builtin_amdgcn_sched_barrier(0);
#pragma unroll
    for (int T = 0; T < 2; ++T)
#pragma unroll
        for (int r = 0; r < 16; ++r) {
            const int ko = 32 * T + (r & 3) + 8 * (r >> 2);
            const int dist = (MODE == CMP_A || MODE == CMP_B) ? (d00 - 16 * ko) : (d00 - ko);
            bool valid = dist >= 0; if (MODE == WIN) valid = valid && dist < 512; if (MODE == SLC) valid = valid && sel;
            if (T == 0) p0[r] = valid ? p0[r] + bv[T][r] : NEG; else p1[r] = valid ? p1[r] + bv[T][r] : NEG;
        }
}
__device__ __forceinline__ void mask_bias2(f32x16& p0, f32x16& p1, const Ctx& C, int kbase) {
    const int d00 = C.t - kbase - 4 * C.hi;
    const LAS float* bp = (const LAS float*)(C.lds + TAB2_OFF) + C.head * TAB2_N + (d00 + 4);
#pragma unroll
    for (int T = 0; T < 2; ++T) {
        float bv[16];
#pragma unroll
        for (int r = 0; r < 16; ++r) bv[r] = bp[59 - (32 * T + (r & 3) + 8 * (r >> 2))];
        __builtin_amdgcn_sched_barrier(0);
#pragma unroll
        for (int r = 0; r < 16; ++r) { if (T == 0) p0[r] += bv[r]; else p1[r] += bv[r]; }
        __builtin_amdgcn_sched_barrier(0);
    }
}
__device__ __forceinline__ float quad_sum(float v) {
    v += __builtin_bit_cast(float, __builtin_amdgcn_mov_dpp(__builtin_bit_cast(int, v), 0xB1, 0xF, 0xF, true));
    v += __builtin_bit_cast(float, __builtin_amdgcn_mov_dpp(__builtin_bit_cast(int, v), 0x4E, 0xF, 0xF, true));
    return v;
}
__device__ __forceinline__ float tile_max(const f32x16& p0, const f32x16& p1) {
    float a = fmaxf(fmaxf(p0[0], p1[0]), p0[1]), b = fmaxf(fmaxf(p1[1], p0[2]), p1[2]);
#pragma unroll
    for (int r = 3; r < 15; r += 2) { a = fmaxf(fmaxf(a, p0[r]), p1[r]); b = fmaxf(fmaxf(b, p0[r + 1]), p1[r + 1]); }
    a = fmaxf(fmaxf(a, p0[15]), p1[15]);
    return pair_max(fmaxf(a, b));
}
__device__ __forceinline__ void v_load(bf16x8 (&vf)[8], const Ctx& C, int buf) {
    const LAS unsigned char* vl = C.lds + buf * KVB + 64 * KSTR + C.q * VSTR + 8 * C.hi;
#pragma unroll
    for (int db = 0; db < 2; ++db)
#pragma unroll
        for (int T = 0; T < 2; ++T)
#pragma unroll
            for (int s = 0; s < 2; ++s) {
                const LAS unsigned char* a = vl + db * 32 * VSTR + (32 * T + 16 * s) * 2;
                const u32x2 lo = *(const LAS u32x2*)a, hi2 = *(const LAS u32x2*)(a + 16);
                const u32x4 vv = {lo.x, lo.y, hi2.x, hi2.y};
                vf[db * 4 + T * 2 + s] = __builtin_bit_cast(bf16x8, vv);
            }
}
__device__ __forceinline__ void pv_mma(f32x16 (&o)[2], const f32x16& p0, const f32x16& p1, const bf16x8 (&vf)[8]) {
    bf16x8 pa[2][2];
#pragma unroll
    for (int s = 0; s < 2; ++s) {
        u32x4 w0, w1;
        w0.x = pk2(p0[8 * s + 0], p0[8 * s + 1]); w0.y = pk2(p0[8 * s + 2], p0[8 * s + 3]); w0.z = pk2(p0[8 * s + 4], p0[8 * s + 5]); w0.w = pk2(p0[8 * s + 6], p0[8 * s + 7]);
        w1.x = pk2(p1[8 * s + 0], p1[8 * s + 1]); w1.y = pk2(p1[8 * s + 2], p1[8 * s + 3]); w1.z = pk2(p1[8 * s + 4], p1[8 * s + 5]); w1.w = pk2(p1[8 * s + 6], p1[8 * s + 7]);
        pa[0][s] = __builtin_bit_cast(bf16x8, w0); pa[1][s] = __builtin_bit_cast(bf16x8, w1);
    }
#pragma unroll
    for (int T = 0; T < 2; ++T)
#pragma unroll
        for (int s = 0; s < 2; ++s)
#pragma unroll
            for (int db = 0; db < 2; ++db) o[db] = __builtin_amdgcn_mfma_f32_32x32x16_bf16(pa[T][s], vf[db * 4 + T * 2 + s], o[db], 0, 0, 0);
}
__device__ __forceinline__ void row_scale(f32x16 (&o)[2], float fq_, const Ctx& C) {
    LAS float* wsc = (LAS float*)(C.lds + WSCR_OFF + C.wave * 256);
    wsc[C.q] = fq_; LDS_WAIT();
#pragma unroll
    for (int r = 0; r < 16; ++r) { const float f = wsc[crow(r, C.hi)]; o[0][r] *= f; o[1][r] *= f; }
    LDS_WAIT();
}
template <bool FIRST> __device__ __forceinline__ void row_fma(const f32x16 (&o)[2], float fq_, const Ctx& C) {
    LAS float* wsc = (LAS float*)(C.lds + WSCR_OFF + C.wave * 256);
    LAS float* otl = (LAS float*)(C.lds + OT_OFF + C.wave * OT_WAVE) + C.q;
    wsc[C.q] = fq_; LDS_WAIT();
#pragma unroll
    for (int r = 0; r < 16; ++r) { const int row = crow(r, C.hi); const float f = wsc[row];
        if (FIRST) { otl[row * OT_STR] = o[0][r] * f; otl[row * OT_STR + 32] = o[1][r] * f; }
        else { otl[row * OT_STR] += o[0][r] * f; otl[row * OT_STR + 32] += o[1][r] * f; } }
    LDS_WAIT();
}

template <int MODE>
__device__ __forceinline__ void branch(const Ctx& C, const Src& S, int jlo, int jhi, const f32x16& negm, const float m, float& l, f32x16 (&o)[2], float inv_l, unsigned sel_lo, unsigned sel_hi) {
    TileRegs R; load_tile(R, S, 64 * jlo, C.tid);
    const float far_bias = ((const LAS float*)(C.lds + BIAS_OFF))[C.head * 128 + 127];
    store_tile(R, C.lds, 0, C.tid);
    __syncthreads();
    if (jlo + 1 <= jhi) load_tile(R, S, 64 * (jlo + 1), C.tid);
#pragma unroll 1
    for (int j = jlo; j <= jhi; ++j) {
        const int buf = (j - jlo) & 1;
        f32x16 p0, p1;
        const bool cfar = (MODE == CMP_A || MODE == CMP_B) && (1024 * j + 1167 <= 64 * C.i);
        if (MODE == CMP_A) {
            f32x16 cin;
#pragma unroll
            for (int r = 0; r < 16; ++r) cin[r] = cfar ? far_bias - m : -m;
            qk_tile(p0, p1, cin, C, buf);
            if (!cfar) mask_bias<MODE>(p0, p1, C, 64 * j, true);
            float s = 0.f;
#pragma unroll
            for (int r = 0; r < 16; ++r) s += fexp2(p0[r]) + fexp2(p1[r]);
            l += s;
        } else if (MODE == CMP_B) {
            f32x16 cin;
#pragma unroll
            for (int r = 0; r < 16; ++r) cin[r] = cfar ? far_bias - m : -m;
            qk_tile(p0, p1, cin, C, buf);
            bf16x8 vf[8]; v_load(vf, C, buf);
            if (!cfar) mask_bias<MODE>(p0, p1, C, 64 * j, true);
#pragma unroll
            for (int r = 0; r < 16; ++r) { p0[r] = fexp2(p0[r]) * inv_l; p1[r] = fexp2(p1[r]) * inv_l; }
            LAS float* imp = (LAS float*)(C.lds + IMP_OFF) + C.tl * 65;
#pragma unroll
            for (int T = 0; T < 2; ++T)
#pragma unroll
                for (int c = 0; c < 4; ++c) {
                    const float e0 = T ? p1[4 * c] : p0[4 * c], e1 = T ? p1[4 * c + 1] : p0[4 * c + 1], e2 = T ? p1[4 * c + 2] : p0[4 * c + 2], e3 = T ? p1[4 * c + 3] : p0[4 * c + 3];
                    float mainv = (e0 + e1) + (e2 + 0.5f * e3), carry = 0.5f * e3;
                    mainv = quad_sum(mainv); carry = quad_sum(carry);
                    const int sb = 16 * j + 8 * T + 2 * c + C.hi;
                    if (C.head == 0) { (void)__hip_atomic_fetch_add(imp + sb, mainv, __ATOMIC_RELAXED, __HIP_MEMORY_SCOPE_WORKGROUP); if (sb + 1 < 64) (void)__hip_atomic_fetch_add(imp + sb + 1, carry, __ATOMIC_RELAXED, __HIP_MEMORY_SCOPE_WORKGROUP); }
                }
            pv_mma(o, p0, p1, vf);
        } else {
            const int delta = C.i - j;
            const bool sel = (MODE == SLC) ? (((j < 32 ? (sel_lo >> j) : (sel_hi >> (j - 32))) & 1u) != 0u) : true;
            if (MODE != SLC || __any(sel)) {
                const bool near = delta <= 2 || (MODE == WIN && delta >= 8);
                if (near) {
                    const float c = sel ? -m : NEG;
                    f32x16 cin;
#pragma unroll
                    for (int r = 0; r < 16; ++r) cin[r] = c;
                    qk_tile(p0, p1, cin, C, buf);
                    mask_bias2(p0, p1, C, 64 * j);
                } else if (MODE == SLC && !__all(sel)) {
                    f32x16 cin;
#pragma unroll
                    for (int r = 0; r < 16; ++r) cin[r] = sel ? negm[r] : NEG;
                    qk_tile(p0, p1, cin, C, buf);
                } else qk_tile(p0, p1, negm, C, buf);
                bf16x8 vf[8]; v_load(vf, C, buf);
                __builtin_amdgcn_sched_barrier(0);
                float s = 0.f;
#pragma unroll
                for (int r = 0; r < 16; ++r) { p0[r] = fexp2(p0[r]); p1[r] = fexp2(p1[r]); s += p0[r] + p1[r]; }
                l += s;
                pv_mma(o, p0, p1, vf);
            }
        }
        if (j < jhi) store_tile(R, C.lds, buf ^ 1, C.tid);
        __syncthreads();
        if (j + 2 <= jhi) load_tile(R, S, 64 * (j + 2), C.tid);
    }
}

__device__ __forceinline__ void attn_unit(Frame& F, int b, int g, int i, bool tables) {
    unsigned char* ws = F.ws;
    const bf16_t* proj = (const bf16_t*)(ws + WS_PROJ);
    int tid_ = threadIdx.x; asm volatile("" : "+v"(tid_));
    Ctx C; C.lds = F.lds; C.tid = tid_; C.lane = tid_ & 63; C.wave = F.wave; C.q = C.lane & 31; C.hi = C.lane >> 5; C.tl = 8 * F.wave + (C.q >> 2); C.head = C.q & 3; C.i = i; C.t = 64 * i + C.tl;
    const size_t row = (size_t)b * SEQ + C.t;
    const int hq = g * 4 + C.head;
#pragma unroll
    for (int d0 = 0; d0 < 4; ++d0) C.qr[d0] = *(const bf16x8*)(proj + row * NPROJ + COL_Q + hq * 64 + 16 * d0 + 8 * C.hi);
    float gate[3];
#pragma unroll
    for (int j = 0; j < 3; ++j) gate[j] = sigmoidf_(bf2f(proj[row * NPROJ + COL_GL + hq * 3 + j]));
    for (int idx = C.tid; idx < 64 * 65; idx += 512) ((LAS float*)(C.lds + IMP_OFF))[idx] = 0.f;
    if (tables) {
        ((LAS float*)(C.lds + BIAS_OFF))[C.tid] = ((const float*)(ws + WS_BTAB))[(g * 4 + (C.tid >> 7)) * 128 + (C.tid & 127)];
        for (int idx = C.tid; idx < 4 * TAB2_N; idx += 512) { const int h = idx / TAB2_N, d = idx % TAB2_N - 63;
            ((LAS float*)(C.lds + TAB2_OFF))[idx] = (d < 0 || d >= 512) ? NEG : ((const float*)(ws + WS_BTAB))[(g * 4 + h) * 128 + (d > 127 ? 127 : d)]; }
        {
            LAS float* bm = (LAS float*)(C.lds + BMAX_OFF);
            if (C.wave < 4) { const float* bt = (const float*)(ws + WS_BTAB) + (g * 4 + C.wave) * 128; float x = fmaxf(bt[C.lane], bt[64 + C.lane]);
#pragma unroll
                for (int o_ = 1; o_ < 64; o_ <<= 1) x = fmaxf(x, __shfl_xor(x, o_));
                if (C.lane == 0) bm[C.wave] = x; }
            const u32x4* kp = (const u32x4*)((const bf16_t*)(ws + WS_KCMP) + (size_t)((b * 4 + g) * 256 + (C.tid >> 1)) * 64 + (C.tid & 1) * 32);
            float ss = 0.f;
#pragma unroll
            for (int k = 0; k < 4; ++k) { const u32x4 w = kp[k]; const unsigned ww[4] = {w.x, w.y, w.z, w.w};
#pragma unroll
                for (int e = 0; e < 4; ++e) { const float a = bflo(ww[e]), b2 = bfhi(ww[e]); ss += a * a + b2 * b2; } }
            ss += __shfl_xor(ss, 1);
#pragma unroll
            for (int o_ = 2; o_ < 64; o_ <<= 1) ss = fmaxf(ss, __shfl_xor(ss, o_));
            if (C.lane == 0) bm[4 + C.wave] = ss;
        }
    }
    __syncthreads();
    const float far_bias = ((const LAS float*)(C.lds + BIAS_OFF))[C.head * 128 + 127];
    const int bg = b * 4 + g;
    float qn, bmax, kc2;
    {
        float ss = 0.f;
#pragma unroll
        for (int d0 = 0; d0 < 4; ++d0) { const u32x4 w = __builtin_bit_cast(u32x4, C.qr[d0]); const unsigned ww[4] = {w.x, w.y, w.z, w.w};
#pragma unroll
            for (int e = 0; e < 4; ++e) { const float a = bflo(ww[e]), b2 = bfhi(ww[e]); ss += a * a + b2 * b2; } }
        qn = sqrtf(pair_sum(ss));
        const LAS float* bm = (const LAS float*)(C.lds + BMAX_OFF);
        bmax = bm[C.head];
        kc2 = fmaxf(fmaxf(fmaxf(bm[4], bm[5]), fmaxf(bm[6], bm[7])), fmaxf(fmaxf(bm[8], bm[9]), fmaxf(bm[10], bm[11])));
    }
    const unsigned* kmx = (const unsigned*)(ws + CTL_KMAX);
    const float m_c = qn * sqrtf(kc2) + bmax, m_s = qn * sqrtf(__builtin_bit_cast(float, kmx[bg])) + bmax, m_w = qn * sqrtf(__builtin_bit_cast(float, kmx[16 + bg])) + bmax;
    f32x16 o[2], negm;
    float l;
    {
        const Src S{(const bf16_t*)(ws + WS_KCMP) + (size_t)(bg * 256) * 64, 64, (const bf16_t*)(ws + WS_VCT) + (size_t)(bg * 64) * 256, 256};
        const int nkt = (4 * i + 2) / 64 + 1;
        l = 0.f; o[0] = f32x16{}; o[1] = f32x16{}; negm = f32x16{};
        branch<CMP_A>(C, S, 0, nkt - 1, negm, m_c, l, o, 0.f, 0u, 0u);
        const float lt = pair_sum(l), inv = lt > 0.f ? 1.f / lt : 0.f;
        branch<CMP_B>(C, S, 0, nkt - 1, negm, m_c, l, o, inv, 0u, 0u);
        row_fma<true>(o, gate[0], C);
    }
    {
        LDS_WAIT();
        LAS unsigned char* selb = C.lds + SEL_OFF;
        if (i >= 16) {
            const int tk = C.lane >> 3, cg = C.lane & 7;
            LAS unsigned* rowb = (LAS unsigned*)(C.lds + IMP_OFF) + (8 * C.wave + tk) * 65;
            unsigned long long kc[8]; unsigned cnt[8];
#pragma unroll
            for (int c = 0; c < 8; ++c) { const int s = cg * 8 + c; unsigned xb = rowb[s];
                xb = (s == 0 || s == i || s == i - 1) ? 0x461c4000u   : xb;
                rowb[s] = xb; kc[c] = ((unsigned long long)xb << 6) | (unsigned)(63 - s); cnt[c] = 0u; }
            LDS_WAIT();
            for (int s2 = 0; s2 <= i; ++s2) {
                const unsigned long long k2 = ((unsigned long long)rowb[s2] << 6) | (unsigned)(63 - s2);
#pragma unroll
                for (int c = 0; c < 8; ++c) cnt[c] += (k2 > kc[c]) ? 1u : 0u;
            }
            unsigned bits = 0;
#pragma unroll
            for (int c = 0; c < 8; ++c) { const int s = cg * 8 + c; if (cnt[c] < 16u && s <= i) bits |= 1u << c; }
            selb[(8 * C.wave + tk) * 8 + cg] = (unsigned char)bits;
        } else {
            if (C.lane < 8) { const unsigned long long mk = (2ull << i) - 1ull; *(LAS unsigned long long*)(selb + (8 * C.wave + C.lane) * 8) = mk; }
        }
        LDS_WAIT();
    }
    const u32x2 selw = *(const LAS u32x2*)(C.lds + SEL_OFF + C.tl * 8);
    {
        const Src S{proj + (size_t)b * SEQ * NPROJ + COL_KS + g * 64, NPROJ, (const bf16_t*)(ws + WS_VST) + (size_t)(bg * 64) * SEQ, SEQ};
        l = 0.f; o[0] = f32x16{}; o[1] = f32x16{};
#pragma unroll
        for (int r = 0; r < 16; ++r) negm[r] = far_bias - m_s;
        branch<SLC>(C, S, 0, i, negm, m_s, l, o, 0.f, selw.x, selw.y);
        const float lt = pair_sum(l);
        row_fma<false>(o, gate[1] / lt, C);
    }
    {
        const Src S{proj + (size_t)b * SEQ * NPROJ + COL_KW + g * 64, NPROJ, (const bf16_t*)(ws + WS_VWT) + (size_t)(bg * 64) * SEQ, SEQ};
        l = 0.f; o[0] = f32x16{}; o[1] = f32x16{};
#pragma unroll
        for (int r = 0; r < 16; ++r) negm[r] = far_bias - m_w;
        branch<WIN>(C, S, i >= 8 ? i - 8 : 0, i, negm, m_w, l, o, 0.f, 0u, 0u);
        const float lt = pair_sum(l);
        row_fma<false>(o, gate[2] / lt, C);
    }
    {
        bf16_t* mix = (bf16_t*)(ws + WS_MIX);
        const LAS float* otw = (const LAS float*)(C.lds + OT_OFF + C.wave * OT_WAVE);
#pragma unroll
        for (int k = 0; k < 4; ++k) { const int rowq = 8 * k + (C.lane >> 3), ch = C.lane & 7;
            const f32x4 a = *(const LAS f32x4*)(otw + rowq * OT_STR + ch * 8), c4 = *(const LAS f32x4*)(otw + rowq * OT_STR + ch * 8 + 4);
            u32x4 w; w.x = pk2(a[0], a[1]); w.y = pk2(a[2], a[3]); w.z = pk2(c4[0], c4[1]); w.w = pk2(c4[2], c4[3]);
            const size_t orow = (size_t)b * SEQ + 64 * i + 8 * C.wave + (rowq >> 2);
            *(u32x4*)(mix + orow * DM + 1024 + (g * 4 + (rowq & 3)) * 64 + ch * 8) = w; }
    }
    __syncthreads();
}
__device__ __forceinline__ void attn_phase(Frame& F) {
    for (int v = F.vcu; v < 256; v += F.G) {
        const int bg = v >> 4, s = v & 15;
#pragma unroll 1
        for (int k = 0; k < 4; ++k) { const int i = (k == 0) ? 63 - s : (k == 1) ? 32 + s : (k == 2) ? 31 - s : s; attn_unit(F, bg >> 2, bg & 3, i, k == 0); }
    }
}
}

__device__ __forceinline__ void final_norm_phase(Frame& F) {
    const int gw = F.vcu * NWAVES + F.wave, NGW = F.G * NWAVES, lane = F.lane;
    const float* ss = (const float*)(F.ws + CTL_SS2); const f32x4* nw = (const f32x4*)F.a->in[I_NFW] + 2 * lane;
    for (int mrow = gw; mrow < MTOK; mrow += NGW) {
        const float rs = __builtin_amdgcn_rsqf(ss[mrow] * (1.f / DM) + EPS);
        const u32x4* xr = (const u32x4*)((const bf16_t*)(F.ws + WS_MIX) + (size_t)mrow * DM) + lane;
        f32x4* orow = (f32x4*)(F.out + (size_t)mrow * DM) + 2 * lane;
#pragma unroll
        for (int j = 0; j < 4; ++j) { const u32x4 b = xr[64 * j]; const f32x4 w0 = nw[128 * j], w1 = nw[128 * j + 1];
            orow[128 * j] = (f32x4){bflo(b.x), bfhi(b.x), bflo(b.y), bfhi(b.y)} * rs * w0; orow[128 * j + 1] = (f32x4){bflo(b.z), bfhi(b.z), bflo(b.w), bfhi(b.w)} * rs * w1; }
    }
}

constexpr int N_PHASES = 9;
__global__ void __launch_bounds__(NWAVES * 64, 2) hymba_fwd(Args args) {
    extern __shared__ __attribute__((aligned(16))) unsigned char lds_raw[];
    Frame F;
    F.lds = (LAS unsigned char*)lds_raw;
    F.tid = threadIdx.x; F.lane = F.tid & 63; F.wave = __builtin_amdgcn_readfirstlane(F.tid >> 6);
    F.G = gridDim.x; { const int bx = blockIdx.x; F.vcu = (F.G % 8 == 0) ? (bx % 8) * (F.G / 8) + bx / 8 : bx; }
    F.a = &args; F.out = args.out; F.ws = args.ws;
    unsigned char* ws = args.ws;
    volatile LAS unsigned* MISC = (volatile LAS unsigned*)(F.lds + MISC_OFF);
    if (F.tid < 32) MISC[F.tid] = 0u;
    __syncthreads();
    XcdBarrier bar; bar.bar = (unsigned*)(ws + WS_CTL) + CW_BAR; bar.x = 0; bar.st = nullptr;
    const int lo = args.ph_lo, hi = args.ph_hi;
    const bool multi = (hi - lo) > 1;
    if (multi) bar = xcd_barrier_post((unsigned*)(ws + WS_CTL) + CW_BAR, MISC + 8);
#ifndef REPEAT_PHASE
#define REPEAT_PHASE -1
#endif
#define REP(k) for (int rep_ = 0; rep_ < ((REPEAT_PHASE == (k)) ? 2 : 1); ++rep_)
#ifndef ONLY_PHASE
#define ONLY_PHASE -1
#endif
#define IN(k) ((ONLY_PHASE < 0 || ONLY_PHASE == (k)) && lo <= (k) && (k) < hi)
#define SEAM(k) do { if (IN(k) && IN((k) + 1)) xcd_barrier(bar); } while (0)
    const int cblk = (int)blockIdx.x;

    if (IN(0)) { REP(0) { p0_prologue(F); } SEAM(0); }
    if (IN(1)) {
        pg8::Gemm g{(const bf16_t*)(ws + WS_XB), (const bf16_t*)(ws + WS_WIN), MTOK, NPROJ, DM, DM, 128, 0};
        pg8::StaticOrder S; S.init(MTOK, NPROJ, F.G, cblk);
        pg8::EpiProj E{(bf16_t*)(ws + WS_PROJ), (const float*)(ws + WS_R1), (bf16_t*)(ws + WS_VST), (bf16_t*)(ws + WS_VWT)};
        REP(1) { pg8::gemm_phase<pg8::EpiProj, pg8::StaticOrder, true>(F.lds, g, S, E); }
        cmp_bias_reduce(F);
        late_transposes(F, 1);
        SEAM(1);
    }
    if (IN(2)) { REP(2) {
        {
            pg8::Gemm g{(const bf16_t*)(ws + WS_PROJ) + COL_KC, (const bf16_t*)(ws + WS_WC1K), 4096, 256, 2048, 16 * NPROJ, NPROJ * 2, 1};
            pg8::StaticOrder S; S.init(4096, 256, F.G, cblk);
            pg8::EpiCmp E{(bf16_t*)(ws + WS_HC), (const float*)(ws + WS_CBF)};
            pg8::gemm_phase<pg8::EpiCmp, pg8::StaticOrder, true>(F.lds, g, S, E);
        }
        {
            pg8::Gemm g{(const bf16_t*)(ws + WS_PROJ) + COL_VC, (const bf16_t*)(ws + WS_WC1V), 4096, 256, 2048, 16 * NPROJ, NPROJ * 2, 1};
            pg8::StaticOrder S; S.init(4096, 256, F.G, (cblk + F.G - 16) % F.G);
            pg8::EpiCmp E{(bf16_t*)(ws + WS_HC) + (size_t)4096 * 256, (const float*)(ws + WS_CBF) + 256};
            pg8::gemm_phase<pg8::EpiCmp, pg8::StaticOrder, true>(F.lds, g, S, E);
        }
        __syncthreads();
        s5_phase<false>(F);
        late_transposes(F, 0);
        __syncthreads(); }
        SEAM(2);
    }
    if (IN(3)) { REP(3) { if (REPEAT_PHASE != 31) s5_phase<true>(F); if (REPEAT_PHASE != 32) cmp2_phase(F); knorm_phase(F); __syncthreads(); } SEAM(3); }
    if (IN(4)) {
        __syncthreads();
        pg8::Gemm g{(const bf16_t*)(ws + WS_Z), (const bf16_t*)(ws + WS_WGLU), MTOK, 1024, 1024, 1024, 128, 0};
        pg8::StaticOrder S; S.init(MTOK, 1024, F.G, cblk);
        pg8::EpiGlu E{(bf16_t*)(ws + WS_MIX), (const bf16_t*)(ws + WS_Z), F.a->in[I_BGLU]};
        for (int rep_ = 0; rep_ < ((REPEAT_PHASE == 40) ? 2 : 1); ++rep_) pg8::gemm_phase<pg8::EpiGlu, pg8::StaticOrder, true>(F.lds, g, S, E);
        __syncthreads();
        REP(4) { att::attn_phase(F); __syncthreads(); }
        SEAM(4);
    }
    if (IN(5)) {
        __syncthreads();
        pg8::Gemm g{(const bf16_t*)(ws + WS_MIX), (const bf16_t*)(ws + WS_WOUT), MTOK, DM, DM, DM, 128, 0};
        pg8::StaticOrder S; S.init(MTOK, DM, F.G, cblk);
        pg8::EpiRes<false> E{F.a->in[I_X], (bf16_t*)(ws + WS_X1B), (float*)(ws + CTL_SS1)};
        pg8::gemm_phase<pg8::EpiRes<false>, pg8::StaticOrder, true>(F.lds, g, S, E);
        SEAM(5);
    }
    if (IN(6)) {
        pg8::Gemm g{(const bf16_t*)(ws + WS_X1B), (const bf16_t*)(ws + WS_WUP), MTOK, DFF, DM, DM, 128, 0};
        pg8::StaticOrder S; S.init(MTOK, DFF, F.G, cblk);
        pg8::EpiUp E{(bf16_t*)(ws + WS_HID), (const float*)(ws + CTL_SS1)};
        REP(6) { pg8::gemm_phase<pg8::EpiUp, pg8::StaticOrder, true>(F.lds, g, S, E); }
        SEAM(6);
    }
    if (IN(7)) {
        pg8::Gemm g{(const bf16_t*)(ws + WS_HID), (const bf16_t*)(ws + WS_WDOWN), MTOK, DM, DFF, DFF, 128, 0};
        pg8::StaticOrder S; S.init(MTOK, DM, F.G, cblk);
        pg8::EpiRes<true> E{(const bf16_t*)(ws + WS_X1B), (bf16_t*)(ws + WS_MIX), (float*)(ws + CTL_SS2)};
        pg8::gemm_phase<pg8::EpiRes<true>, pg8::StaticOrder, true>(F.lds, g, S, E);
        SEAM(7);
    }
    if (IN(8)) final_norm_phase(F);
#undef IN
#undef SEAM
}

extern "C" void kernel_launch(void* const* d_in, const int* in_sizes, int n_in, void* d_out, int out_size, void* d_ws, size_t ws_size, hipStream_t stream) {
    static int grid = 0;
    if (grid == 0) {
        if (n_in != 25 || in_sizes[0] != MTOK * DM || out_size != MTOK * DM || ws_size < WS_END) {
            fprintf(stderr, "kernel_launch: unexpected shapes (n_in %d, in0 %d, out %d, ws %zu < %zu); nothing launched\n", n_in, n_in > 0 ? in_sizes[0] : -1, out_size, ws_size, (size_t)WS_END); grid = -1; return; }
        int dev = 0, cus = 0, per_cu = 0;
        if (hipGetDevice(&dev) != hipSuccess || hipDeviceGetAttribute(&cus, hipDeviceAttributeMultiprocessorCount, dev) != hipSuccess) { grid = -1; return; }
        if (hipFuncSetAttribute((const void*)hymba_fwd, hipFuncAttributeMaxDynamicSharedMemorySize, LDS_BYTES) != hipSuccess) { fprintf(stderr, "kernel_launch: hipFuncSetAttribute failed\n"); grid = -1; return; }
        if (hipOccupancyMaxActiveBlocksPerMultiprocessor(&per_cu, (const void*)hymba_fwd, NWAVES * 64, LDS_BYTES) != hipSuccess || per_cu < 1) { fprintf(stderr, "kernel_launch: occupancy query says %d blocks per CU\n", per_cu); per_cu = 1; }
        (void)hipGetLastError();
        grid = cus;
    }
    if (grid < 0) return;
    if (MK_N_LAUNCHES == 1) { if (hipMemsetAsync((char*)d_ws + WS_CTL, 0, CTL_ZERO_BYTES, stream) != hipSuccess) return; }
    Args a{};
    for (int i = 0; i < 25; ++i) a.in[i] = (const float*)d_in[i];
    a.out = (float*)d_out; a.ws = (unsigned char*)d_ws;
    if (MK_N_LAUNCHES == 1) {
        a.ph_lo = 0; a.ph_hi = N_PHASES;
        void* kargs[] = {&a};
        hipError_t e = hipLaunchCooperativeKernel((const void*)hymba_fwd, dim3(grid), dim3(NWAVES * 64), kargs, LDS_BYTES, stream);
        if (e != hipSuccess) fprintf(stderr, "kernel_launch: cooperative launch failed: %s (grid %d)\n", hipGetErrorString(e), grid);
    } else {
        for (int p = 0; p < N_PHASES; ++p) { a.ph_lo = p; a.ph_hi = p + 1; hipLaunchKernelGGL(hymba_fwd, dim3(grid), dim3(NWAVES * 64), LDS_BYTES, stream, a); }
    }
}
```

```cpp
#include <hip/hip_runtime.h>
#include <cstdio>
#include <cstdint>

#ifndef MK_N_LAUNCHES
#define MK_N_LAUNCHES 1
#endif

#define LAS __attribute__((address_space(3)))
#define GAS __attribute__((address_space(1)))
typedef unsigned short bf16_t;
typedef short bf16x8 __attribute__((ext_vector_type(8)));
typedef float f32x2 __attribute__((ext_vector_type(2)));
typedef float f32x4 __attribute__((ext_vector_type(4)));
typedef float f32x16 __attribute__((ext_vector_type(16)));
typedef unsigned u32x2 __attribute__((ext_vector_type(2)));
typedef unsigned u32x4 __attribute__((ext_vector_type(4)));
typedef __bf16 bf16x2_t __attribute__((ext_vector_type(2)));

#define LDS_WAIT() asm volatile("s_waitcnt lgkmcnt(0)" ::: "memory")
#define VM_WAIT() asm volatile("s_waitcnt vmcnt(0)" ::: "memory")

constexpr int BATCH = 4, SEQ = 4096, DM = 2048, MTOK = BATCH * SEQ, DFF = 8192;
constexpr int D_IN = 3632, NPROJ = 3840;
constexpr int COL_U = 0, COL_Q = 1024, COL_KC = 2048, COL_VC = 2304, COL_KS = 2560, COL_VS = 2816, COL_KW = 3072, COL_VW = 3328, COL_GL = 3584;
constexpr float EPS = 1e-6f;
constexpr float LOG2E = 1.4426950408889634f;
constexpr float C2 = 0.125f * LOG2E;
constexpr int NWAVES = 8;

constexpr size_t MiB = 1u << 20;
constexpr size_t WS_CTL = 0, CTL_ZERO_BYTES = 1 * MiB;
constexpr int CW_BAR = 4096;
constexpr size_t CTL_KMAX = 96 * 1024;
constexpr size_t CTL_SS1 = 256 * 1024, CTL_SS2 = 512 * 1024, CTL_CB = 768 * 1024;
constexpr size_t WS_R1 = 1 * MiB, WS_BTAB = 1 * MiB + 64 * 1024, WS_S5AB = 1 * MiB + 128 * 1024, WS_CBP = 1 * MiB + 256 * 1024  , WS_CBF = 1 * MiB + 384 * 1024  ;
constexpr size_t WS_BRE = 2 * MiB, WS_BIM = 2 * MiB + 128 * 1024, WS_CM = 2 * MiB + 256 * 1024;
constexpr size_t WS_SEG = 3 * MiB;
constexpr size_t WS_WIN = 4 * MiB, WS_WGLU = 19 * MiB, WS_WOUT = 21 * MiB, WS_WUP = 29 * MiB, WS_WDOWN = 61 * MiB, WS_WC1K = 93 * MiB, WS_WC1V = 94 * MiB,
                 WS_WC2K = 95 * MiB, WS_WC2V = 95 * MiB + 64 * 1024;
constexpr size_t WS_X1B = 100 * MiB, WS_MIX = 164 * MiB, WS_HID = 228 * MiB;
constexpr size_t WS_XB = 228 * MiB, WS_PROJ = 292 * MiB, WS_Z = 412 * MiB, WS_HC = 444 * MiB, WS_KCMP = 448 * MiB, WS_VCMP = 448 * MiB + 512 * 1024;
constexpr size_t WS_VST = 450 * MiB, WS_VWT = 458 * MiB, WS_VCT = 466 * MiB;
constexpr size_t WS_END = 484 * MiB;

constexpr int LDS_BYTES = 147456;
constexpr int MISC_OFF = 135168 + 4096;

__device__ __forceinline__ unsigned f2bf(float f) { unsigned u = __builtin_bit_cast(unsigned, f); return (u + 0x7fffu + ((u >> 16) & 1u)) >> 16; }
__device__ __forceinline__ unsigned pk2(float lo, float hi) { f32x2 v = {lo, hi}; bf16x2_t b = __builtin_convertvector(v, bf16x2_t); return __builtin_bit_cast(unsigned, b); }
__device__ __forceinline__ float bf2f(unsigned b) { return __builtin_bit_cast(float, b << 16); }
__device__ __forceinline__ float bflo(unsigned w) { return __builtin_bit_cast(float, w << 16); }
__device__ __forceinline__ float bfhi(unsigned w) { return __builtin_bit_cast(float, w & 0xffff0000u); }
__device__ __forceinline__ float fexp2(float x) { return __builtin_amdgcn_exp2f(x); }
__device__ __forceinline__ float frcp(float x) { return __builtin_amdgcn_rcpf(x); }
__device__ __forceinline__ float sigmoidf_(float x) { return frcp(1.f + fexp2(-x * LOG2E)); }
__device__ __forceinline__ float gelu_tanh(float x) {
    const float u = 0.7978845608028654f * (x + 0.044715f * x * x * x);
    return x * frcp(1.f + fexp2(-2.f * LOG2E * u));
}
__device__ __forceinline__ int crow(int r, int hi) { return (r & 3) + 8 * (r >> 2) + 4 * hi; }
__device__ __forceinline__ float wave_sum(float v) {
#pragma unroll
    for (int o = 1; o < 64; o <<= 1) v += __shfl_xor(v, o);
    return v;
}
__device__ __forceinline__ float pair_max(float v) {
    unsigned a = __builtin_bit_cast(unsigned, v), b = a; asm volatile("" : "+v"(b));
    auto rr = __builtin_amdgcn_permlane32_swap(a, b, false, false);
    unsigned r0 = rr[0], r1 = rr[1]; asm volatile("" : "+v"(r0), "+v"(r1));
    return fmaxf(__builtin_bit_cast(float, r0), __builtin_bit_cast(float, r1));
}
__device__ __forceinline__ float pair_sum(float v) {
    unsigned a = __builtin_bit_cast(unsigned, v), b = a; asm volatile("" : "+v"(b));
    auto rr = __builtin_amdgcn_permlane32_swap(a, b, false, false);
    unsigned r0 = rr[0], r1 = rr[1]; asm volatile("" : "+v"(r0), "+v"(r1));
    return __builtin_bit_cast(float, r0) + __builtin_bit_cast(float, r1);
}

__device__ const unsigned char T5B[128] = {0, 1, 2, 3, 4, 5, 6, 7, 8, 9, 10, 11, 12, 13, 14, 15, 16, 16, 16, 17, 17, 18, 18, 18, 19, 19, 19, 20, 20, 20, 20, 21, 21, 21, 21, 22, 22, 22, 22, 22, 23, 23, 23, 23, 23, 23,
    24, 24, 24, 24, 24, 24, 25, 25, 25, 25, 25, 25, 25, 26, 26, 26, 26, 26, 26, 26, 26, 27, 27, 27, 27, 27, 27, 27, 27, 27, 27, 28, 28, 28, 28, 28, 28, 28, 28, 28, 28, 29, 29, 29, 29, 29, 29, 29, 29, 29, 29, 29, 29,
    30, 30, 30, 30, 30, 30, 30, 30, 30, 30, 30, 30, 30, 30, 31, 31, 31, 31, 31, 31, 31, 31, 31, 31, 31, 31, 31, 31, 31};

namespace pg8 {
constexpr int BM = 256, BK = 64, HALF = 128, HTB = HALF * BK * 2, STAGE_BYTES = 8 * HTB, NXCD = 8, WGM = 8;
__host__ __device__ __forceinline__ int lds_byte(int r, int c) { const int st = (r >> 4) * 2 + (c >> 5), rr = r & 15, cc = c & 31, ob = rr * 64 + cc * 2; return st * 1024 + (ob ^ (((ob >> 9) & 1) << 5)); }
__host__ __device__ __forceinline__ void stage_rc(int b, int& R, int& C) { const int st = b / 1024, sb = b % 1024, swz = sb ^ (((sb >> 9) & 1) << 5); R = (st >> 1) * 16 + swz / 64; C = (st & 1) * 32 + (swz % 64) / 2; }
__host__ __device__ __forceinline__ int perm32(int rho) { const int n = rho >> 4, i = rho & 15; return 8 * (i >> 2) + 4 * n + (i & 3); }

struct Unit { int pm, pn; };
struct Gemm { const bf16_t* A; const bf16_t* Bt; int M, N, K; int lda; int a_kstep; int amode; };
__device__ __forceinline__ const char* a_base(const Gemm& g, int pm) {
    if (g.amode == 0) return (const char*)g.A + (size_t)pm * (size_t)BM * (size_t)g.lda * 2;
    return (const char*)g.A + ((size_t)(pm >> 2) * SEQ * NPROJ + (size_t)(pm & 3) * 64) * 2;
}

struct StaticOrder {
    int nM, nN, nwg, G, c;
    __host__ __device__ void init(int M, int N, int G_, int c_) { nM = M / BM; nN = N / BM; nwg = nM * nN; G = G_; c = c_; }
    __host__ __device__ bool next(int i, Unit& u) const {
        const long L = (long)i * G + c; if (L >= nwg) return false;
        int wgid = (int)L; { const int q = nwg / NXCD, r = nwg % NXCD, xcd = wgid % NXCD, off = wgid / NXCD; wgid = (xcd < r ? xcd * (q + 1) : r * (q + 1) + (xcd - r) * q) + off; }
        const int nig = WGM * nN, gid = wgid / nig, fm = gid * WGM, gsz = (nM - fm) < WGM ? (nM - fm) : WGM;
        u.pm = fm + ((wgid % nig) % gsz); u.pn = (wgid % nig) / gsz; return true;
    }
};

typedef f32x4 Acc[2][2][4][2];

template <class Epi, class Sched, bool ALIGN_EPI = true>
__device__ __forceinline__ void gemm_phase(LAS unsigned char* lds, const Gemm g, const Sched& S, const Epi& E) {
    const int tid = threadIdx.x, wid = __builtin_amdgcn_readfirstlane(tid >> 6), lane = tid & 63, wr = wid >> 2, wc = wid & 3, fr = lane & 15, fq = lane >> 4;
    const int K = g.K, nt = K / BK;
    unsigned voffA[2], voffB[2];
#pragma unroll
    for (int i = 0; i < 2; ++i) { int R, C; stage_rc(tid * 16 + i * 8192, R, C); const int Rb = (R & ~31) + perm32(R & 31);
        voffA[i] = (unsigned)(R * g.lda + C) * 2u; voffB[i] = (unsigned)(Rb * K + C) * 2u; }
    const size_t kstepA = (size_t)g.a_kstep, kstepB = (size_t)(BK * 2);
    const size_t hstepA = (size_t)HALF * g.lda * 2, hstepB = (size_t)HALF * K * 2;
    const size_t tstepB = 2 * hstepB;
    const unsigned ldsw = (unsigned)wid * 1024u;
    const int aoff = lds_byte(wr * 64 + fr, fq * 8), boff = lds_byte(wc * 32 + fr, fq * 8);
#define PG8_SA(b, h) (((b) * 2 + (h)) * HTB)
#define PG8_SB(b, h) ((4 + (b) * 2 + (h)) * HTB)
#define PG8_STAGE(bufoff, gbase, voff) do { _Pragma("unroll") for (int _i = 0; _i < 2; ++_i) \
        __builtin_amdgcn_global_load_lds((const unsigned*)((const char*)(gbase) + (voff)[_i]), (LAS unsigned*)(lds + (bufoff) + ldsw + _i * 8192), 16, 0, 0); } while (0)
#define PG8_LDA(dst, b, h) do { _Pragma("unroll") for (int m = 0; m < 4; ++m) _Pragma("unroll") for (int k = 0; k < 2; ++k) dst[m][k] = *(const LAS bf16x8*)(lds + PG8_SA(b, h) + aoff + m * 2048 + k * 1024); } while (0)
#define PG8_LDB(dst, b, h) do { _Pragma("unroll") for (int n = 0; n < 2; ++n) _Pragma("unroll") for (int k = 0; k < 2; ++k) dst[n][k] = *(const LAS bf16x8*)(lds + PG8_SB(b, h) + boff + n * 2048 + k * 1024); } while (0)
#define PG8_MMA(ai, bj, At, Bt) do { __builtin_amdgcn_s_setprio(1); _Pragma("unroll") for (int m = 0; m < 4; ++m) _Pragma("unroll") for (int n = 0; n < 2; ++n) _Pragma("unroll") for (int k = 0; k < 2; ++k) \
        acc[ai][bj][m][n] = __builtin_amdgcn_mfma_f32_16x16x32_bf16(Bt[n][k], At[m][k], acc[ai][bj][m][n], 0, 0, 0); __builtin_amdgcn_s_setprio(0); } while (0)
#define PG8_WAIT_V(n) asm volatile("s_waitcnt vmcnt(" #n ")" ::: "memory")
#define PG8_WAIT_L(n) asm volatile("s_waitcnt lgkmcnt(" #n ")" ::: "memory")
#define PG8_BAR __builtin_amdgcn_s_barrier()
#define PG8_SCHED __builtin_amdgcn_sched_barrier(0)
    Unit cur, nxt; int ui = 0;
    if (!S.next(0, cur)) return;
    f32x4 acc[2][2][4][2];
#pragma unroll
    for (int a = 0; a < 2; ++a)
#pragma unroll
        for (int b = 0; b < 2; ++b)
#pragma unroll
            for (int m = 0; m < 4; ++m)
#pragma unroll
                for (int n = 0; n < 2; ++n) acc[a][b][m][n] = (f32x4){0.f, 0.f, 0.f, 0.f};
    bf16x8 At[4][2], B0[2][2], B1[2][2];
    const char* cA = a_base(g, cur.pm); const char* cB = (const char*)g.Bt + (size_t)cur.pn * tstepB;
    PG8_STAGE(PG8_SB(0, 0), cB, voffB); PG8_STAGE(PG8_SB(0, 1), cB + hstepB, voffB); PG8_STAGE(PG8_SA(0, 0), cA, voffA); PG8_STAGE(PG8_SA(0, 1), cA + hstepA, voffA);
    if (wr == 1) PG8_BAR;
    PG8_WAIT_V(2); PG8_BAR;
    PG8_STAGE(PG8_SB(1, 0), cB + kstepB, voffB); PG8_STAGE(PG8_SA(1, 0), cA + kstepA, voffA); PG8_STAGE(PG8_SB(1, 1), cB + hstepB + kstepB, voffB);
    PG8_WAIT_V(6); PG8_BAR;
    for (;;) {
        const bool has_next = S.next(ui + 1, nxt);
        const char* nA = has_next ? a_base(g, nxt.pm) : cA; const char* nB = has_next ? (const char*)g.Bt + (size_t)nxt.pn * tstepB : cB;
        for (int t = 0; t < nt; t += 2) {
            const bool last = (t == nt - 2);
            const char* a1 = cA + (size_t)(t + 1) * kstepA;
            const char* a2 = last ? nA : cA + (size_t)(t + 2) * kstepA; const char* b2 = last ? nB : cB + (size_t)(t + 2) * kstepB;
            const char* a3 = a2 + kstepA; const char* b3 = b2 + kstepB;
            PG8_LDB(B0, 0, 0); PG8_LDB(B1, 0, 1); PG8_SCHED; PG8_LDA(At, 0, 0); PG8_STAGE(PG8_SA(1, 1), a1 + hstepA, voffA);
            PG8_WAIT_V(8); PG8_WAIT_L(0); PG8_BAR; PG8_MMA(0, 0, At, B0); PG8_MMA(0, 1, At, B1); PG8_BAR; PG8_SCHED;
            PG8_LDA(At, 0, 1); PG8_STAGE(PG8_SB(0, 0), b2, voffB); PG8_STAGE(PG8_SB(0, 1), b2 + hstepB, voffB); PG8_STAGE(PG8_SA(0, 0), a2, voffA);
            PG8_WAIT_V(8); PG8_WAIT_L(0); PG8_BAR; PG8_MMA(1, 0, At, B0); PG8_MMA(1, 1, At, B1); PG8_BAR; PG8_SCHED;
            PG8_LDB(B0, 1, 0); PG8_LDB(B1, 1, 1); PG8_SCHED; PG8_LDA(At, 1, 0); PG8_STAGE(PG8_SA(0, 1), a2 + hstepA, voffA);
            PG8_WAIT_V(8); PG8_WAIT_L(0); PG8_BAR; PG8_MMA(0, 0, At, B0); PG8_MMA(0, 1, At, B1); PG8_BAR; PG8_SCHED;
            PG8_LDA(At, 1, 1); PG8_STAGE(PG8_SB(1, 0), b3, voffB); PG8_STAGE(PG8_SB(1, 1), b3 + hstepB, voffB); PG8_STAGE(PG8_SA(1, 0), a3, voffA);
            PG8_WAIT_V(8); PG8_WAIT_L(0); PG8_BAR; PG8_MMA(1, 0, At, B0); PG8_MMA(1, 1, At, B1); PG8_BAR; PG8_SCHED;
        }
        if constexpr (ALIGN_EPI) { if (wr == 0) PG8_BAR; }
        E(acc, cur, wr, wc, fr, fq);
        if (!has_next) break;
#pragma unroll
        for (int a = 0; a < 2; ++a)
#pragma unroll
            for (int b = 0; b < 2; ++b)
#pragma unroll
                for (int m = 0; m < 4; ++m)
#pragma unroll
                    for (int n = 0; n < 2; ++n) acc[a][b][m][n] = (f32x4){0.f, 0.f, 0.f, 0.f};
        cur = nxt; cA = nA; cB = nB; ++ui;
        if constexpr (ALIGN_EPI) { if (wr == 1) PG8_BAR; }
    }
    PG8_WAIT_V(0);
    if constexpr (!ALIGN_EPI) { if (wr == 0) PG8_BAR; }
    PG8_BAR;
#undef PG8_SA
#undef PG8_SB
#undef PG8_STAGE
#undef PG8_LDA
#undef PG8_LDB
#undef PG8_MMA
#undef PG8_WAIT_V
#undef PG8_WAIT_L
#undef PG8_BAR
#undef PG8_SCHED
}

#define EPI_ROWS_BEGIN const int row0 = u.pm * BM + wr * 64 + fr; const int col0 = u.pn * BM + wc * 32 + 8 * fq; \
    _Pragma("unroll") for (int ai = 0; ai < 2; ++ai) _Pragma("unroll") for (int m = 0; m < 4; ++m) { const int row = row0 + ai * HALF + m * 16;
#define EPI_ROWS_END }

struct EpiProj {
    bf16_t* O; const float* r1; bf16_t* vst; bf16_t* vwt;
    __device__ __forceinline__ void operator()(const Acc& acc, const Unit& u, int wr, int wc, int fr, int fq) const {
        const float sc = (u.pn >= 4 && u.pn < 8) ? C2 : 1.f;
        if (u.pn == 11 || u.pn == 13) {
            bf16_t* vt = (u.pn == 11) ? vst : vwt;
            const int cl = wc * 32 + 8 * fq;
            EPI_ROWS_BEGIN
                const float rs = r1[row]; const int bb = row >> 12, tok = row & (SEQ - 1);
#pragma unroll
                for (int bj = 0; bj < 2; ++bj) { const int c0 = cl + bj * HALF; bf16_t* bp = vt + ((size_t)(bb * 4 + (c0 >> 6)) * 64 + (c0 & 63)) * SEQ + tok;
#pragma unroll
                    for (int e = 0; e < 4; ++e) { bp[(size_t)e * SEQ] = (bf16_t)f2bf(acc[ai][bj][m][0][e] * rs); bp[(size_t)(4 + e) * SEQ] = (bf16_t)f2bf(acc[ai][bj][m][1][e] * rs); } }
            EPI_ROWS_END
            (void)col0;
            return;
        }
        EPI_ROWS_BEGIN
            const float rs = r1[row] * sc; bf16_t* rowp = O + (size_t)row * NPROJ + col0;
#pragma unroll
            for (int bj = 0; bj < 2; ++bj) { const f32x4 v0 = acc[ai][bj][m][0] * rs, v1 = acc[ai][bj][m][1] * rs;
                u32x4 w; w.x = pk2(v0[0], v0[1]); w.y = pk2(v0[2], v0[3]); w.z = pk2(v1[0], v1[1]); w.w = pk2(v1[2], v1[3]);
                *(u32x4*)(rowp + bj * HALF) = w; }
        EPI_ROWS_END
    }
};
struct EpiCmp {
    bf16_t* O; const float* bias;
    __device__ __forceinline__ void operator()(const Acc& acc, const Unit& u, int wr, int wc, int fr, int fq) const {
        const int bc = wc * 32 + 8 * fq;
        f32x4 bv[2][2];
#pragma unroll
        for (int bj = 0; bj < 2; ++bj)
#pragma unroll
            for (int n = 0; n < 2; ++n) bv[bj][n] = *(const f32x4*)(bias + bc + bj * HALF + 4 * n);
        EPI_ROWS_BEGIN
            bf16_t* rowp = O + (size_t)row * 256 + col0;
#pragma unroll
            for (int bj = 0; bj < 2; ++bj) { const f32x4 v0 = acc[ai][bj][m][0] + bv[bj][0], v1 = acc[ai][bj][m][1] + bv[bj][1];
                u32x4 w; w.x = pk2(gelu_tanh(v0[0]), gelu_tanh(v0[1])); w.y = pk2(gelu_tanh(v0[2]), gelu_tanh(v0[3])); w.z = pk2(gelu_tanh(v1[0]), gelu_tanh(v1[1])); w.w = pk2(gelu_tanh(v1[2]), gelu_tanh(v1[3]));
                *(u32x4*)(rowp + bj * HALF) = w; }
        EPI_ROWS_END
    }
};
struct EpiGlu {
    bf16_t* O; const bf16_t* Z; const float* bias;
    __device__ __forceinline__ void operator()(const Acc& acc, const Unit& u, int wr, int wc, int fr, int fq) const {
        f32x4 bv[2][2];
#pragma unroll
        for (int bj = 0; bj < 2; ++bj)
#pragma unroll
            for (int n = 0; n < 2; ++n) bv[bj][n] = *(const f32x4*)(bias + u.pn * BM + wc * 32 + 8 * fq + bj * HALF + 4 * n);
        EPI_ROWS_BEGIN
            bf16_t* rowp = O + (size_t)row * DM + col0; const bf16_t* zp = Z + (size_t)row * 1024 + col0;
#pragma unroll
            for (int bj = 0; bj < 2; ++bj) { const f32x4 v0 = acc[ai][bj][m][0] + bv[bj][0], v1 = acc[ai][bj][m][1] + bv[bj][1];
                const u32x4 zz = *(const u32x4*)(zp + bj * HALF);
                u32x4 w; w.x = pk2(bflo(zz.x) * sigmoidf_(v0[0]), bfhi(zz.x) * sigmoidf_(v0[1])); w.y = pk2(bflo(zz.y) * sigmoidf_(v0[2]), bfhi(zz.y) * sigmoidf_(v0[3]));
                w.z = pk2(bflo(zz.z) * sigmoidf_(v1[0]), bfhi(zz.z) * sigmoidf_(v1[1])); w.w = pk2(bflo(zz.w) * sigmoidf_(v1[2]), bfhi(zz.w) * sigmoidf_(v1[3]));
                *(u32x4*)(rowp + bj * HALF) = w; }
        EPI_ROWS_END
    }
};
template <bool BF> struct EpiRes {
    const void* base; bf16_t* ob; float* ss;
    __device__ __forceinline__ void operator()(const Acc& acc, const Unit& u, int wr, int wc, int fr, int fq) const {
        EPI_ROWS_BEGIN
            const size_t off = (size_t)row * DM + col0; float q = 0.f;
#pragma unroll
            for (int bj = 0; bj < 2; ++bj) { f32x4 b0, b1;
                if (BF) { const u32x4 bb = *(const u32x4*)((const bf16_t*)base + off + bj * HALF); b0 = (f32x4){bflo(bb.x), bfhi(bb.x), bflo(bb.y), bfhi(bb.y)}; b1 = (f32x4){bflo(bb.z), bfhi(bb.z), bflo(bb.w), bfhi(bb.w)}; }
                else { b0 = *(const f32x4*)((const float*)base + off + bj * HALF); b1 = *(const f32x4*)((const float*)base + off + bj * HALF + 4); }
                const f32x4 v0 = acc[ai][bj][m][0] + b0, v1 = acc[ai][bj][m][1] + b1;
                q += (v0[0] * v0[0] + v0[1] * v0[1]) + (v0[2] * v0[2] + v0[3] * v0[3]) + (v1[0] * v1[0] + v1[1] * v1[1]) + (v1[2] * v1[2] + v1[3] * v1[3]);
                u32x4 w; w.x = pk2(v0[0], v0[1]); w.y = pk2(v0[2], v0[3]); w.z = pk2(v1[0], v1[1]); w.w = pk2(v1[2], v1[3]); *(u32x4*)(ob + off + bj * HALF) = w; }
            q += __shfl_xor(q, 16); q += __shfl_xor(q, 32);
            if (fq == 0) atomicAdd(ss + row, q);
        EPI_ROWS_END
    }
};
struct EpiUp {
    bf16_t* O; const float* ss;
    __device__ __forceinline__ void operator()(const Acc& acc, const Unit& u, int wr, int wc, int fr, int fq) const {
        EPI_ROWS_BEGIN
            const float rs = __builtin_amdgcn_rsqf(ss[row] * (1.f / DM) + EPS); bf16_t* rowp = O + (size_t)row * DFF + col0;
#pragma unroll
            for (int bj = 0; bj < 2; ++bj) { f32x4 v0 = acc[ai][bj][m][0] * rs, v1 = acc[ai][bj][m][1] * rs;
#pragma unroll
                for (int e = 0; e < 4; ++e) { const float a = fmaxf(v0[e], 0.f), b = fmaxf(v1[e], 0.f); v0[e] = a * a; v1[e] = b * b; }
                u32x4 w; w.x = pk2(v0[0], v0[1]); w.y = pk2(v0[2], v0[3]); w.z = pk2(v1[0], v1[1]); w.w = pk2(v1[2], v1[3]);
                *(u32x4*)(rowp + bj * HALF) = w; }
        EPI_ROWS_END
    }
};
}

typedef GAS unsigned gu32;
#define RLX_AGENT __ATOMIC_RELAXED, __HIP_MEMORY_SCOPE_AGENT
#define XB_TMO      128
#define XB_XCNT(j)  (256  + 64 * (j))
#define XB_XSUB(j)  (1280 + 64 * (j))
#define XB_XGEN(j)  (2304 + 64 * (j))
#define XB_TOP      3328
#define XB_TOPGEN   3392
#define XCD_BAR_WORDS 3456
#define XB_SPIN_CAP (1u << 22)
__device__ __forceinline__ unsigned xb_ld(unsigned* p)              { return __hip_atomic_load(p, __ATOMIC_RELAXED, __HIP_MEMORY_SCOPE_AGENT); }
__device__ __forceinline__ unsigned xb_add(unsigned* p, unsigned v) { return __hip_atomic_fetch_add(p, v, __ATOMIC_RELAXED, __HIP_MEMORY_SCOPE_AGENT); }
__device__ __forceinline__ unsigned xb_xcc_id() { return (unsigned)__builtin_amdgcn_s_getreg((3 << 11) | 20) & 0xFu; }
#define XB_SPIN(cond, bar) do { unsigned _sp = 0; while (cond) { __builtin_amdgcn_s_sleep(1); \
    if ((++_sp & 255u) == 0u) { if (xb_ld(&(bar)[XB_TMO])) break; if (_sp > XB_SPIN_CAP) { atomicAdd(&(bar)[XB_TMO], 1u); break; } } } } while (0)
struct XcdBarrier { unsigned* bar; unsigned x; volatile LAS unsigned* st; };
__device__ __forceinline__ XcdBarrier xcd_barrier_post(unsigned* bar, volatile LAS unsigned* st) {
    XcdBarrier b; b.bar = bar; b.x = xb_xcc_id(); b.st = st;
    if (threadIdx.x == 0) (void)xb_add(&bar[XB_XCNT(b.x)], 1u);
    return b;
}
__device__ __forceinline__ void xcd_barrier_complete(unsigned* bar, unsigned x, unsigned& nloc, unsigned& nx) {
    const unsigned G = gridDim.x * gridDim.y * gridDim.z;
    unsigned sum, cnt, mine, sp = 0u;
    for (;;) {
        sum = 0u; cnt = 0u; mine = 0u;
#pragma unroll
        for (unsigned j = 0; j < 16; ++j) { const unsigned c = xb_ld(&bar[XB_XCNT(j)]); sum += c; cnt += (c > 0u) ? 1u : 0u; mine = (j == x) ? c : mine; }
        if (sum == G) break;
        __builtin_amdgcn_s_sleep(1);
        if ((++sp & 255u) == 0u) { if (xb_ld(&bar[XB_TMO])) break; if (sp > XB_SPIN_CAP) { atomicAdd(&bar[XB_TMO], 1u); break; } }
    }
    nloc = mine > 0u ? mine : 1u; nx = cnt > 0u ? cnt : 1u;
}
__device__ __forceinline__ void xcd_barrier(const XcdBarrier& b) {
    asm volatile("s_waitcnt vmcnt(0)" ::: "memory");
    __syncthreads();
    if (threadIdx.x == 0) {
        unsigned* bar = b.bar;
        __builtin_amdgcn_s_waitcnt(0);
        unsigned nloc = b.st[0], nx = b.st[1];
        if (nloc == 0u) { xcd_barrier_complete(bar, b.x, nloc, nx); b.st[0] = nloc; b.st[1] = nx; }
        const unsigned old = xb_add(&bar[XB_XSUB(b.x)], 1u);
        const unsigned gen = old / nloc;
        if (old + 1u == (gen + 1u) * nloc) {
            __builtin_amdgcn_fence(__ATOMIC_RELEASE, "agent");
            asm volatile("s_waitcnt vmcnt(0)" ::: "memory");
            const unsigned og = xb_add(&bar[XB_TOP], 1u);
            const unsigned tg = og / nx;
            if (og + 1u == (tg + 1u) * nx) xb_add(&bar[XB_TOPGEN], 1u);
            else XB_SPIN(xb_ld(&bar[XB_TOPGEN]) == tg, bar);
            __builtin_amdgcn_fence(__ATOMIC_ACQUIRE, "agent");
            xb_add(&bar[XB_XGEN(b.x)], 1u);
            asm volatile("s_waitcnt vmcnt(0)" ::: "memory");
        } else {
            XB_SPIN(xb_ld(&bar[XB_XGEN(b.x)]) == gen, bar);
            __builtin_amdgcn_fence(__ATOMIC_ACQUIRE, "agent");
            asm volatile("s_waitcnt vmcnt(0)" ::: "memory");
        }
    }
    __syncthreads();
}

struct Args { const float* in[25]; float* out; unsigned char* ws; int ph_lo, ph_hi; };
struct Frame {
    LAS unsigned char* lds;
    int tid, lane, wave, vcu, G;
    const Args* a; float* out; unsigned char* ws;
};
enum { I_X = 0, I_N1W, I_WIN, I_ARE, I_AIM, I_LOGDT, I_BRE, I_BIM, I_CRE, I_CIM, I_D, I_WGLU, I_BGLU, I_PECK, I_WCK1, I_WCK2, I_PECV, I_WCV1, I_WCV2, I_WOUT, I_N2W, I_WUP, I_WDOWN, I_REL, I_NFW };

__device__ __forceinline__ void p0_transpose_item(const float* W, int K, int N, int Npad, bf16_t* WT, const float* scale, LAS float* scr, int item, int lane) {
    const int nblk = Npad / 64, kb = item / nblk, nb = item % nblk, k0 = 64 * kb, n0 = 64 * nb;
    const int rr = lane >> 4, cc = lane & 15, n = n0 + 4 * cc;
    f32x4 v[16];
#pragma unroll
    for (int i = 0; i < 16; ++i) { v[i] = (f32x4){0.f, 0.f, 0.f, 0.f}; if (n < N) v[i] = *(const f32x4*)(W + (size_t)(k0 + 4 * i + rr) * N + n); }
#pragma unroll
    for (int i = 0; i < 16; ++i) { const int kk = 4 * i + rr; f32x4 x = v[i]; if (scale) x = x * scale[k0 + kk];
        LAS float* d = scr + kk * 65 + 4 * cc; d[0] = x[0]; d[1] = x[1]; d[2] = x[2]; d[3] = x[3]; }
    LDS_WAIT();
    const int c = lane & 7;
#pragma unroll
    for (int j = 0; j < 8; ++j) { const int nn = (lane >> 3) + 8 * j; const LAS float* s = scr + (8 * c) * 65 + nn;
        u32x4 o; o.x = pk2(s[0 * 65], s[1 * 65]); o.y = pk2(s[2 * 65], s[3 * 65]); o.z = pk2(s[4 * 65], s[5 * 65]); o.w = pk2(s[6 * 65], s[7 * 65]);
        *(u32x4*)(WT + (size_t)(n0 + nn) * K + k0 + 8 * c) = o; }
    LDS_WAIT();
}
__device__ __forceinline__ void tr_load(const float* W, int N, int nblk, int item, int lane, f32x4 (&v)[16]) {
    const int kb = item / nblk, nb = item % nblk; const float* p = W + (size_t)(64 * kb + (lane >> 4)) * N + 64 * nb + 4 * (lane & 15);
#pragma unroll
    for (int i = 0; i < 16; ++i) v[i] = *(const f32x4*)(p + (size_t)(4 * i) * N);
}
__device__ __forceinline__ void tr_store(int K, int nblk, bf16_t* WT, const float* scale, LAS float* scr, int item, int lane, const f32x4 (&v)[16]) {
    const int kb = item / nblk, nb = item % nblk, k0 = 64 * kb, n0 = 64 * nb, rr = lane >> 4, cc = lane & 15;
#pragma unroll
    for (int i = 0; i < 16; ++i) { const int kk = 4 * i + rr; f32x4 x = v[i]; if (scale) x = x * scale[k0 + kk];
        LAS float* d = scr + kk * 65 + 4 * cc; d[0] = x[0]; d[1] = x[1]; d[2] = x[2]; d[3] = x[3]; }
    LDS_WAIT();
    const int c = lane & 7;
#pragma unroll
    for (int j = 0; j < 8; ++j) { const int nn = (lane >> 3) + 8 * j; const LAS float* s = scr + (8 * c) * 65 + nn;
        u32x4 o; o.x = pk2(s[0 * 65], s[1 * 65]); o.y = pk2(s[2 * 65], s[3 * 65]); o.z = pk2(s[4 * 65], s[5 * 65]); o.w = pk2(s[6 * 65], s[7 * 65]);
        *(u32x4*)(WT + (size_t)(n0 + nn) * K + k0 + 8 * c) = o; }
    LDS_WAIT();
}
__device__ __forceinline__ void tr_pipe(const float* W, int K, int N, bf16_t* WT, const float* scale, LAS float* scr, int first, int end, int stride, int lane) {
    if (first >= end) return;
    const int nblk = N / 64;
    f32x4 va[16], vb[16];
    int it0 = first;
    tr_load(W, N, nblk, it0, lane, va);
    for (;;) {
        const int it1 = it0 + stride; const bool h1 = it1 < end;
        tr_load(W, N, nblk, h1 ? it1 : first, lane, vb);
        tr_store(K, nblk, WT, scale, scr, it0, lane, va);
        if (!h1) break;
        it0 = it1 + stride; const bool h0 = it0 < end;
        tr_load(W, N, nblk, h0 ? it0 : first, lane, va);
        tr_store(K, nblk, WT, scale, scr, it1, lane, vb);
        if (!h0) break;
    }
}
__device__ __forceinline__ int tr_first(int g2, int n2, int off) { const int d = (g2 - off) % n2; return d < 0 ? d + n2 : d; }
__device__ __forceinline__ void late_transposes(Frame& F, int part) {
    LAS float* scr = (LAS float*)(F.lds + F.wave * 16896);
    const int gw = F.vcu * NWAVES + F.wave, NGW = F.G * NWAVES, lane = F.lane;
    unsigned char* ws = F.ws;
    constexpr int T_GLU = (1024 / 64) * (1024 / 64), T_OUT = (DM / 64) * (DM / 64), T_UP = (DM / 64) * (DFF / 64), T_DOWN = (DFF / 64) * (DM / 64);
    if (part == 0) {
        int g2 = gw, n2 = NGW;
        if (F.G > 64) { if (blockIdx.x < 32) return; g2 = ((int)blockIdx.x - 32) * NWAVES + F.wave; n2 = (F.G - 32) * NWAVES; }
        tr_pipe(F.a->in[I_WDOWN], DFF, DM, (bf16_t*)(ws + WS_WDOWN), nullptr, scr, tr_first(g2, n2, 0), T_DOWN, n2, lane);
        tr_pipe(F.a->in[I_WOUT], DM, DM, (bf16_t*)(ws + WS_WOUT), nullptr, scr, tr_first(g2, n2, T_DOWN), T_OUT, n2, lane);
        tr_pipe(F.a->in[I_WGLU], 1024, 1024, (bf16_t*)(ws + WS_WGLU), nullptr, scr, tr_first(g2, n2, T_DOWN + T_OUT), T_GLU, n2, lane);
    } else {
        int g2 = gw, n2 = NGW;
        const int nwg = (MTOK / 256) * (NPROJ / 256), r = nwg % F.G;
        if (r != 0 && F.G - r >= 8) { if ((int)blockIdx.x < r) return; g2 = ((int)blockIdx.x - r) * NWAVES + F.wave; n2 = (F.G - r) * NWAVES; }
        tr_pipe(F.a->in[I_WUP], DM, DFF, (bf16_t*)(ws + WS_WUP), F.a->in[I_N2W], scr, g2, T_UP, n2, lane);
    }
}
__device__ __forceinline__ void p0_prologue(Frame& F) {
    LAS float* scr = (LAS float*)(F.lds + F.wave * 16896);
    const int gw = F.vcu * NWAVES + F.wave, NGW = F.G * NWAVES, lane = F.lane;
    unsigned char* ws = F.ws;
    constexpr int T_IN = (DM / 64) * (NPROJ / 64), T_C1 = (2048 / 64) * (256 / 64), T_C2 = (256 / 64) * (64 / 64);
    constexpr int NITEMS = T_IN + 2 * T_C1 + 2 * T_C2;
    for (int it = gw; it < NITEMS; it += NGW) {
        int r = it;
        if (r < T_IN) { p0_transpose_item(F.a->in[I_WIN], DM, D_IN, NPROJ, (bf16_t*)(ws + WS_WIN), F.a->in[I_N1W], scr, r, lane); continue; } r -= T_IN;
        if (r < T_C1) { p0_transpose_item(F.a->in[I_WCK1], 2048, 256, 256, (bf16_t*)(ws + WS_WC1K), nullptr, scr, r, lane); continue; } r -= T_C1;
        if (r < T_C1) { p0_transpose_item(F.a->in[I_WCV1], 2048, 256, 256, (bf16_t*)(ws + WS_WC1V), nullptr, scr, r, lane); continue; } r -= T_C1;
        if (r < T_C2) { p0_transpose_item(F.a->in[I_WCK2], 256, 64, 64, (bf16_t*)(ws + WS_WC2K), nullptr, scr, r, lane); continue; } r -= T_C2;
        p0_transpose_item(F.a->in[I_WCV2], 256, 64, 64, (bf16_t*)(ws + WS_WC2V), nullptr, scr, r, lane);
    }
    {
        const float* x = F.a->in[I_X]; bf16_t* xb = (bf16_t*)(ws + WS_XB); float* r1 = (float*)(ws + WS_R1);
        for (int mrow = gw; mrow < MTOK; mrow += NGW) {
            const f32x4* xr = (const f32x4*)(x + (size_t)mrow * DM) + lane; u32x2* o8 = (u32x2*)(xb + (size_t)mrow * DM) + lane;
            f32x4 v[8]; float s = 0.f;
#pragma unroll
            for (int j = 0; j < 8; ++j) { v[j] = xr[64 * j]; s += (v[j].x * v[j].x + v[j].y * v[j].y) + (v[j].z * v[j].z + v[j].w * v[j].w); }
            s = wave_sum(s);
#pragma unroll
            for (int j = 0; j < 8; ++j) { u32x2 w; w.x = pk2(v[j].x, v[j].y); w.y = pk2(v[j].z, v[j].w); o8[64 * j] = w; }
            if (lane == 0) r1[mrow] = __builtin_amdgcn_rsqf(s * (1.f / DM) + EPS);
        }
    }
    {
        const int idx = gw * 64 + lane;
        if (idx < 4096) {
            const int g = idx >> 6;
            const float dt = expf(F.a->in[I_LOGDT][g]); const float ar = F.a->in[I_ARE][idx], ai = F.a->in[I_AIM][idx];
            const float em1 = expm1f(dt * ar), th = dt * ai, c = cosf(th), s = sinf(th), sh = sinf(0.5f * th);
            const float mag = em1 + 1.f, abr = mag * c, abi = mag * s;
            const float zr = em1 * c - 2.f * sh * sh, zi = abi;
            const float den = ar * ar + ai * ai;
            const float cr = (zr * ar + zi * ai) / den, ci = (zi * ar - zr * ai) / den;
            const float magS = expf(512.f * dt * ar), thS = 512.f * th;
            f32x4 ab; ab.x = abr; ab.y = abi; ab.z = magS * cosf(thS); ab.w = magS * sinf(thS);
            ((f32x4*)(ws + WS_S5AB))[idx] = ab;
            bf16_t* bre = (bf16_t*)(ws + WS_BRE) + (size_t)idx * 16; bf16_t* bim = (bf16_t*)(ws + WS_BIM) + (size_t)idx * 16;
            const float* sbr = F.a->in[I_BRE] + (size_t)idx * 16; const float* sbi = F.a->in[I_BIM] + (size_t)idx * 16;
#pragma unroll
            for (int h = 0; h < 16; ++h) { const float br = sbr[h], bi = sbi[h]; bre[h] = (bf16_t)f2bf(cr * br - ci * bi); bim[h] = (bf16_t)f2bf(cr * bi + ci * br); }
        }
        const int i2 = gw * 64 + lane;
        if (i2 < 64 * 16 * 64) { bf16_t* cm = (bf16_t*)(ws + WS_CM); ((unsigned*)cm)[i2] = pk2(F.a->in[I_CRE][i2], -F.a->in[I_CIM][i2]); }
        if (i2 < 2048) { const int h = i2 >> 7, d = i2 & 127; ((float*)(ws + WS_BTAB))[i2] = F.a->in[I_REL][(int)T5B[d] * 16 + h] * LOG2E; }
    }
    for (int it = gw; it < 2 * 32 * 4; it += NGW) {
        const int which = it >> 7, ks = (it >> 2) & 31, jg = it & 3;
        const float* pe = F.a->in[which ? I_PECV : I_PECK] + ks * 64; const float* w1 = F.a->in[which ? I_WCV1 : I_WCK1] + (size_t)(ks * 64) * 256 + jg * 64 + lane;
        float a = 0.f;
#pragma unroll 16
        for (int k = 0; k < 64; ++k) a += pe[k] * w1[(size_t)k * 256];
        ((float*)(ws + WS_CBP))[(which * 32 + ks) * 256 + jg * 64 + lane] = a;
    }
    for (int idx = gw * 64 + lane; idx < MTOK; idx += NGW * 64) { ((float*)(ws + CTL_SS1))[idx] = 0.f; ((float*)(ws + CTL_SS2))[idx] = 0.f; }
    if (gw == 0 && lane < 32) ((unsigned*)(ws + CTL_KMAX))[lane] = 0u;
}
__device__ __forceinline__ void cmp_bias_reduce(Frame& F) {
    if (blockIdx.x != 0) return;
    const float* p = (const float*)(F.ws + WS_CBP); float* o = (float*)(F.ws + WS_CBF);
    const int which = F.tid >> 8, col = F.tid & 255; float a = 0.f;
    for (int ks = 0; ks < 32; ++ks) a += p[(which * 32 + ks) * 256 + col];
    o[which * 256 + col] = a;
}

template <bool FINAL>
__device__ __forceinline__ void s5_item(Frame& F, int b, int g, int seg) {
    const int lane = F.lane, pp = lane & 31, hi = lane >> 5;
    unsigned char* ws = F.ws;
    LAS unsigned char* L = F.lds + F.wave * 16896;
    const bf16_t* proj = (const bf16_t*)(ws + WS_PROJ);
    const f32x4 ab = ((const f32x4*)(ws + WS_S5AB))[g * 64 + lane];
    const float ar = ab.x, ai = ab.y;
    const bf16_t* bre = (const bf16_t*)(ws + WS_BRE) + (size_t)g * 64 * 16; const bf16_t* bim = (const bf16_t*)(ws + WS_BIM) + (size_t)g * 64 * 16;
    const bf16x8 bre0 = *(const bf16x8*)(bre + pp * 16 + 8 * hi), bre1 = *(const bf16x8*)(bre + (32 + pp) * 16 + 8 * hi);
    const bf16x8 bim0 = *(const bf16x8*)(bim + pp * 16 + 8 * hi), bim1 = *(const bf16x8*)(bim + (32 + pp) * 16 + 8 * hi);
    f32x2* segend = (f32x2*)(ws + WS_SEG) + (size_t)((b * 64 + g) * 8) * 64;
    float sr = 0.f, si = 0.f;
    bf16x8 cf[4]; f32x4 dv = {0.f, 0.f, 0.f, 0.f};
    if (FINAL) {
        for (int s2 = 0; s2 < seg; ++s2) { const f32x2 e = segend[s2 * 64 + lane]; const float nr = ab.z * sr - ab.w * si + e.x, ni = ab.z * si + ab.w * sr + e.y; sr = nr; si = ni; }
        const bf16_t* cm = (const bf16_t*)(ws + WS_CM) + (size_t)(g * 16 + (lane & 15)) * 128 + 8 * (lane >> 4);
#pragma unroll
        for (int ks = 0; ks < 4; ++ks) cf[ks] = *(const bf16x8*)(cm + 32 * ks);
        dv = *(const f32x4*)(F.a->in[I_D] + g * 16 + 4 * (lane >> 4));
    }
    bf16_t* zb = (bf16_t*)(ws + WS_Z);
    const bf16_t* up = proj + ((size_t)b * SEQ + seg * 512 + pp) * NPROJ + COL_U + g * 16 + 8 * hi;
    asm volatile("" :: "v"(bre0), "v"(bre1), "v"(bim0), "v"(bim1), "v"(ab));
    if (FINAL) asm volatile("" :: "v"(cf[0]), "v"(cf[1]), "v"(cf[2]), "v"(cf[3]), "v"(dv));
    const bf16_t* up2 = proj + ((size_t)b * SEQ + seg * 512 + (lane & 15)) * NPROJ + COL_U + g * 16 + 4 * (lane >> 4);
    u32x2 uu_next0 = {0u, 0u}, uu_next1 = {0u, 0u};
    if (FINAL) { uu_next0 = *(const u32x2*)up2; uu_next1 = *(const u32x2*)(up2 + (size_t)16 * NPROJ); }
    bf16x8 ua_next = *(const bf16x8*)up;
    for (int ch = 0; ch < 16; ++ch) {
        const size_t row0 = (size_t)b * SEQ + seg * 512 + ch * 32;
        const bf16x8 ua = ua_next;
        ua_next = *(const bf16x8*)(up + (size_t)(ch < 15 ? ch + 1 : 15) * 32 * NPROJ);
        const u32x2 uu_cur[2] = {uu_next0, uu_next1};
        if (FINAL) { const bf16_t* q2 = up2 + (size_t)(ch < 15 ? ch + 1 : 15) * 32 * NPROJ; uu_next0 = *(const u32x2*)q2; uu_next1 = *(const u32x2*)(q2 + (size_t)16 * NPROJ); }
        const f32x16 z16 = {};
        const f32x16 re0 = __builtin_amdgcn_mfma_f32_32x32x16_bf16(ua, bre0, z16, 0, 0, 0), im0 = __builtin_amdgcn_mfma_f32_32x32x16_bf16(ua, bim0, z16, 0, 0, 0);
        const f32x16 re1 = __builtin_amdgcn_mfma_f32_32x32x16_bf16(ua, bre1, z16, 0, 0, 0), im1 = __builtin_amdgcn_mfma_f32_32x32x16_bf16(ua, bim1, z16, 0, 0, 0);
#pragma unroll
        for (int r = 0; r < 16; ++r) { const int t = crow(r, hi);
            *(LAS f32x2*)(L + t * 528 + 8 * pp) = (f32x2){re0[r], im0[r]};
            *(LAS f32x2*)(L + t * 528 + 8 * (32 + pp)) = (f32x2){re1[r], im1[r]}; }
        LDS_WAIT();
#pragma unroll 8
        for (int t = 0; t < 32; ++t) {
            const f32x2 xv = *(const LAS f32x2*)(L + t * 528 + 8 * lane);
            const float nr = ar * sr - ai * si + xv.x, ni = ar * si + ai * sr + xv.y; sr = nr; si = ni;
            if (FINAL) *(LAS unsigned*)(L + t * 528 + 4 * lane) = pk2(sr, si);
        }
        if (FINAL) {
            LDS_WAIT();
#pragma unroll
            for (int tt = 0; tt < 2; ++tt) {
                f32x4 acc = {0.f, 0.f, 0.f, 0.f};
#pragma unroll
                for (int ks = 0; ks < 4; ++ks) { const bf16x8 sb = *(const LAS bf16x8*)(L + (16 * tt + (lane & 15)) * 528 + (32 * ks + 8 * (lane >> 4)) * 2);
                    acc = __builtin_amdgcn_mfma_f32_16x16x32_bf16(cf[ks], sb, acc, 0, 0, 0); }
                const size_t row = row0 + 16 * tt + (lane & 15);
                const u32x2 uu = uu_cur[tt];
                const float y0 = acc[0] + dv[0] * bflo(uu.x), y1 = acc[1] + dv[1] * bfhi(uu.x), y2 = acc[2] + dv[2] * bflo(uu.y), y3 = acc[3] + dv[3] * bfhi(uu.y);
                u32x2 w; w.x = pk2(gelu_tanh(y0), gelu_tanh(y1)); w.y = pk2(gelu_tanh(y2), gelu_tanh(y3));
                *(u32x2*)(zb + row * 1024 + g * 16 + 4 * (lane >> 4)) = w;
            }
        }
        LDS_WAIT();
    }
    if (!FINAL) segend[seg * 64 + lane] = (f32x2){sr, si};
}
__device__ __forceinline__ void cmul(float& cr, float& ci, float ar, float ai, float br, float bi) { cr = ar * br - ai * bi; ci = ar * bi + ai * br; }
__device__ __forceinline__ void s5_pass1_item(Frame& F, int b, int g, int seg) {
    const int lane = F.lane, pp = lane & 31, hi = lane >> 5;
    unsigned char* ws = F.ws;
    const bf16_t* proj = (const bf16_t*)(ws + WS_PROJ);
    const bf16_t* bre = (const bf16_t*)(ws + WS_BRE) + (size_t)g * 64 * 16; const bf16_t* bim = (const bf16_t*)(ws + WS_BIM) + (size_t)g * 64 * 16;
    const bf16x8 bre0 = *(const bf16x8*)(bre + pp * 16 + 8 * hi), bre1 = *(const bf16x8*)(bre + (32 + pp) * 16 + 8 * hi);
    const bf16x8 bim0 = *(const bf16x8*)(bim + pp * 16 + 8 * hi), bim1 = *(const bf16x8*)(bim + (32 + pp) * 16 + 8 * hi);
    float wr[2][16], wi[2][16], a32r[2], a32i[2];
#pragma unroll
    for (int T = 0; T < 2; ++T) {
        const f32x4 ab = ((const f32x4*)(ws + WS_S5AB))[g * 64 + 32 * T + pp];
        float pr[4], pi[4];
        pr[0] = 1.f; pi[0] = 0.f; pr[1] = ab.x; pi[1] = ab.y; cmul(pr[2], pi[2], ab.x, ab.y, ab.x, ab.y); cmul(pr[3], pi[3], pr[2], pi[2], ab.x, ab.y);
        float q4r, q4i, q8r, q8i, q16r, q16i, q24r, q24i;
        cmul(q4r, q4i, pr[2], pi[2], pr[2], pi[2]); cmul(q8r, q8i, q4r, q4i, q4r, q4i); cmul(q16r, q16i, q8r, q8i, q8r, q8i); cmul(q24r, q24i, q16r, q16i, q8r, q8i);
        const float fr = hi ? 1.f : q4r, fi = hi ? 0.f : q4i;
        const float br_[4] = {1.f, q8r, q16r, q24r}, bi_[4] = {0.f, q8i, q16i, q24i};
#pragma unroll
        for (int r = 0; r < 16; ++r) {
            float tr, ti; cmul(tr, ti, br_[3 - (r >> 2)], bi_[3 - (r >> 2)], pr[3 - (r & 3)], pi[3 - (r & 3)]);
            cmul(wr[T][r], wi[T][r], tr, ti, fr, fi);
        }
        float t28r, t28i; cmul(t28r, t28i, q24r, q24i, q4r, q4i); cmul(a32r[T], a32i[T], t28r, t28i, q4r, q4i);
    }
    float sr[2] = {0.f, 0.f}, si[2] = {0.f, 0.f};
    const bf16_t* up = proj + ((size_t)b * SEQ + seg * 512 + pp) * NPROJ + COL_U + g * 16 + 8 * hi;
    asm volatile("" :: "v"(bre0), "v"(bre1), "v"(bim0), "v"(bim1));
    bf16x8 ua_next = *(const bf16x8*)up;
    for (int ch = 0; ch < 16; ++ch) {
        const bf16x8 ua = ua_next;
        ua_next = *(const bf16x8*)(up + (size_t)(ch < 15 ? ch + 1 : 15) * 32 * NPROJ);
        const f32x16 z16 = {};
        const f32x16 re0 = __builtin_amdgcn_mfma_f32_32x32x16_bf16(ua, bre0, z16, 0, 0, 0), im0 = __builtin_amdgcn_mfma_f32_32x32x16_bf16(ua, bim0, z16, 0, 0, 0);
        const f32x16 re1 = __builtin_amdgcn_mfma_f32_32x32x16_bf16(ua, bre1, z16, 0, 0, 0), im1 = __builtin_amdgcn_mfma_f32_32x32x16_bf16(ua, bim1, z16, 0, 0, 0);
        float e0r = 0.f, e0i = 0.f, e1r = 0.f, e1i = 0.f;
#pragma unroll
        for (int r = 0; r < 16; ++r) {
            e0r += wr[0][r] * re0[r] - wi[0][r] * im0[r]; e0i += wr[0][r] * im0[r] + wi[0][r] * re0[r];
            e1r += wr[1][r] * re1[r] - wi[1][r] * im1[r]; e1i += wr[1][r] * im1[r] + wi[1][r] * re1[r];
        }
        e0r = pair_sum(e0r); e0i = pair_sum(e0i); e1r = pair_sum(e1r); e1i = pair_sum(e1i);
        float nr, ni;
        cmul(nr, ni, a32r[0], a32i[0], sr[0], si[0]); sr[0] = nr + e0r; si[0] = ni + e0i;
        cmul(nr, ni, a32r[1], a32i[1], sr[1], si[1]); sr[1] = nr + e1r; si[1] = ni + e1i;
    }
    f32x2* segend = (f32x2*)(ws + WS_SEG) + (size_t)((b * 64 + g) * 8) * 64;
    segend[seg * 64 + 32 * hi + pp] = hi ? (f32x2){sr[1], si[1]} : (f32x2){sr[0], si[0]};
}
template <bool FINAL> __device__ __forceinline__ void s5_phase(Frame& F) {
    int gw = F.vcu * NWAVES + F.wave, NGW = F.G * NWAVES;
    if (!FINAL && F.G > 64) { if (blockIdx.x < 32) return; gw = ((int)blockIdx.x - 32) * NWAVES + F.wave; NGW = (F.G - 32) * NWAVES; }
    for (int it = gw; it < BATCH * 64 * 8; it += NGW) { const int g = it & 63, bs = it >> 6; if (FINAL) s5_item<true>(F, bs >> 3, g, bs & 7); else s5_pass1_item(F, bs >> 3, g, bs & 7); }
}

__device__ __forceinline__ void cmp2_phase(Frame& F) {
    const int gw = F.vcu * NWAVES + F.wave, NGW = F.G * NWAVES, lane = F.lane, pp = lane & 31, hi = lane >> 5;
    unsigned char* ws = F.ws;
    for (int it = gw; it < 256; it += NGW) {
        const int which = it >> 7, rt = it & 127;
        const bf16_t* Hc = (const bf16_t*)(ws + WS_HC) + (size_t)which * 4096 * 256 + (size_t)(32 * rt + pp) * 256 + 8 * hi;
        const bf16_t* W2 = (const bf16_t*)(ws + (which ? WS_WC2V : WS_WC2K)) + (size_t)pp * 256 + 8 * hi;
        bf16_t* O = (bf16_t*)(ws + (which ? WS_VCMP : WS_KCMP));
        f32x16 a0 = {}, a1 = {};
#pragma unroll 4
        for (int ks = 0; ks < 16; ++ks) { const bf16x8 a = *(const bf16x8*)(Hc + 16 * ks), b0 = *(const bf16x8*)(W2 + 16 * ks), b1 = *(const bf16x8*)(W2 + 32 * 256 + 16 * ks);
            a0 = __builtin_amdgcn_mfma_f32_32x32x16_bf16(a, b0, a0, 0, 0, 0); a1 = __builtin_amdgcn_mfma_f32_32x32x16_bf16(a, b1, a1, 0, 0, 0); }
        if (which == 0) {
#pragma unroll
            for (int r = 0; r < 16; ++r) { const int row = 32 * rt + crow(r, hi); const bool zero = (row & 255) == 255;
                O[(size_t)row * 64 + pp] = zero ? (bf16_t)0 : (bf16_t)f2bf(a0[r]); O[(size_t)row * 64 + 32 + pp] = zero ? (bf16_t)0 : (bf16_t)f2bf(a1[r]); }
        } else {
            bf16_t* OT = (bf16_t*)(ws + WS_VCT);
#pragma unroll
            for (int c = 0; c < 4; ++c) { const int row = 32 * rt + 8 * c + 4 * hi; const int bgx = row >> 8, n = row & 255;
                float x0[4], x1[4];
#pragma unroll
                for (int e = 0; e < 4; ++e) { const bool zero = (n + e) == 255; x0[e] = zero ? 0.f : a0[4 * c + e]; x1[e] = zero ? 0.f : a1[4 * c + e]; }
                *(u32x2*)(OT + ((size_t)bgx * 64 + pp) * 256 + n) = (u32x2){pk2(x0[0], x0[1]), pk2(x0[2], x0[3])};
                *(u32x2*)(OT + ((size_t)bgx * 64 + 32 + pp) * 256 + n) = (u32x2){pk2(x1[0], x1[1]), pk2(x1[2], x1[3])}; }
        }
    }
}

__device__ __forceinline__ void knorm_phase(Frame& F) {
    int gw = F.vcu * NWAVES + F.wave, NGW = F.G * NWAVES; const int lane = F.lane;
    if (F.G > 64) { if (blockIdx.x < 32) return; gw = ((int)blockIdx.x - 32) * NWAVES + F.wave; NGW = (F.G - 32) * NWAVES; }
    const bf16_t* proj = (const bf16_t*)(F.ws + WS_PROJ);
    for (int it = gw; it < 2 * 16 * 64; it += NGW) {
        const int tensor = it >> 10, bg = (it >> 6) & 15, tb = it & 63;
        const u32x4* p = (const u32x4*)(proj + ((size_t)(bg >> 2) * SEQ + tb * 64 + lane) * NPROJ + (tensor ? COL_KW : COL_KS) + (bg & 3) * 64);
        float ss = 0.f;
#pragma unroll
        for (int k = 0; k < 8; ++k) { const u32x4 w = p[k]; const unsigned ww[4] = {w.x, w.y, w.z, w.w};
#pragma unroll
            for (int e = 0; e < 4; ++e) { const float a = bflo(ww[e]), b2 = bfhi(ww[e]); ss += a * a + b2 * b2; } }
#pragma unroll
        for (int o = 1; o < 64; o <<= 1) ss = fmaxf(ss, __shfl_xor(ss, o));
        if (lane == 0) atomicMax((unsigned*)(F.ws + CTL_KMAX) + tensor * 16 + bg, __builtin_bit_cast(unsigned, ss));
    }
}

namespace att {
constexpr int KSTR = 144, VSTR = 136, KVB = 64 * KSTR + 64 * VSTR;
constexpr int BIAS_OFF = 2 * KVB, WSCR_OFF = BIAS_OFF + 2048, IMP_OFF = WSCR_OFF + 8 * 256, SEL_OFF = IMP_OFF + 64 * 65 * 4, OT_OFF = SEL_OFF + 512, OT_STR = 68, OT_WAVE = 32 * OT_STR * 4, TAB2_OFF = OT_OFF + 8 * OT_WAVE, TAB2_N = 640, BMAX_OFF = TAB2_OFF + 4 * TAB2_N * 4  , END_OFF = BMAX_OFF + 64;
static_assert(END_OFF <= MISC_OFF, "attention LDS map");
constexpr float NEG = -1e30f;
enum { CMP_A = 0, CMP_B = 1, SLC = 2, WIN = 3 };
struct TileRegs { u32x4 k, v; };
struct Src { const bf16_t* k; size_t kstride; const bf16_t* vt; size_t vstride; };
struct Ctx {
    LAS unsigned char* lds; int tid, lane, wave, q, hi, tl, head, t, i;
    bf16x8 qr[4];
};
__device__ __forceinline__ void load_tile(TileRegs& R, const Src& S, int key0, int tid) {
    const unsigned r = (unsigned)tid >> 3, c = (unsigned)tid & 7u;
    const unsigned koff = (r * (unsigned)S.kstride + c * 8u) * 2u, voff = (r * (unsigned)S.vstride + c * 8u) * 2u;
    const char* kb = (const char*)S.k + (size_t)key0 * S.kstride * 2; const char* vb = (const char*)S.vt + (size_t)key0 * 2;
    R.k = *(const u32x4*)(kb + koff);
    R.v = *(const u32x4*)(vb + voff);
}
__device__ __forceinline__ void store_tile(const TileRegs& R, LAS unsigned char* lds, int buf, int tid) {
    const int r = tid >> 3, c = tid & 7;
    LAS unsigned char* b = lds + buf * KVB;
    *(LAS u32x4*)(b + r * KSTR + c * 16) = R.k;
    *(LAS u32x2*)(b + 64 * KSTR + r * VSTR + c * 16) = (u32x2){R.v.x, R.v.y};
    *(LAS u32x2*)(b + 64 * KSTR + r * VSTR + c * 16 + 8) = (u32x2){R.v.z, R.v.w};
}
__device__ __forceinline__ void qk_tile(f32x16& p0, f32x16& p1, const f32x16& cin, const Ctx& C, int buf) {
    const LAS unsigned char* kl = C.lds + buf * KVB + C.q * KSTR + 16 * C.hi;
    bf16x8 kf[8];
#pragma unroll
    for (int d0 = 0; d0 < 4; ++d0) { kf[2 * d0] = *(const LAS bf16x8*)(kl + 32 * d0); kf[2 * d0 + 1] = *(const LAS bf16x8*)(kl + 32 * KSTR + 32 * d0); }
    __builtin_amdgcn_sched_barrier(0);
    p0 = __builtin_amdgcn_mfma_f32_32x32x16_bf16(kf[0], C.qr[0], cin, 0, 0, 0); p1 = __builtin_amdgcn_mfma_f32_32x32x16_bf16(kf[1], C.qr[0], cin, 0, 0, 0);
#pragma unroll
    for (int d0 = 1; d0 < 4; ++d0) { p0 = __builtin_amdgcn_mfma_f32_32x32x16_bf16(kf[2 * d0], C.qr[d0], p0, 0, 0, 0); p1 = __builtin_amdgcn_mfma_f32_32x32x16_bf16(kf[2 * d0 + 1], C.qr[d0], p1, 0, 0, 0); }
}
template <int MODE> __device__ __forceinline__ void mask_bias(f32x16& p0, f32x16& p1, const Ctx& C, int kbase, bool sel) {
    const LAS float* bt = (const LAS float*)(C.lds + BIAS_OFF) + C.head * 128;
    const int d00 = (MODE == CMP_A || MODE == CMP_B) ? (C.t - 31 - 16 * (kbase + 4 * C.hi)) : (C.t - kbase - 4 * C.hi);
    float bv[2][16];
#pragma unroll
    for (int T = 0; T < 2; ++T)
#pragma unroll
        for (int r = 0; r < 16; ++r) {
            const int ko = 32 * T + (r & 3) + 8 * (r >> 2);
            const int dist = (MODE == CMP_A || MODE == CMP_B) ? (d00 - 16 * ko) : (d00 - ko);
            const int di = dist < 0 ? 0 : (dist > 127 ? 127 : dist);
            bv[T][r] = bt[di];
        }
    __builtin_amdgcn_sched_barrier(0);
#pragma unroll
    for (int T = 0; T < 2; ++T)
#pragma unroll
        for (int r = 0; r < 16; ++r) {
            const int ko = 32 * T + (r & 3) + 8 * (r >> 2);
            const int dist = (MODE == CMP_A || MODE == CMP_B) ? (d00 - 16 * ko) : (d00 - ko);
            bool valid = dist >= 0; if (MODE == WIN) valid = valid && dist < 512; if (MODE == SLC) valid = valid && sel;
            if (T == 0) p0[r] = valid ? p0[r] + bv[T][r] : NEG; else p1[r] = valid ? p1[r] + bv[T][r] : NEG;
        }
}
__device__ __forceinline__ void mask_bias2(f32x16& p0, f32x16& p1, const Ctx& C, int kbase) {
    const int d00 = C.t - kbase - 4 * C.hi;
    const LAS float* bp = (const LAS float*)(C.lds + TAB2_OFF) + C.head * TAB2_N + (d00 + 4);
#pragma unroll
    for (int T = 0; T < 2; ++T) {
        float bv[16];
#pragma unroll
        for (int r = 0; r < 16; ++r) bv[r] = bp[59 - (32 * T + (r & 3) + 8 * (r >> 2))];
        __builtin_amdgcn_sched_barrier(0);
#pragma unroll
        for (int r = 0; r < 16; ++r) { if (T == 0) p0[r] += bv[r]; else p1[r] += bv[r]; }
        __builtin_amdgcn_sched_barrier(0);
    }
}
__device__ __forceinline__ float quad_sum(float v) {
    v += __builtin_bit_cast(float, __builtin_amdgcn_mov_dpp(__builtin_bit_cast(int, v), 0xB1, 0xF, 0xF, true));
    v += __builtin_bit_cast(float, __builtin_amdgcn_mov_dpp(__builtin_bit_cast(int, v), 0x4E, 0xF, 0xF, true));
    return v;
}
__device__ __forceinline__ float tile_max(const f32x16& p0, const f32x16& p1) {
    float a = fmaxf(fmaxf(p0[0], p1[0]), p0[1]), b = fmaxf(fmaxf(p1[1], p0[2]), p1[2]);
#pragma unroll
    for (int r = 3; r < 15; r += 2) { a = fmaxf(fmaxf(a, p0[r]), p1[r]); b = fmaxf(fmaxf(b, p0[r + 1]), p1[r + 1]); }
    a = fmaxf(fmaxf(a, p0[15]), p1[15]);
    return pair_max(fmaxf(a, b));
}
__device__ __forceinline__ void v_load(bf16x8 (&vf)[8], const Ctx& C, int buf) {
    const LAS unsigned char* vl = C.lds + buf * KVB + 64 * KSTR + C.q * VSTR + 8 * C.hi;
#pragma unroll
    for (int db = 0; db < 2; ++db)
#pragma unroll
        for (int T = 0; T < 2; ++T)
#pragma unroll
            for (int s = 0; s < 2; ++s) {
                const LAS unsigned char* a = vl + db * 32 * VSTR + (32 * T + 16 * s) * 2;
                const u32x2 lo = *(const LAS u32x2*)a, hi2 = *(const LAS u32x2*)(a + 16);
                const u32x4 vv = {lo.x, lo.y, hi2.x, hi2.y};
                vf[db * 4 + T * 2 + s] = __builtin_bit_cast(bf16x8, vv);
            }
}
__device__ __forceinline__ void pv_mma(f32x16 (&o)[2], const f32x16& p0, const f32x16& p1, const bf16x8 (&vf)[8]) {
    bf16x8 pa[2][2];
#pragma unroll
    for (int s = 0; s < 2; ++s) {
        u32x4 w0, w1;
        w0.x = pk2(p0[8 * s + 0], p0[8 * s + 1]); w0.y = pk2(p0[8 * s + 2], p0[8 * s + 3]); w0.z = pk2(p0[8 * s + 4], p0[8 * s + 5]); w0.w = pk2(p0[8 * s + 6], p0[8 * s + 7]);
        w1.x = pk2(p1[8 * s + 0], p1[8 * s + 1]); w1.y = pk2(p1[8 * s + 2], p1[8 * s + 3]); w1.z = pk2(p1[8 * s + 4], p1[8 * s + 5]); w1.w = pk2(p1[8 * s + 6], p1[8 * s + 7]);
        pa[0][s] = __builtin_bit_cast(bf16x8, w0); pa[1][s] = __builtin_bit_cast(bf16x8, w1);
    }
#pragma unroll
    for (int T = 0; T < 2; ++T)
#pragma unroll
        for (int s = 0; s < 2; ++s)
#pragma unroll
            for (int db = 0; db < 2; ++db) o[db] = __builtin_amdgcn_mfma_f32_32x32x16_bf16(pa[T][s], vf[db * 4 + T * 2 + s], o[db], 0, 0, 0);
}
__device__ __forceinline__ void row_scale(f32x16 (&o)[2], float fq_, const Ctx& C) {
    LAS float* wsc = (LAS float*)(C.lds + WSCR_OFF + C.wave * 256);
    wsc[C.q] = fq_; LDS_WAIT();
#pragma unroll
    for (int r = 0; r < 16; ++r) { const float f = wsc[crow(r, C.hi)]; o[0][r] *= f; o[1][r] *= f; }
    LDS_WAIT();
}
template <bool FIRST> __device__ __forceinline__ void row_fma(const f32x16 (&o)[2], float fq_, const Ctx& C) {
    LAS float* wsc = (LAS float*)(C.lds + WSCR_OFF + C.wave * 256);
    LAS float* otl = (LAS float*)(C.lds + OT_OFF + C.wave * OT_WAVE) + C.q;
    wsc[C.q] = fq_; LDS_WAIT();
#pragma unroll
    for (int r = 0; r < 16; ++r) { const int row = crow(r, C.hi); const float f = wsc[row];
        if (FIRST) { otl[row * OT_STR] = o[0][r] * f; otl[row * OT_STR + 32] = o[1][r] * f; }
        else { otl[row * OT_STR] += o[0][r] * f; otl[row * OT_STR + 32] += o[1][r] * f; } }
    LDS_WAIT();
}

template <int MODE>
__device__ __forceinline__ void branch(const Ctx& C, const Src& S, int jlo, int jhi, const f32x16& negm, const float m, float& l, f32x16 (&o)[2], float inv_l, unsigned sel_lo, unsigned sel_hi) {
    TileRegs R; load_tile(R, S, 64 * jlo, C.tid);
    const float far_bias = ((const LAS float*)(C.lds + BIAS_OFF))[C.head * 128 + 127];
    store_tile(R, C.lds, 0, C.tid);
    __syncthreads();
    if (jlo + 1 <= jhi) load_tile(R, S, 64 * (jlo + 1), C.tid);
#pragma unroll 1
    for (int j = jlo; j <= jhi; ++j) {
        const int buf = (j - jlo) & 1;
        f32x16 p0, p1;
        const bool cfar = (MODE == CMP_A || MODE == CMP_B) && (1024 * j + 1167 <= 64 * C.i);
        if (MODE == CMP_A) {
            f32x16 cin;
#pragma unroll
            for (int r = 0; r < 16; ++r) cin[r] = cfar ? far_bias - m : -m;
            qk_tile(p0, p1, cin, C, buf);
            if (!cfar) mask_bias<MODE>(p0, p1, C, 64 * j, true);
            float s = 0.f;
#pragma unroll
            for (int r = 0; r < 16; ++r) s += fexp2(p0[r]) + fexp2(p1[r]);
            l += s;
        } else if (MODE == CMP_B) {
            f32x16 cin;
#pragma unroll
            for (int r = 0; r < 16; ++r) cin[r] = cfar ? far_bias - m : -m;
            qk_tile(p0, p1, cin, C, buf);
            bf16x8 vf[8]; v_load(vf, C, buf);
            if (!cfar) mask_bias<MODE>(p0, p1, C, 64 * j, true);
#pragma unroll
            for (int r = 0; r < 16; ++r) { p0[r] = fexp2(p0[r]) * inv_l; p1[r] = fexp2(p1[r]) * inv_l; }
            LAS float* imp = (LAS float*)(C.lds + IMP_OFF) + C.tl * 65;
#pragma unroll
            for (int T = 0; T < 2; ++T)
#pragma unroll
                for (int c = 0; c < 4; ++c) {
                    const float e0 = T ? p1[4 * c] : p0[4 * c], e1 = T ? p1[4 * c + 1] : p0[4 * c + 1], e2 = T ? p1[4 * c + 2] : p0[4 * c + 2], e3 = T ? p1[4 * c + 3] : p0[4 * c + 3];
                    float mainv = (e0 + e1) + (e2 + 0.5f * e3), carry = 0.5f * e3;
                    mainv = quad_sum(mainv); carry = quad_sum(carry);
                    const int sb = 16 * j + 8 * T + 2 * c + C.hi;
                    if (C.head == 0) { (void)__hip_atomic_fetch_add(imp + sb, mainv, __ATOMIC_RELAXED, __HIP_MEMORY_SCOPE_WORKGROUP); if (sb + 1 < 64) (void)__hip_atomic_fetch_add(imp + sb + 1, carry, __ATOMIC_RELAXED, __HIP_MEMORY_SCOPE_WORKGROUP); }
                }
            pv_mma(o, p0, p1, vf);
        } else {
            const int delta = C.i - j;
            const bool sel = (MODE == SLC) ? (((j < 32 ? (sel_lo >> j) : (sel_hi >> (j - 32))) & 1u) != 0u) : true;
            if (MODE != SLC || __any(sel)) {
                const bool near = delta <= 2 || (MODE == WIN && delta >= 8);
                if (near) {
                    const float c = sel ? -m : NEG;
                    f32x16 cin;
#pragma unroll
                    for (int r = 0; r < 16; ++r) cin[r] = c;
                    qk_tile(p0, p1, cin, C, buf);
                    mask_bias2(p0, p1, C, 64 * j);
                } else if (MODE == SLC && !__all(sel)) {
                    f32x16 cin;
#pragma unroll
                    for (int r = 0; r < 16; ++r) cin[r] = sel ? negm[r] : NEG;
                    qk_tile(p0, p1, cin, C, buf);
                } else qk_tile(p0, p1, negm, C, buf);
                bf16x8 vf[8]; v_load(vf, C, buf);
                __builtin_amdgcn_sched_barrier(0);
                float s = 0.f;
#pragma unroll
                for (int r = 0; r < 16; ++r) { p0[r] = fexp2(p0[r]); p1[r] = fexp2(p1[r]); s += p0[r] + p1[r]; }
                l += s;
                pv_mma(o, p0, p1, vf);
            }
        }
        if (j < jhi) store_tile(R, C.lds, buf ^ 1, C.tid);
        __syncthreads();
        if (j + 2 <= jhi) load_tile(R, S, 64 * (j + 2), C.tid);
    }
}

__device__ __forceinline__ void attn_unit(Frame& F, int b, int g, int i, bool tables) {
    unsigned char* ws = F.ws;
    const bf16_t* proj = (const bf16_t*)(ws + WS_PROJ);
    int tid_ = threadIdx.x; asm volatile("" : "+v"(tid_));
    Ctx C; C.lds = F.lds; C.tid = tid_; C.lane = tid_ & 63; C.wave = F.wave; C.q = C.lane & 31; C.hi = C.lane >> 5; C.tl = 8 * F.wave + (C.q >> 2); C.head = C.q & 3; C.i = i; C.t = 64 * i + C.tl;
    const size_t row = (size_t)b * SEQ + C.t;
    const int hq = g * 4 + C.head;
#pragma unroll
    for (int d0 = 0; d0 < 4; ++d0) C.qr[d0] = *(const bf16x8*)(proj + row * NPROJ + COL_Q + hq * 64 + 16 * d0 + 8 * C.hi);
    float gate[3];
#pragma unroll
    for (int j = 0; j < 3; ++j) gate[j] = sigmoidf_(bf2f(proj[row * NPROJ + COL_GL + hq * 3 + j]));
    for (int idx = C.tid; idx < 64 * 65; idx += 512) ((LAS float*)(C.lds + IMP_OFF))[idx] = 0.f;
    if (tables) {
        ((LAS float*)(C.lds + BIAS_OFF))[C.tid] = ((const float*)(ws + WS_BTAB))[(g * 4 + (C.tid >> 7)) * 128 + (C.tid & 127)];
        for (int idx = C.tid; idx < 4 * TAB2_N; idx += 512) { const int h = idx / TAB2_N, d = idx % TAB2_N - 63;
            ((LAS float*)(C.lds + TAB2_OFF))[idx] = (d < 0 || d >= 512) ? NEG : ((const float*)(ws + WS_BTAB))[(g * 4 + h) * 128 + (d > 127 ? 127 : d)]; }
        {
            LAS float* bm = (LAS float*)(C.lds + BMAX_OFF);
            if (C.wave < 4) { const float* bt = (const float*)(ws + WS_BTAB) + (g * 4 + C.wave) * 128; float x = fmaxf(bt[C.lane], bt[64 + C.lane]);
#pragma unroll
                for (int o_ = 1; o_ < 64; o_ <<= 1) x = fmaxf(x, __shfl_xor(x, o_));
                if (C.lane == 0) bm[C.wave] = x; }
            const u32x4* kp = (const u32x4*)((const bf16_t*)(ws + WS_KCMP) + (size_t)((b * 4 + g) * 256 + (C.tid >> 1)) * 64 + (C.tid & 1) * 32);
            float ss = 0.f;
#pragma unroll
            for (int k = 0; k < 4; ++k) { const u32x4 w = kp[k]; const unsigned ww[4] = {w.x, w.y, w.z, w.w};
#pragma unroll
                for (int e = 0; e < 4; ++e) { const float a = bflo(ww[e]), b2 = bfhi(ww[e]); ss += a * a + b2 * b2; } }
            ss += __shfl_xor(ss, 1);
#pragma unroll
            for (int o_ = 2; o_ < 64; o_ <<= 1) ss = fmaxf(ss, __shfl_xor(ss, o_));
            if (C.lane == 0) bm[4 + C.wave] = ss;
        }
    }
    __syncthreads();
    const float far_bias = ((const LAS float*)(C.lds + BIAS_OFF))[C.head * 128 + 127];
    const int bg = b * 4 + g;
    float qn, bmax, kc2;
    {
        float ss = 0.f;
#pragma unroll
        for (int d0 = 0; d0 < 4; ++d0) { const u32x4 w = __builtin_bit_cast(u32x4, C.qr[d0]); const unsigned ww[4] = {w.x, w.y, w.z, w.w};
#pragma unroll
            for (int e = 0; e < 4; ++e) { const float a = bflo(ww[e]), b2 = bfhi(ww[e]); ss += a * a + b2 * b2; } }
        qn = sqrtf(pair_sum(ss));
        const LAS float* bm = (const LAS float*)(C.lds + BMAX_OFF);
        bmax = bm[C.head];
        kc2 = fmaxf(fmaxf(fmaxf(bm[4], bm[5]), fmaxf(bm[6], bm[7])), fmaxf(fmaxf(bm[8], bm[9]), fmaxf(bm[10], bm[11])));
    }
    const unsigned* kmx = (const unsigned*)(ws + CTL_KMAX);
    const float m_c = qn * sqrtf(kc2) + bmax, m_s = qn * sqrtf(__builtin_bit_cast(float, kmx[bg])) + bmax, m_w = qn * sqrtf(__builtin_bit_cast(float, kmx[16 + bg])) + bmax;
    f32x16 o[2], negm;
    float l;
    {
        const Src S{(const bf16_t*)(ws + WS_KCMP) + (size_t)(bg * 256) * 64, 64, (const bf16_t*)(ws + WS_VCT) + (size_t)(bg * 64) * 256, 256};
        const int nkt = (4 * i + 2) / 64 + 1;
        l = 0.f; o[0] = f32x16{}; o[1] = f32x16{}; negm = f32x16{};
        branch<CMP_A>(C, S, 0, nkt - 1, negm, m_c, l, o, 0.f, 0u, 0u);
        const float lt = pair_sum(l), inv = lt > 0.f ? 1.f / lt : 0.f;
        branch<CMP_B>(C, S, 0, nkt - 1, negm, m_c, l, o, inv, 0u, 0u);
        row_fma<true>(o, gate[0], C);
    }
    {
        LDS_WAIT();
        LAS unsigned char* selb = C.lds + SEL_OFF;
        if (i >= 16) {
            const int tk = C.lane >> 3, cg = C.lane & 7;
            LAS unsigned* rowb = (LAS unsigned*)(C.lds + IMP_OFF) + (8 * C.wave + tk) * 65;
            unsigned long long kc[8]; unsigned cnt[8];
#pragma unroll
            for (int c = 0; c < 8; ++c) { const int s = cg * 8 + c; unsigned xb = rowb[s];
                xb = (s == 0 || s == i || s == i - 1) ? 0x461c4000u   : xb;
                rowb[s] = xb; kc[c] = ((unsigned long long)xb << 6) | (unsigned)(63 - s); cnt[c] = 0u; }
            LDS_WAIT();
            for (int s2 = 0; s2 <= i; ++s2) {
                const unsigned long long k2 = ((unsigned long long)rowb[s2] << 6) | (unsigned)(63 - s2);
#pragma unroll
                for (int c = 0; c < 8; ++c) cnt[c] += (k2 > kc[c]) ? 1u : 0u;
            }
            unsigned bits = 0;
#pragma unroll
            for (int c = 0; c < 8; ++c) { const int s = cg * 8 + c; if (cnt[c] < 16u && s <= i) bits |= 1u << c; }
            selb[(8 * C.wave + tk) * 8 + cg] = (unsigned char)bits;
        } else {
            if (C.lane < 8) { const unsigned long long mk = (2ull << i) - 1ull; *(LAS unsigned long long*)(selb + (8 * C.wave + C.lane) * 8) = mk; }
        }
        LDS_WAIT();
    }
    const u32x2 selw = *(const LAS u32x2*)(C.lds + SEL_OFF + C.tl * 8);
    {
        const Src S{proj + (size_t)b * SEQ * NPROJ + COL_KS + g * 64, NPROJ, (const bf16_t*)(ws + WS_VST) + (size_t)(bg * 64) * SEQ, SEQ};
        l = 0.f; o[0] = f32x16{}; o[1] = f32x16{};
#pragma unroll
        for (int r = 0; r < 16; ++r) negm[r] = far_bias - m_s;
        branch<SLC>(C, S, 0, i, negm, m_s, l, o, 0.f, selw.x, selw.y);
        const float lt = pair_sum(l);
        row_fma<false>(o, gate[1] / lt, C);
    }
    {
        const Src S{proj + (size_t)b * SEQ * NPROJ + COL_KW + g * 64, NPROJ, (const bf16_t*)(ws + WS_VWT) + (size_t)(bg * 64) * SEQ, SEQ};
        l = 0.f; o[0] = f32x16{}; o[1] = f32x16{};
#pragma unroll
        for (int r = 0; r < 16; ++r) negm[r] = far_bias - m_w;
        branch<WIN>(C, S, i >= 8 ? i - 8 : 0, i, negm, m_w, l, o, 0.f, 0u, 0u);
        const float lt = pair_sum(l);
        row_fma<false>(o, gate[2] / lt, C);
    }
    {
        bf16_t* mix = (bf16_t*)(ws + WS_MIX);
        const LAS float* otw = (const LAS float*)(C.lds + OT_OFF + C.wave * OT_WAVE);
#pragma unroll
        for (int k = 0; k < 4; ++k) { const int rowq = 8 * k + (C.lane >> 3), ch = C.lane & 7;
            const f32x4 a = *(const LAS f32x4*)(otw + rowq * OT_STR + ch * 8), c4 = *(const LAS f32x4*)(otw + rowq * OT_STR + ch * 8 + 4);
            u32x4 w; w.x = pk2(a[0], a[1]); w.y = pk2(a[2], a[3]); w.z = pk2(c4[0], c4[1]); w.w = pk2(c4[2], c4[3]);
            const size_t orow = (size_t)b * SEQ + 64 * i + 8 * C.wave + (rowq >> 2);
            *(u32x4*)(mix + orow * DM + 1024 + (g * 4 + (rowq & 3)) * 64 + ch * 8) = w; }
    }
    __syncthreads();
}
__device__ __forceinline__ void attn_phase(Frame& F) {
    for (int v = F.vcu; v < 256; v += F.G) {
        const int bg = v >> 4, s = v & 15;
#pragma unroll 1
        for (int k = 0; k < 4; ++k) { const int i = (k == 0) ? 63 - s : (k == 1) ? 32 + s : (k == 2) ? 31 - s : s; attn_unit(F, bg >> 2, bg & 3, i, k == 0); }
    }
}
}

__device__ __forceinline__ void final_norm_phase(Frame& F) {
    const int gw = F.vcu * NWAVES + F.wave, NGW = F.G * NWAVES, lane = F.lane;
    const float* ss = (const float*)(F.ws + CTL_SS2); const f32x4* nw = (const f32x4*)F.a->in[I_NFW] + 2 * lane;
    for (int mrow = gw; mrow < MTOK; mrow += NGW) {
        const float rs = __builtin_amdgcn_rsqf(ss[mrow] * (1.f / DM) + EPS);
        const u32x4* xr = (const u32x4*)((const bf16_t*)(F.ws + WS_MIX) + (size_t)mrow * DM) + lane;
        f32x4* orow = (f32x4*)(F.out + (size_t)mrow * DM) + 2 * lane;
#pragma unroll
        for (int j = 0; j < 4; ++j) { const u32x4 b = xr[64 * j]; const f32x4 w0 = nw[128 * j], w1 = nw[128 * j + 1];
            orow[128 * j] = (f32x4){bflo(b.x), bfhi(b.x), bflo(b.y), bfhi(b.y)} * rs * w0; orow[128 * j + 1] = (f32x4){bflo(b.z), bfhi(b.z), bflo(b.w), bfhi(b.w)} * rs * w1; }
    }
}

constexpr int N_PHASES = 9;
__global__ void __launch_bounds__(NWAVES * 64, 2) hymba_fwd(Args args) {
    extern __shared__ __attribute__((aligned(16))) unsigned char lds_raw[];
    Frame F;
    F.lds = (LAS unsigned char*)lds_raw;
    F.tid = threadIdx.x; F.lane = F.tid & 63; F.wave = __builtin_amdgcn_readfirstlane(F.tid >> 6);
    F.G = gridDim.x; { const int bx = blockIdx.x; F.vcu = (F.G % 8 == 0) ? (bx % 8) * (F.G / 8) + bx / 8 : bx; }
    F.a = &args; F.out = args.out; F.ws = args.ws;
    unsigned char* ws = args.ws;
    volatile LAS unsigned* MISC = (volatile LAS unsigned*)(F.lds + MISC_OFF);
    if (F.tid < 32) MISC[F.tid] = 0u;
    __syncthreads();
    XcdBarrier bar; bar.bar = (unsigned*)(ws + WS_CTL) + CW_BAR; bar.x = 0; bar.st = nullptr;
    const int lo = args.ph_lo, hi = args.ph_hi;
    const bool multi = (hi - lo) > 1;
    if (multi) bar = xcd_barrier_post((unsigned*)(ws + WS_CTL) + CW_BAR, MISC + 8);
#ifndef REPEAT_PHASE
#define REPEAT_PHASE -1
#endif
#define REP(k) for (int rep_ = 0; rep_ < ((REPEAT_PHASE == (k)) ? 2 : 1); ++rep_)
#ifndef ONLY_PHASE
#define ONLY_PHASE -1
#endif
#define IN(k) ((ONLY_PHASE < 0 || ONLY_PHASE == (k)) && lo <= (k) && (k) < hi)
#define SEAM(k) do { if (IN(k) && IN((k) + 1)) xcd_barrier(bar); } while (0)
    const int cblk = (int)blockIdx.x;

    if (IN(0)) { REP(0) { p0_prologue(F); } SEAM(0); }
    if (IN(1)) {
        pg8::Gemm g{(const bf16_t*)(ws + WS_XB), (const bf16_t*)(ws + WS_WIN), MTOK, NPROJ, DM, DM, 128, 0};
        pg8::StaticOrder S; S.init(MTOK, NPROJ, F.G, cblk);
        pg8::EpiProj E{(bf16_t*)(ws + WS_PROJ), (const float*)(ws + WS_R1), (bf16_t*)(ws + WS_VST), (bf16_t*)(ws + WS_VWT)};
        REP(1) { pg8::gemm_phase<pg8::EpiProj, pg8::StaticOrder, true>(F.lds, g, S, E); }
        cmp_bias_reduce(F);
        late_transposes(F, 1);
        SEAM(1);
    }
    if (IN(2)) { REP(2) {
        {
            pg8::Gemm g{(const bf16_t*)(ws + WS_PROJ) + COL_KC, (const bf16_t*)(ws + WS_WC1K), 4096, 256, 2048, 16 * NPROJ, NPROJ * 2, 1};
            pg8::StaticOrder S; S.init(4096, 256, F.G, cblk);
            pg8::EpiCmp E{(bf16_t*)(ws + WS_HC), (const float*)(ws + WS_CBF)};
            pg8::gemm_phase<pg8::EpiCmp, pg8::StaticOrder, true>(F.lds, g, S, E);
        }
        {
            pg8::Gemm g{(const bf16_t*)(ws + WS_PROJ) + COL_VC, (const bf16_t*)(ws + WS_WC1V), 4096, 256, 2048, 16 * NPROJ, NPROJ * 2, 1};
            pg8::StaticOrder S; S.init(4096, 256, F.G, (cblk + F.G - 16) % F.G);
            pg8::EpiCmp E{(bf16_t*)(ws + WS_HC) + (size_t)4096 * 256, (const float*)(ws + WS_CBF) + 256};
            pg8::gemm_phase<pg8::EpiCmp, pg8::StaticOrder, true>(F.lds, g, S, E);
        }
        __syncthreads();
        if (F.wave < 4) { late_transposes(F, 0); s5_phase<false>(F); } else { s5_phase<false>(F); late_transposes(F, 0); }
        knorm_phase(F);
        __syncthreads(); }
        SEAM(2);
    }
    if (IN(3)) { REP(3) { if (REPEAT_PHASE != 31) s5_phase<true>(F); if (REPEAT_PHASE != 32) cmp2_phase(F); __syncthreads(); } SEAM(3); }
    if (IN(4)) {
        __syncthreads();
        pg8::Gemm g{(const bf16_t*)(ws + WS_Z), (const bf16_t*)(ws + WS_WGLU), MTOK, 1024, 1024, 1024, 128, 0};
        pg8::StaticOrder S; S.init(MTOK, 1024, F.G, cblk);
        pg8::EpiGlu E{(bf16_t*)(ws + WS_MIX), (const bf16_t*)(ws + WS_Z), F.a->in[I_BGLU]};
        for (int rep_ = 0; rep_ < ((REPEAT_PHASE == 40) ? 2 : 1); ++rep_) pg8::gemm_phase<pg8::EpiGlu, pg8::StaticOrder, true>(F.lds, g, S, E);
        __syncthreads();
        REP(4) { att::attn_phase(F); __syncthreads(); }
        SEAM(4);
    }
    if (IN(5)) {
        __syncthreads();
        pg8::Gemm g{(const bf16_t*)(ws + WS_MIX), (const bf16_t*)(ws + WS_WOUT), MTOK, DM, DM, DM, 128, 0};
        pg8::StaticOrder S; S.init(MTOK, DM, F.G, cblk);
        pg8::EpiRes<false> E{F.a->in[I_X], (bf16_t*)(ws + WS_X1B), (float*)(ws + CTL_SS1)};
        pg8::gemm_phase<pg8::EpiRes<false>, pg8::StaticOrder, true>(F.lds, g, S, E);
        SEAM(5);
    }
    if (IN(6)) {
        pg8::Gemm g{(const bf16_t*)(ws + WS_X1B), (const bf16_t*)(ws + WS_WUP), MTOK, DFF, DM, DM, 128, 0};
        pg8::StaticOrder S; S.init(MTOK, DFF, F.G, cblk);
        pg8::EpiUp E{(bf16_t*)(ws + WS_HID), (const float*)(ws + CTL_SS1)};
        REP(6) { pg8::gemm_phase<pg8::EpiUp, pg8::StaticOrder, true>(F.lds, g, S, E); }
        SEAM(6);
    }
    if (IN(7)) {
        pg8::Gemm g{(const bf16_t*)(ws + WS_HID), (const bf16_t*)(ws + WS_WDOWN), MTOK, DM, DFF, DFF, 128, 0};
        pg8::StaticOrder S; S.init(MTOK, DM, F.G, cblk);
        pg8::EpiRes<true> E{(const bf16_t*)(ws + WS_X1B), (bf16_t*)(ws + WS_MIX), (float*)(ws + CTL_SS2)};
        pg8::gemm_phase<pg8::EpiRes<true>, pg8::StaticOrder, true>(F.lds, g, S, E);
        SEAM(7);
    }
    if (IN(8)) final_norm_phase(F);
#undef IN
#undef SEAM
}

extern "C" void kernel_launch(void* const* d_in, const int* in_sizes, int n_in, void* d_out, int out_size, void* d_ws, size_t ws_size, hipStream_t stream) {
    static int grid = 0;
    if (grid == 0) {
        if (n_in != 25 || in_sizes[0] != MTOK * DM || out_size != MTOK * DM || ws_size < WS_END) {
            fprintf(stderr, "kernel_launch: unexpected shapes (n_in %d, in0 %d, out %d, ws %zu < %zu); nothing launched\n", n_in, n_in > 0 ? in_sizes[0] : -1, out_size, ws_size, (size_t)WS_END); grid = -1; return; }
        int dev = 0, cus = 0, per_cu = 0;
        if (hipGetDevice(&dev) != hipSuccess || hipDeviceGetAttribute(&cus, hipDeviceAttributeMultiprocessorCount, dev) != hipSuccess) { grid = -1; return; }
        if (hipFuncSetAttribute((const void*)hymba_fwd, hipFuncAttributeMaxDynamicSharedMemorySize, LDS_BYTES) != hipSuccess) { fprintf(stderr, "kernel_launch: hipFuncSetAttribute failed\n"); grid = -1; return; }
        if (hipOccupancyMaxActiveBlocksPerMultiprocessor(&per_cu, (const void*)hymba_fwd, NWAVES * 64, LDS_BYTES) != hipSuccess || per_cu < 1) { fprintf(stderr, "kernel_launch: occupancy query says %d blocks per CU\n", per_cu); per_cu = 1; }
        (void)hipGetLastError();
        grid = cus;
    }
    if (grid < 0) return;
    if (MK_N_LAUNCHES == 1) { if (hipMemsetAsync((char*)d_ws + WS_CTL, 0, CTL_ZERO_BYTES, stream) != hipSuccess) return; }
    Args a{};
    for (int i = 0; i < 25; ++i) a.in[i] = (const float*)d_in[i];
    a.out = (float*)d_out; a.ws = (unsigned char*)d_ws;
    if (MK_N_LAUNCHES == 1) {
        a.ph_lo = 0; a.ph_hi = N_PHASES;
        void* kargs[] = {&a};
        hipError_t e = hipLaunchCooperativeKernel((const void*)hymba_fwd, dim3(grid), dim3(NWAVES * 64), kargs, LDS_BYTES, stream);
        if (e != hipSuccess) fprintf(stderr, "kernel_launch: cooperative launch failed: %s (grid %d)\n", hipGetErrorString(e), grid);
    } else {
        for (int p = 0; p < N_PHASES; ++p) { a.ph_lo = p; a.ph_hi = p + 1; hipLaunchKernelGGL(hymba_fwd, dim3(grid), dim3(NWAVES * 64), LDS_BYTES, stream, a); }
    }
}
```
